# Optimizing an MI355X kernel written in HIP

```python
import math
import jax, jax.numpy as jnp
from jax import lax
import numpy as np

D_MODEL = 2048
BATCH = 8
SEQ = 4096
DEPTH = 2

CHUNK = 64
Q_BLOCK = 128
NORM_EPS = 1e-6
NEG_INF = -1e30

A_HEADS = 8
A_QK_DIM = 64
A_V_DIM = 2 * A_QK_DIM
B_HEADS = 8
B_HEAD_DIM = 128
C_HEADS = 8
C_Q_RANK = 512
C_KV_RANK = 512
C_NOPE_DIM = 128
C_ROPE_DIM = 64
C_V_DIM = 128
ROPE_THETA = 10000.0

N_BRANCHES = 3
BRANCH_WIDTH = 1024

IN_SPLIT_SIZES = (
    A_HEADS * 2 * A_QK_DIM,
    A_HEADS * 2 * A_QK_DIM,
    A_HEADS * A_V_DIM,
    B_HEADS * B_HEAD_DIM,
    B_HEADS * B_HEAD_DIM,
    B_HEADS * B_HEAD_DIM,
    B_HEADS,
    C_Q_RANK,
    C_KV_RANK,
    C_ROPE_DIM,
    N_BRANCHES * D_MODEL,
)
N_IN = 13384

DFF_DENSE = 5632
N_EXPERTS = 8
TOP_K = 2
DFF_EXPERT = 7168

kernel_name = 'hybrid_gated_diff_fox_mla_moe_encoder'


def rmsnorm(x, g):
    xf = x.astype(jnp.float32)
    y = xf * lax.rsqrt(jnp.mean(xf * xf, axis=-1, keepdims=True) + NORM_EPS)
    return (y * g.astype(jnp.float32)).astype(x.dtype)


def rotary(x, positions):
    half = x.shape[-1] // 2
    inv_freq = ROPE_THETA ** (-jnp.arange(half, dtype=jnp.float32) / half)
    ang = positions.astype(jnp.float32)[..., None] * inv_freq
    if x.ndim == 4:
        ang = ang[:, :, None, :]
    cos, sin = jnp.cos(ang), jnp.sin(ang)
    xf = x.astype(jnp.float32)
    x1, x2 = xf[..., :half], xf[..., half:]
    return jnp.concatenate([x1 * cos - x2 * sin, x2 * cos + x1 * sin], axis=-1).astype(x.dtype)


def alibi_slopes(n_heads):
    return jnp.exp2(-8.0 * (jnp.arange(n_heads, dtype=jnp.float32) + 1.0) / n_heads)


def block_causal_mask(q_idx, k_idx):
    return (k_idx[None, :] // CHUNK) <= (q_idx[:, None] // CHUNK)


def sweep_query_blocks(block_fn, seq_len):
    out = lax.map(block_fn, jnp.arange(seq_len // Q_BLOCK))
    nb, b, qb, h, dv = out.shape
    return jnp.moveaxis(out, 0, 1).reshape(b, nb * qb, h, dv)


def diff_attention(q, k, v, positions, lam, lam_init, subln_g):
    b, s_len, h, dv = v.shape
    slopes = alibi_slopes(h)
    k_idx = jnp.arange(s_len)
    scale = A_QK_DIM ** -0.5

    def block(i):
        start = i * Q_BLOCK
        qb = lax.dynamic_slice_in_dim(q, start, Q_BLOCK, axis=1)
        pq = lax.dynamic_slice_in_dim(positions, start, Q_BLOCK, axis=1)
        q_idx = start + jnp.arange(Q_BLOCK)
        s = jnp.einsum('bqhmd,bkhmd->bhmqk', qb, k).astype(jnp.float32) * scale
        dist = jnp.abs(pq[:, :, None] - positions[:, None, :]).astype(jnp.float32)
        s = s - slopes[None, :, None, None, None] * dist[:, None, None]
        s = jnp.where(block_causal_mask(q_idx, k_idx), s, NEG_INF)
        p = jax.nn.softmax(s, axis=-1)
        w = p[:, :, 0] - lam * p[:, :, 1]
        return jnp.einsum('bhqk,bkhd->bqhd', w.astype(v.dtype), v)

    o = sweep_query_blocks(block, s_len)
    o = rmsnorm(o, subln_g) * (1.0 - lam_init)
    return o.reshape(b, s_len, h * dv)


def forgetting_attention(q, k, v, f_logit):
    b, s_len, h, d = v.shape
    cum = jnp.cumsum(jax.nn.log_sigmoid(f_logit.astype(jnp.float32)), axis=1)
    cum_t = jnp.transpose(cum, (0, 2, 1))
    k_idx = jnp.arange(s_len)
    scale = d ** -0.5

    def block(i):
        start = i * Q_BLOCK
        qb = lax.dynamic_slice_in_dim(q, start, Q_BLOCK, axis=1)
        cq = lax.dynamic_slice_in_dim(cum_t, start, Q_BLOCK, axis=2)
        q_idx = start + jnp.arange(Q_BLOCK)
        s = jnp.einsum('bqhd,bkhd->bhqk', qb, k).astype(jnp.float32) * scale
        s = s + (cq[:, :, :, None] - cum_t[:, :, None, :])
        s = jnp.where(k_idx[None, :] <= q_idx[:, None], s, NEG_INF)
        p = jax.nn.softmax(s, axis=-1)
        return jnp.einsum('bhqk,bkhd->bqhd', p.astype(v.dtype), v)

    return sweep_query_blocks(block, s_len).reshape(b, s_len, h * d)


def latent_attention(c_q, c_kv, k_rope, positions, q_norm_g, kv_norm_g, w_uq, w_uk, w_uv):
    b, s_len, _ = c_q.shape
    q = jnp.einsum('bsr,rhd->bshd', rmsnorm(c_q, q_norm_g), w_uq)
    q_nope = q[..., :C_NOPE_DIM]
    q_rope = rotary(q[..., C_NOPE_DIM:], positions)
    ckv = rmsnorm(c_kv, kv_norm_g)
    k_nope = jnp.einsum('bsr,rhd->bshd', ckv, w_uk)
    v = jnp.einsum('bsr,rhd->bshd', ckv, w_uv)
    k_r = rotary(k_rope, positions)
    k_idx = jnp.arange(s_len)
    scale = (C_NOPE_DIM + C_ROPE_DIM) ** -0.5

    def block(i):
        start = i * Q_BLOCK
        qn = lax.dynamic_slice_in_dim(q_nope, start, Q_BLOCK, axis=1)
        qr = lax.dynamic_slice_in_dim(q_rope, start, Q_BLOCK, axis=1)
        q_idx = start + jnp.arange(Q_BLOCK)
        s = (jnp.einsum('bqhd,bkhd->bhqk', qn, k_nope)
             + jnp.einsum('bqhr,bkr->bhqk', qr, k_r)).astype(jnp.float32) * scale
        s = jnp.where(block_causal_mask(q_idx, k_idx), s, NEG_INF)
        p = jax.nn.softmax(s, axis=-1)
        return jnp.einsum('bhqk,bkhd->bqhd', p.astype(v.dtype), v)

    return sweep_query_blocks(block, s_len).reshape(b, s_len, C_HEADS * C_V_DIM)


def hybrid_mixer(h, positions, w_in, diff_lambda, diff_subln_g, fox_forget_bias,
                 mla_q_norm_g, mla_kv_norm_g, mla_w_uq, mla_w_uk, mla_w_uv,
                 w_branch, w_out, lam_init):
    b, s_len, _ = h.shape
    split_points = [int(p) for p in np.cumsum(IN_SPLIT_SIZES)[:-1]]
    (a_q, a_k, a_v, b_q, b_k, b_v, b_f, c_q, c_kv, c_kr, gates) = jnp.split(
        h @ w_in, split_points, axis=-1)

    lam_f = diff_lambda.astype(jnp.float32)
    lam = (jnp.exp(jnp.sum(lam_f[0] * lam_f[1])) - jnp.exp(jnp.sum(lam_f[2] * lam_f[3]))
           + lam_init)
    o_a = diff_attention(a_q.reshape(b, s_len, A_HEADS, 2, A_QK_DIM),
                         a_k.reshape(b, s_len, A_HEADS, 2, A_QK_DIM),
                         a_v.reshape(b, s_len, A_HEADS, A_V_DIM),
                         positions, lam, lam_init, diff_subln_g)
    o_b = forgetting_attention(b_q.reshape(b, s_len, B_HEADS, B_HEAD_DIM),
                               b_k.reshape(b, s_len, B_HEADS, B_HEAD_DIM),
                               b_v.reshape(b, s_len, B_HEADS, B_HEAD_DIM),
                               b_f + fox_forget_bias)
    o_c = latent_attention(c_q, c_kv, c_kr, positions, mla_q_norm_g, mla_kv_norm_g,
                           mla_w_uq, mla_w_uk, mla_w_uv)

    branches = jnp.stack([o_a, o_b, o_c], axis=2)
    branch_out = jnp.einsum('bsgc,gcd->bsgd', branches, w_branch)
    gate = jax.nn.sigmoid(gates.reshape(b, s_len, N_BRANCHES, D_MODEL))
    merged = jnp.sum(gate * branch_out, axis=2)
    return merged @ w_out


def swiglu(h, w1, w3, w2):
    return (jax.nn.silu(h @ w1) * (h @ w3)) @ w2


def moe_swiglu(h, router_w, w1, w3, w2):
    logits = (h @ router_w).astype(jnp.float32)
    top_vals, top_idx = lax.top_k(logits, TOP_K)
    weights = jax.nn.softmax(top_vals, axis=-1)
    combine = jnp.einsum('bsk,bske->bse', weights,
                         jax.nn.one_hot(top_idx, N_EXPERTS, dtype=jnp.float32))
    y = jnp.zeros_like(h)
    for e in range(N_EXPERTS):
        y = y + combine[..., e, None].astype(h.dtype) * swiglu(h, w1[e], w3[e], w2[e])
    return y


def setup_inputs(seed: int = 0) -> dict:
    key = jax.random.key(seed)
    ks = jax.random.split(key, 24)
    n_dense = (DEPTH + 1) // 2
    n_moe = DEPTH // 2

    def normal(k, shape, fan_in):
        return jax.random.normal(k, shape, jnp.float32) * (fan_in ** -0.5)

    def gain(k, shape):
        return 1.0 + 0.02 * jax.random.normal(k, shape, jnp.float32)

    x = jax.random.normal(ks[0], (BATCH, SEQ, D_MODEL), jnp.float32)
    offset = jax.random.randint(ks[1], (BATCH, 1), 0, 16, dtype=jnp.int32) * CHUNK
    positions = offset + jnp.arange(SEQ, dtype=jnp.int32)[None, :]
    return {
        'x': x,
        'positions': positions,
        'attn_norm_g': gain(ks[2], (DEPTH, D_MODEL)),
        'w_in': normal(ks[3], (DEPTH, D_MODEL, N_IN), D_MODEL),
        'diff_lambda': 0.1 * jax.random.normal(ks[4], (DEPTH, 4, A_QK_DIM), jnp.float32),
        'diff_subln_g': gain(ks[5], (DEPTH, A_V_DIM)),
        'fox_forget_bias': jax.random.uniform(ks[6], (DEPTH, B_HEADS), jnp.float32, 1.0, 5.0),
        'mla_q_norm_g': gain(ks[7], (DEPTH, C_Q_RANK)),
        'mla_kv_norm_g': gain(ks[8], (DEPTH, C_KV_RANK)),
        'mla_w_uq': normal(ks[9], (DEPTH, C_Q_RANK, C_HEADS, C_NOPE_DIM + C_ROPE_DIM), C_Q_RANK),
        'mla_w_uk': normal(ks[10], (DEPTH, C_KV_RANK, C_HEADS, C_NOPE_DIM), C_KV_RANK),
        'mla_w_uv': normal(ks[11], (DEPTH, C_KV_RANK, C_HEADS, C_V_DIM), C_KV_RANK),
        'w_branch': normal(ks[12], (DEPTH, N_BRANCHES, BRANCH_WIDTH, D_MODEL), BRANCH_WIDTH),
        'w_out': normal(ks[13], (DEPTH, D_MODEL, D_MODEL), D_MODEL),
        'ffn_norm_g': gain(ks[14], (DEPTH, D_MODEL)),
        'dense_w1': normal(ks[15], (n_dense, D_MODEL, DFF_DENSE), D_MODEL),
        'dense_w3': normal(ks[16], (n_dense, D_MODEL, DFF_DENSE), D_MODEL),
        'dense_w2': normal(ks[17], (n_dense, DFF_DENSE, D_MODEL), DFF_DENSE),
        'router_w': normal(ks[18], (n_moe, D_MODEL, N_EXPERTS), D_MODEL),
        'expert_w1': normal(ks[19], (n_moe, N_EXPERTS, D_MODEL, DFF_EXPERT), D_MODEL),
        'expert_w3': normal(ks[20], (n_moe, N_EXPERTS, D_MODEL, DFF_EXPERT), D_MODEL),
        'expert_w2': normal(ks[21], (n_moe, N_EXPERTS, DFF_EXPERT, D_MODEL), DFF_EXPERT),
        'final_norm_g': gain(ks[22], (D_MODEL,)),
    }


def reference(x, positions, attn_norm_g, w_in, diff_lambda, diff_subln_g, fox_forget_bias,
              mla_q_norm_g, mla_kv_norm_g, mla_w_uq, mla_w_uk, mla_w_uv, w_branch, w_out,
              ffn_norm_g, dense_w1, dense_w3, dense_w2, router_w, expert_w1, expert_w3,
              expert_w2, final_norm_g):
    for l in range(DEPTH):
        lam_init = 0.8 - 0.6 * math.exp(-0.3 * l)
        h = rmsnorm(x, attn_norm_g[l])
        x = x + hybrid_mixer(h, positions, w_in[l], diff_lambda[l], diff_subln_g[l],
                             fox_forget_bias[l], mla_q_norm_g[l], mla_kv_norm_g[l],
                             mla_w_uq[l], mla_w_uk[l], mla_w_uv[l], w_branch[l], w_out[l],
                             lam_init)
        h = rmsnorm(x, ffn_norm_g[l])
        j = l // 2
        if l % 2 == 0:
            x = x + swiglu(h, dense_w1[j], dense_w3[j], dense_w2[j])
        else:
            x = x + moe_swiglu(h, router_w[j], expert_w1[j], expert_w3[j], expert_w2[j])
    return rmsnorm(x, final_norm_g)
```

```cpp
#include <hip/hip_runtime.h>
#include <cstdio>
#include <cstdint>

#ifndef MK_ONE_LAUNCH
#define MK_ONE_LAUNCH 1
#endif

#define GAS __attribute__((address_space(1)))
#define LAS __attribute__((address_space(3)))
typedef unsigned short bf16_t;
typedef short bf16x8 __attribute__((ext_vector_type(8)));
typedef short s16x4 __attribute__((ext_vector_type(4)));
typedef float f32x4 __attribute__((ext_vector_type(4)));
typedef float f32x2 __attribute__((ext_vector_type(2)));
typedef float f32x16 __attribute__((ext_vector_type(16)));
typedef unsigned u32x4 __attribute__((ext_vector_type(4)));
typedef unsigned u32x2 __attribute__((ext_vector_type(2)));
typedef int i32x4 __attribute__((ext_vector_type(4)));

constexpr int NB = 8, SEQ = 4096, T = NB * SEQ, DM = 2048, DEPTH = 2;
constexpr int N_IN_SRC = 13384, NIN = 13568, LDP = 13312, TAILW = 256;
constexpr int DFF = 5632, NEXP = 8, DFFE = 7168;
constexpr float NORM_EPS = 1e-6f;
constexpr int PC_AQ = 0, PC_AK = 1024, PC_AV = 2048, PC_BQ = 3072, PC_BK = 4096, PC_BV = 5120, PC_CQ = 6144, PC_CKV = 6656, PC_GATE = 7168;
constexpr int MOE_ROWS = 2 * T + 2048;

constexpr size_t MiB = 1u << 20;
constexpr size_t WS_CTL = 0, CTL_ZERO_BYTES = 1 * MiB;
constexpr size_t WS_MISC = 3 * MiB;
constexpr size_t MS_RSTDQ = WS_MISC, MS_RSTDKV = MS_RSTDQ + (size_t)T * 4, MS_CKS = MS_RSTDKV + (size_t)T * 4, MS_ROUTE = MS_CKS + (size_t)NB * 8 * SEQ * 4,
                 MS_RSTD2 = MS_ROUTE + (size_t)T * 16, MS_SLOTS = MS_RSTD2 + (size_t)T * 4, MS_CNT = MS_SLOTS + (size_t)T * 8, MS_MOEOFF = MS_CNT + 1024 * 8 * 4,
                 MS_LAM = MS_MOEOFF + 256, MS_END = MS_LAM + 256;
static_assert(MS_END <= 8 * MiB, "misc region");
constexpr size_t WS_BASE = 8 * MiB;
constexpr size_t SZ_WIN = (size_t)NIN * DM * 2, SZ_WUQ = (size_t)1536 * 512 * 2, SZ_WUKV = (size_t)2048 * 512 * 2, SZ_WBR = (size_t)3 * 2048 * 1024 * 2, SZ_WOUT = (size_t)DM * DM * 2;
constexpr size_t WS_WIN = WS_BASE, WS_WUQ = WS_WIN + 2 * SZ_WIN, WS_WUKV = WS_WUQ + 2 * SZ_WUQ, WS_WBR = WS_WUKV + 2 * SZ_WUKV, WS_WOUT = WS_WBR + 2 * SZ_WBR,
                 WS_WD13 = WS_WOUT + 2 * SZ_WOUT, WS_WD2 = WS_WD13 + (size_t)2 * DFF * DM * 2, WS_H = WS_WD2 + (size_t)DM * DFF * 2,
                 WS_PROJ = WS_H + (size_t)T * DM * 2, WS_TAIL = WS_PROJ + (size_t)T * LDP * 2, WS_QM = WS_TAIL + (size_t)T * TAILW * 4, WS_KNV = WS_QM + (size_t)T * 1536 * 2,
                 WS_KROT = WS_KNV + (size_t)T * 2048 * 2, WS_OBUF = WS_KROT + (size_t)T * 64 * 2, WS_MERGED = WS_OBUF + (size_t)T * 3072 * 2, WS_MIX_END = WS_MERGED + (size_t)T * DM * 2;
constexpr size_t WS_UD = WS_PROJ;
static_assert((size_t)T * DFF * 2 <= (size_t)T * LDP * 2, "dense hidden fits in proj");
constexpr size_t WS_EW13 = WS_BASE, WS_EW2 = WS_EW13 + (size_t)NEXP * 2 * DFFE * DM * 2, WS_HS = WS_EW2 + (size_t)NEXP * DM * DFFE * 2,
                 WS_UM = WS_HS + (size_t)MOE_ROWS * DM * 2, WS_MOE_END = WS_UM + (size_t)MOE_ROWS * DFFE * 2;
constexpr size_t WS_NEED = WS_MIX_END > WS_MOE_END ? WS_MIX_END : WS_MOE_END;
static_assert(WS_NEED <= 2134232128ull, "workspace map exceeds the guaranteed minimum");
constexpr int CW_TMO = 0, CW_BAR = 4096;

constexpr int RING_BYTES = 131072, LDSCTL_OFF = RING_BYTES, MISC_OFF = LDSCTL_OFF + 320, LDS_BYTES = 147456;

#define RLX_AGENT __ATOMIC_RELAXED, __HIP_MEMORY_SCOPE_AGENT
#define LDS_WAIT() asm volatile("s_waitcnt lgkmcnt(0)" ::: "memory")
#define VM_WAIT() asm volatile("s_waitcnt vmcnt(0)" ::: "memory")
__device__ __forceinline__ unsigned cvt_pk_bf16(float lo, float hi) { unsigned r; asm volatile("v_cvt_pk_bf16_f32 %0, %1, %2" : "=v"(r) : "v"(lo), "v"(hi)); return r; }
__device__ __forceinline__ float bf2f(unsigned short h) { return __uint_as_float((unsigned)h << 16); }
__device__ __forceinline__ float bflo(unsigned w) { return __uint_as_float(w << 16); }
__device__ __forceinline__ float bfhi(unsigned w) { return __uint_as_float(w & 0xffff0000u); }
template <int CTRL> __device__ __forceinline__ float dpp_f(float v) { return __int_as_float(__builtin_amdgcn_update_dpp(0, __float_as_int(v), CTRL, 0xf, 0xf, true)); }
__device__ __forceinline__ float row_sum16(float v) {
    v += dpp_f<0xB1>(v);
    v += dpp_f<0x4E>(v);
    v += dpp_f<0x141>(v);
    v += dpp_f<0x140>(v);
    return v;
}
__device__ __forceinline__ float wave_sum(float v) {
    v = row_sum16(v);
    const int i = __float_as_int(v);
    return (__int_as_float(__builtin_amdgcn_readlane(i, 0)) + __int_as_float(__builtin_amdgcn_readlane(i, 16))) + (__int_as_float(__builtin_amdgcn_readlane(i, 32)) + __int_as_float(__builtin_amdgcn_readlane(i, 48)));
}
__device__ __forceinline__ float sigmoidf_(float x) { return __builtin_amdgcn_rcpf(1.0f + __expf(-x)); }

#define XB_TMO      128
#define XB_XCNT(j)  (256  + 64 * (j))
#define XB_XSUB(j)  (1280 + 64 * (j))
#define XB_XGEN(j)  (2304 + 64 * (j))
#define XB_TOP      3328
#define XB_TOPGEN   3392
#define XCD_BAR_WORDS 3456
#define XB_SPIN_CAP (1u << 22)
__device__ __forceinline__ unsigned xb_ld(unsigned* p)              { return __hip_atomic_load(p, __ATOMIC_RELAXED, __HIP_MEMORY_SCOPE_AGENT); }
__device__ __forceinline__ unsigned xb_add(unsigned* p, unsigned v) { return __hip_atomic_fetch_add(p, v, __ATOMIC_RELAXED, __HIP_MEMORY_SCOPE_AGENT); }
__device__ __forceinline__ unsigned xb_xcc_id() { return (unsigned)__builtin_amdgcn_s_getreg((3 << 11) | 20) & 0xFu; }
#define XB_SPIN(cond, bar) do { unsigned _sp = 0; while (cond) { __builtin_amdgcn_s_sleep(1); \
    if ((++_sp & 255u) == 0u) { if (xb_ld(&(bar)[XB_TMO])) break; if (_sp > XB_SPIN_CAP) { atomicAdd(&(bar)[XB_TMO], 1u); break; } } } } while (0)
struct XcdBarrier { unsigned* bar; unsigned x; volatile LAS unsigned* st; };
__device__ __forceinline__ XcdBarrier xcd_barrier_post(unsigned* bar, volatile LAS unsigned* st) {
    XcdBarrier b; b.bar = bar; b.x = xb_xcc_id(); b.st = st;
    if (threadIdx.x == 0) (void)xb_add(&bar[XB_XCNT(b.x)], 1u);
    return b;
}
__device__ __forceinline__ void xcd_barrier_complete(unsigned* bar, unsigned x, unsigned& nloc, unsigned& nx) {
    const unsigned G = gridDim.x * gridDim.y * gridDim.z;
    unsigned sum, cnt, mine, sp = 0u;
    for (;;) {
        sum = 0u; cnt = 0u; mine = 0u;
#pragma unroll
        for (unsigned j = 0; j < 16; ++j) { const unsigned c = xb_ld(&bar[XB_XCNT(j)]); sum += c; cnt += (c > 0u) ? 1u : 0u; mine = (j == x) ? c : mine; }
        if (sum == G) break;
        __builtin_amdgcn_s_sleep(1);
        if ((++sp & 255u) == 0u) { if (xb_ld(&bar[XB_TMO])) break; if (sp > XB_SPIN_CAP) { atomicAdd(&bar[XB_TMO], 1u); break; } }
    }
    nloc = mine > 0u ? mine : 1u; nx = cnt > 0u ? cnt : 1u;
}
__device__ __forceinline__ void xcd_barrier(const XcdBarrier& b) {
    asm volatile("s_waitcnt vmcnt(0)" ::: "memory");
    __syncthreads();
    if (threadIdx.x == 0) {
        unsigned* bar = b.bar;
        __builtin_amdgcn_s_waitcnt(0);
        unsigned nloc = b.st[0], nx = b.st[1];
        if (nloc == 0u) { xcd_barrier_complete(bar, b.x, nloc, nx); b.st[0] = nloc; b.st[1] = nx; }
        const unsigned old = xb_add(&bar[XB_XSUB(b.x)], 1u);
        const unsigned gen = old / nloc;
        if (old + 1u == (gen + 1u) * nloc) {
            __builtin_amdgcn_fence(__ATOMIC_RELEASE, "agent");
            asm volatile("s_waitcnt vmcnt(0)" ::: "memory");
            const unsigned og = xb_add(&bar[XB_TOP], 1u);
            const unsigned tg = og / nx;
            if (og + 1u == (tg + 1u) * nx) xb_add(&bar[XB_TOPGEN], 1u);
            else XB_SPIN(xb_ld(&bar[XB_TOPGEN]) == tg, bar);
            __builtin_amdgcn_fence(__ATOMIC_ACQUIRE, "agent");
            xb_add(&bar[XB_XGEN(b.x)], 1u);
            asm volatile("s_waitcnt vmcnt(0)" ::: "memory");
        } else {
            XB_SPIN(xb_ld(&bar[XB_XGEN(b.x)]) == gen, bar);
            __builtin_amdgcn_fence(__ATOMIC_ACQUIRE, "agent");
            asm volatile("s_waitcnt vmcnt(0)" ::: "memory");
        }
    }
    __syncthreads();
}

#ifndef PG8_SP2
#define PG8_SP2 1
#endif
namespace pg8 {
constexpr int BM = 256, BK = 64, HALF = 128, HTB = HALF * BK * 2, STAGE_BYTES = 8 * HTB, NXCD = 8, WGM = 4;
__host__ __device__ __forceinline__ int lds_byte(int r, int c) { const int st = (r >> 4) * 2 + (c >> 5), rr = r & 15, cc = c & 31, ob = rr * 64 + cc * 2; return st * 1024 + (ob ^ (((ob >> 9) & 1) << 5)); }
__host__ __device__ __forceinline__ void stage_rc(int b, int& R, int& C) { const int st = b / 1024, sb = b % 1024, swz = sb ^ (((sb >> 9) & 1) << 5); R = (st >> 1) * 16 + swz / 64; C = (st & 1) * 32 + (swz % 64) / 2; }
__host__ __device__ __forceinline__ int perm32(int rho) { const int n = rho >> 4, i = rho & 15; return 8 * (i >> 2) + 4 * n + (i & 3); }

struct Unit { int pm, pn, z; };
struct Gemm { const bf16_t* A; int lda; size_t azs; const bf16_t* Bt; int K; size_t bzs; };

struct StaticOrder {
    int nM, nN, nwg, G, c;
    __device__ void init(int nM_, int nN_, int G_, int c_) { nM = nM_; nN = nN_; nwg = nM * nN; G = G_; c = c_; }
    __device__ bool tile(int i, int& pm, int& pn) const {
        const long L = (long)i * G + c; if (L >= nwg) return false;
        int wgid = (int)L; { const int q = nwg / NXCD, r = nwg % NXCD, xcd = wgid % NXCD, off = wgid / NXCD; wgid = (xcd < r ? xcd * (q + 1) : r * (q + 1) + (xcd - r) * q) + off; }
        const int nig = WGM * nN, gid = wgid / nig, fm = gid * WGM, gsz = (nM - fm) < WGM ? (nM - fm) : WGM;
        pm = fm + ((wgid % nig) % gsz); pn = (wgid % nig) / gsz; return true;
    }
    __device__ bool next(int i, Unit& u) const { u.z = 0; return tile(i, u.pm, u.pn); }
};
struct Z3Order : StaticOrder {
    __device__ bool next(int i, Unit& u) const { u.z = i % 3; return tile(i / 3, u.pm, u.pn); }
};
struct MoeOrder : StaticOrder {
    int off[9];
    __device__ bool next(int i, Unit& u) const {
        if (!tile(i, u.pm, u.pn)) return false;
        const int r = u.pm * 256; int z = 0;
#pragma unroll
        for (int e = 1; e < 8; ++e) z += (r >= off[e]) ? 1 : 0;
        u.z = z; return true;
    }
};

template <class Epi, class Sched>
__device__ __forceinline__ void gemm_phase(LAS unsigned char* lds, const Gemm g, const Sched& S, const Epi& E) {
    int tid = threadIdx.x; asm volatile("" : "+v"(tid));
    const int wid = __builtin_amdgcn_readfirstlane(tid >> 6), lane = tid & 63, wr = wid >> 2, wc = wid & 3, fr = lane & 15, fq = lane >> 4;
    const int K = g.K, nt = K / BK, lda = g.lda;
    unsigned voffA[2], voffB[2];
#pragma unroll
    for (int i = 0; i < 2; ++i) { int R, C; stage_rc(tid * 16 + i * 8192, R, C); const int Rb = Epi::PERM ? ((R & ~31) + perm32(R & 31)) : R;
        voffA[i] = (unsigned)(R * lda + C) * 2u; voffB[i] = (unsigned)(Rb * K + C) * 2u; }
    const size_t kstep = (size_t)(BK * 2);
    const size_t hstepA = (size_t)HALF * lda * 2, hstepB = (size_t)HALF * K * 2;
    const unsigned ldsw = (unsigned)wid * 1024u;
    const int aoff = lds_byte(wr * 64 + fr, fq * 8), boff = lds_byte(wc * 32 + fr, fq * 8);
#define PG8_SA(b, h) (((b) * 2 + (h)) * HTB)
#define PG8_SB(b, h) ((4 + (b) * 2 + (h)) * HTB)
#define PG8_STAGE(bufoff, gbase, voff) do { _Pragma("unroll") for (int _i = 0; _i < 2; ++_i) \
        __builtin_amdgcn_global_load_lds((const unsigned*)((const char*)(gbase) + (voff)[_i]), (LAS unsigned*)(lds + (bufoff) + ldsw + _i * 8192), 16, 0, 0); } while (0)
#define PG8_LDA(dst, b, h) do { _Pragma("unroll") for (int m = 0; m < 4; ++m) _Pragma("unroll") for (int k = 0; k < 2; ++k) dst[m][k] = *(const LAS bf16x8*)(lds + PG8_SA(b, h) + aoff + m * 2048 + k * 1024); } while (0)
#define PG8_LDB(dst, b, h) do { _Pragma("unroll") for (int n = 0; n < 2; ++n) _Pragma("unroll") for (int k = 0; k < 2; ++k) dst[n][k] = *(const LAS bf16x8*)(lds + PG8_SB(b, h) + boff + n * 2048 + k * 1024); } while (0)
#define PG8_MMA(ai, bj, At, Bt) do { __builtin_amdgcn_s_setprio(1); _Pragma("unroll") for (int m = 0; m < 4; ++m) _Pragma("unroll") for (int n = 0; n < 2; ++n) _Pragma("unroll") for (int k = 0; k < 2; ++k) \
        acc[ai][bj][m][n] = __builtin_amdgcn_mfma_f32_16x16x32_bf16(Bt[n][k], At[m][k], acc[ai][bj][m][n], 0, 0, 0); __builtin_amdgcn_s_setprio(0); } while (0)
#define PG8_WAIT_V(n) asm volatile("s_waitcnt vmcnt(" #n ")" ::: "memory")
#define PG8_WAIT_L(n) asm volatile("s_waitcnt lgkmcnt(" #n ")" ::: "memory")
#define PG8_BAR __builtin_amdgcn_s_barrier()
#define PG8_SCHED __builtin_amdgcn_sched_barrier(0)
    Unit cur, nxt; int ui = 0;
    if (!S.next(0, cur)) return;
    f32x4 acc[2][2][4][2];
#pragma unroll
    for (int a = 0; a < 2; ++a)
#pragma unroll
        for (int b = 0; b < 2; ++b)
#pragma unroll
            for (int m = 0; m < 4; ++m)
#pragma unroll
                for (int n = 0; n < 2; ++n) acc[a][b][m][n] = (f32x4){0.f, 0.f, 0.f, 0.f};
    bf16x8 At[4][2], B0[2][2], B1[2][2];
    const char* cA = (const char*)(g.A + (size_t)cur.z * g.azs) + (size_t)cur.pm * 2 * hstepA;
    const char* cB = (const char*)(g.Bt + (size_t)cur.z * g.bzs) + (size_t)cur.pn * 2 * hstepB;
#if PG8_SP2
    PG8_STAGE(PG8_SB(0, 0), cB, voffB); PG8_STAGE(PG8_SB(0, 1), cB + hstepB, voffB); PG8_STAGE(PG8_SA(0, 0), cA, voffA); PG8_STAGE(PG8_SA(0, 1), cA + hstepA, voffA);
    if (wr == 1) PG8_BAR;
    PG8_WAIT_V(2); PG8_BAR;
    PG8_STAGE(PG8_SB(1, 0), cB + kstep, voffB); PG8_STAGE(PG8_SA(1, 0), cA + kstep, voffA); PG8_STAGE(PG8_SB(1, 1), cB + hstepB + kstep, voffB);
    PG8_WAIT_V(6); PG8_BAR;
#else
    PG8_STAGE(PG8_SB(0, 0), cB, voffB); PG8_STAGE(PG8_SA(0, 0), cA, voffA); PG8_STAGE(PG8_SB(0, 1), cB + hstepB, voffB); PG8_STAGE(PG8_SA(0, 1), cA + hstepA, voffA);
    if (wr == 1) PG8_BAR;
    PG8_WAIT_V(4); PG8_BAR;
    PG8_STAGE(PG8_SB(1, 0), cB + kstep, voffB); PG8_STAGE(PG8_SA(1, 0), cA + kstep, voffA); PG8_STAGE(PG8_SB(1, 1), cB + hstepB + kstep, voffB);
    PG8_WAIT_V(6); PG8_BAR;
#endif
    for (;;) {
        const bool has_next = S.next(ui + 1, nxt);
        const char* nA = has_next ? (const char*)(g.A + (size_t)nxt.z * g.azs) + (size_t)nxt.pm * 2 * hstepA : cA;
        const char* nB = has_next ? (const char*)(g.Bt + (size_t)nxt.z * g.bzs) + (size_t)nxt.pn * 2 * hstepB : cB;
        for (int t = 0; t < nt; t += 2) {
            const bool last = (t == nt - 2);
            const char* a1 = cA + (size_t)(t + 1) * kstep;
            const char* a2 = last ? nA : cA + (size_t)(t + 2) * kstep; const char* b2 = last ? nB : cB + (size_t)(t + 2) * kstep;
            const char* a3 = a2 + kstep; const char* b3 = b2 + kstep;
#if PG8_SP2
            PG8_LDB(B0, 0, 0); PG8_LDB(B1, 0, 1); PG8_SCHED; PG8_LDA(At, 0, 0); PG8_STAGE(PG8_SA(1, 1), a1 + hstepA, voffA);
            PG8_WAIT_V(8); PG8_WAIT_L(0); PG8_BAR; PG8_MMA(0, 0, At, B0); PG8_MMA(0, 1, At, B1); PG8_BAR; PG8_SCHED;
            PG8_LDA(At, 0, 1); PG8_STAGE(PG8_SB(0, 0), b2, voffB); PG8_STAGE(PG8_SB(0, 1), b2 + hstepB, voffB); PG8_STAGE(PG8_SA(0, 0), a2, voffA);
            PG8_WAIT_V(8); PG8_WAIT_L(0); PG8_BAR; PG8_MMA(1, 0, At, B0); PG8_MMA(1, 1, At, B1); PG8_BAR; PG8_SCHED;
            PG8_LDB(B0, 1, 0); PG8_LDB(B1, 1, 1); PG8_SCHED; PG8_LDA(At, 1, 0); PG8_STAGE(PG8_SA(0, 1), a2 + hstepA, voffA);
            PG8_WAIT_V(8); PG8_WAIT_L(0); PG8_BAR; PG8_MMA(0, 0, At, B0); PG8_MMA(0, 1, At, B1); PG8_BAR; PG8_SCHED;
            PG8_LDA(At, 1, 1); PG8_STAGE(PG8_SB(1, 0), b3, voffB); PG8_STAGE(PG8_SB(1, 1), b3 + hstepB, voffB); PG8_STAGE(PG8_SA(1, 0), a3, voffA);
            PG8_WAIT_V(8); PG8_WAIT_L(0); PG8_BAR; PG8_MMA(1, 0, At, B0); PG8_MMA(1, 1, At, B1); PG8_BAR; PG8_SCHED;
#else
            PG8_LDB(B0, 0, 0); PG8_SCHED; PG8_LDA(At, 0, 0); PG8_STAGE(PG8_SA(1, 1), a1 + hstepA, voffA);
            PG8_WAIT_L(8); PG8_BAR; PG8_WAIT_L(0); PG8_MMA(0, 0, At, B0); PG8_BAR; PG8_SCHED;
            PG8_LDB(B1, 0, 1); PG8_STAGE(PG8_SB(0, 0), b2, voffB);
            PG8_BAR; PG8_WAIT_L(0); PG8_MMA(0, 1, At, B1); PG8_BAR;
            PG8_LDA(At, 0, 1); PG8_STAGE(PG8_SA(0, 0), a2, voffA);
            PG8_BAR; PG8_WAIT_L(0); PG8_MMA(1, 0, At, B0); PG8_BAR; PG8_SCHED;
            PG8_STAGE(PG8_SB(0, 1), b2 + hstepB, voffB);
            PG8_WAIT_V(6); PG8_BAR; PG8_MMA(1, 1, At, B1); PG8_BAR;
            PG8_LDB(B0, 1, 0); PG8_SCHED; PG8_LDA(At, 1, 0); PG8_STAGE(PG8_SA(0, 1), a2 + hstepA, voffA);
            PG8_WAIT_L(8); PG8_BAR; PG8_WAIT_L(0); PG8_MMA(0, 0, At, B0); PG8_BAR; PG8_SCHED;
            PG8_LDB(B1, 1, 1); PG8_STAGE(PG8_SB(1, 0), b3, voffB);
            PG8_BAR; PG8_WAIT_L(0); PG8_MMA(0, 1, At, B1); PG8_BAR;
            PG8_LDA(At, 1, 1); PG8_STAGE(PG8_SA(1, 0), a3, voffA);
            PG8_BAR; PG8_WAIT_L(0); PG8_MMA(1, 0, At, B0); PG8_BAR; PG8_SCHED;
            PG8_STAGE(PG8_SB(1, 1), b3 + hstepB, voffB);
            PG8_WAIT_V(6); PG8_BAR; PG8_MMA(1, 1, At, B1); PG8_BAR;
#endif
        }
        if (wr == 0) PG8_BAR;
        E(acc, cur, wr, wc, fr, fq);
        if (!has_next) break;
#pragma unroll
        for (int a = 0; a < 2; ++a)
#pragma unroll
            for (int b = 0; b < 2; ++b)
#pragma unroll
                for (int m = 0; m < 4; ++m)
#pragma unroll
                    for (int n = 0; n < 2; ++n) acc[a][b][m][n] = (f32x4){0.f, 0.f, 0.f, 0.f};
        cur = nxt; cA = nA; cB = nB; ++ui;
        if (wr == 1) PG8_BAR;
    }
    PG8_WAIT_V(0);
    PG8_BAR;
#undef PG8_SA
#undef PG8_SB
#undef PG8_STAGE
#undef PG8_LDA
#undef PG8_LDB
#undef PG8_MMA
#undef PG8_WAIT_V
#undef PG8_WAIT_L
#undef PG8_BAR
#undef PG8_SCHED
}

#define EPI_ROWS(ai, m) (u.pm * BM + (ai) * HALF + wr * 64 + (m) * 16 + fr)

struct EpiProj {
    static constexpr bool PERM = true;
    bf16_t* O; float* tail;
    __device__ __forceinline__ void operator()(f32x4 (&acc)[2][2][4][2], const Unit& u, int wr, int wc, int fr, int fq) const {
        const int colt = wc * 32 + 8 * fq;
        if (u.pn < LDP / 256) {
#pragma unroll
            for (int ai = 0; ai < 2; ++ai)
#pragma unroll
                for (int m = 0; m < 4; ++m) { bf16_t* rowp = O + (size_t)EPI_ROWS(ai, m) * LDP + u.pn * BM + colt;
#pragma unroll
                    for (int bj = 0; bj < 2; ++bj) { const f32x4 v0 = acc[ai][bj][m][0], v1 = acc[ai][bj][m][1];
                        u32x4 w; w.x = cvt_pk_bf16(v0[0], v0[1]); w.y = cvt_pk_bf16(v0[2], v0[3]); w.z = cvt_pk_bf16(v1[0], v1[1]); w.w = cvt_pk_bf16(v1[2], v1[3]);
                        *(u32x4*)(rowp + bj * HALF) = w; } }
        } else {
#pragma unroll
            for (int ai = 0; ai < 2; ++ai)
#pragma unroll
                for (int m = 0; m < 4; ++m) { float* rowp = tail + (size_t)EPI_ROWS(ai, m) * TAILW + colt;
#pragma unroll
                    for (int bj = 0; bj < 2; ++bj) { *(f32x4*)(rowp + bj * HALF) = acc[ai][bj][m][0]; *(f32x4*)(rowp + bj * HALF + 4) = acc[ai][bj][m][1]; } }
        }
    }
};
struct EpiBf16 {
    static constexpr bool PERM = true;
    bf16_t* O; int ldc; const float* rowscale;
    __device__ __forceinline__ void operator()(f32x4 (&acc)[2][2][4][2], const Unit& u, int wr, int wc, int fr, int fq) const {
        const int colt = u.pn * BM + wc * 32 + 8 * fq;
#pragma unroll
        for (int ai = 0; ai < 2; ++ai)
#pragma unroll
            for (int m = 0; m < 4; ++m) { const int row = EPI_ROWS(ai, m); const float s = rowscale ? rowscale[row] : 1.0f; bf16_t* rowp = O + (size_t)row * ldc + colt;
#pragma unroll
                for (int bj = 0; bj < 2; ++bj) { const f32x4 v0 = acc[ai][bj][m][0] * s, v1 = acc[ai][bj][m][1] * s;
                    u32x4 w; w.x = cvt_pk_bf16(v0[0], v0[1]); w.y = cvt_pk_bf16(v0[2], v0[3]); w.z = cvt_pk_bf16(v1[0], v1[1]); w.w = cvt_pk_bf16(v1[2], v1[3]);
                    *(u32x4*)(rowp + bj * HALF) = w; } }
    }
};
struct EpiQ {
    static constexpr bool PERM = true;
    bf16_t* O; const float* rowscale; const int* positions; float qscale;
    __device__ __forceinline__ void operator()(f32x4 (&acc)[2][2][4][2], const Unit& u, int wr, int wc, int fr, int fq) const {
        const int colt = u.pn * BM + wc * 32 + 8 * fq;
        float sc[2][4], pf[2][4];
#pragma unroll
        for (int ai = 0; ai < 2; ++ai)
#pragma unroll
            for (int m = 0; m < 4; ++m) { const int row = EPI_ROWS(ai, m); sc[ai][m] = rowscale[row] * qscale; pf[ai][m] = (float)positions[row]; }
        float rf[2][4]; bool rope[2];
#pragma unroll
        for (int bj = 0; bj < 2; ++bj) { const int d = (colt + bj * HALF) % 192; rope[bj] = d >= 128;
#pragma unroll
            for (int k = 0; k < 4; ++k) rf[bj][k] = __builtin_amdgcn_exp2f(-(float)((d - 128) / 2 + k) * 0.41524101186092f) * 0.15915494309189535f; }
#pragma unroll
        for (int ai = 0; ai < 2; ++ai)
#pragma unroll
            for (int m = 0; m < 4; ++m) { const int row = EPI_ROWS(ai, m); const float s = sc[ai][m], p = pf[ai][m]; bf16_t* rowp = O + (size_t)row * 1536 + colt;
#pragma unroll
                for (int bj = 0; bj < 2; ++bj) { f32x4 v[2] = {acc[ai][bj][m][0] * s, acc[ai][bj][m][1] * s};
                    if (rope[bj]) {
#pragma unroll
                        for (int k = 0; k < 4; ++k) { const float rev = p * rf[bj][k], frc = rev - floorf(rev); const float c = __builtin_amdgcn_cosf(frc), sn = __builtin_amdgcn_sinf(frc);
                            const float a0 = v[k >> 1][2 * (k & 1)], b0 = v[k >> 1][2 * (k & 1) + 1];
                            v[k >> 1][2 * (k & 1)] = a0 * c - b0 * sn; v[k >> 1][2 * (k & 1) + 1] = b0 * c + a0 * sn; }
                    }
                    u32x4 w; w.x = cvt_pk_bf16(v[0][0], v[0][1]); w.y = cvt_pk_bf16(v[0][2], v[0][3]); w.z = cvt_pk_bf16(v[1][0], v[1][1]); w.w = cvt_pk_bf16(v[1][2], v[1][3]);
                    *(u32x4*)(rowp + bj * HALF) = w; } }
    }
};
struct EpiSwiglu {
    static constexpr bool PERM = true;
    bf16_t* O; int ldc;
    __device__ __forceinline__ void operator()(f32x4 (&acc)[2][2][4][2], const Unit& u, int wr, int wc, int fr, int fq) const {
        const int colt = u.pn * HALF + wc * 32 + 8 * fq;
#pragma unroll
        for (int ai = 0; ai < 2; ++ai)
#pragma unroll
            for (int m = 0; m < 4; ++m) { bf16_t* rowp = O + (size_t)EPI_ROWS(ai, m) * ldc + colt; float r[8];
#pragma unroll
                for (int n = 0; n < 2; ++n)
#pragma unroll
                    for (int i = 0; i < 4; ++i) { const float a = acc[ai][0][m][n][i], b = acc[ai][1][m][n][i]; r[n * 4 + i] = a * sigmoidf_(a) * b; }
                u32x4 w; w.x = cvt_pk_bf16(r[0], r[1]); w.y = cvt_pk_bf16(r[2], r[3]); w.z = cvt_pk_bf16(r[4], r[5]); w.w = cvt_pk_bf16(r[6], r[7]);
                *(u32x4*)rowp = w; }
    }
};
struct EpiBranch {
    static constexpr bool PERM = true;
    bf16_t* O; const bf16_t* proj;
    __device__ __forceinline__ void operator()(f32x4 (&acc)[2][2][4][2], const Unit& u, int wr, int wc, int fr, int fq) const {
        const int colt = u.pn * BM + wc * 32 + 8 * fq;
#pragma unroll
        for (int ai = 0; ai < 2; ++ai) {
            u32x4 gw[4][2];
#pragma unroll
            for (int m = 0; m < 4; ++m) { const bf16_t* gp = proj + (size_t)EPI_ROWS(ai, m) * LDP + PC_GATE + u.z * DM + colt;
#pragma unroll
                for (int bj = 0; bj < 2; ++bj) gw[m][bj] = *(const u32x4*)(gp + bj * HALF); }
            asm volatile("" ::: "memory");
#pragma unroll
            for (int m = 0; m < 4; ++m)
#pragma unroll
                for (int bj = 0; bj < 2; ++bj) { const u32x4 g = gw[m][bj]; const f32x4 v0 = acc[ai][bj][m][0], v1 = acc[ai][bj][m][1];
                    acc[ai][bj][m][0] = (f32x4){v0[0] * sigmoidf_(bflo(g.x)), v0[1] * sigmoidf_(bfhi(g.x)), v0[2] * sigmoidf_(bflo(g.y)), v0[3] * sigmoidf_(bfhi(g.y))};
                    acc[ai][bj][m][1] = (f32x4){v1[0] * sigmoidf_(bflo(g.z)), v1[1] * sigmoidf_(bfhi(g.z)), v1[2] * sigmoidf_(bflo(g.w)), v1[3] * sigmoidf_(bfhi(g.w))}; }
            if (u.z != 0) {
#pragma unroll
                for (int m = 0; m < 4; ++m) { const bf16_t* rowp = O + (size_t)EPI_ROWS(ai, m) * DM + colt;
#pragma unroll
                    for (int bj = 0; bj < 2; ++bj) gw[m][bj] = *(const u32x4*)(rowp + bj * HALF); }
                asm volatile("" ::: "memory");
#pragma unroll
                for (int m = 0; m < 4; ++m)
#pragma unroll
                    for (int bj = 0; bj < 2; ++bj) { const u32x4 o = gw[m][bj];
                        acc[ai][bj][m][0] += (f32x4){bflo(o.x), bfhi(o.x), bflo(o.y), bfhi(o.y)}; acc[ai][bj][m][1] += (f32x4){bflo(o.z), bfhi(o.z), bflo(o.w), bfhi(o.w)}; }
            }
#pragma unroll
            for (int m = 0; m < 4; ++m) { bf16_t* rowp = O + (size_t)EPI_ROWS(ai, m) * DM + colt;
#pragma unroll
                for (int bj = 0; bj < 2; ++bj) { const f32x4 v0 = acc[ai][bj][m][0], v1 = acc[ai][bj][m][1];
                    u32x4 w; w.x = cvt_pk_bf16(v0[0], v0[1]); w.y = cvt_pk_bf16(v0[2], v0[3]); w.z = cvt_pk_bf16(v1[0], v1[1]); w.w = cvt_pk_bf16(v1[2], v1[3]);
                    *(u32x4*)(rowp + bj * HALF) = w; } }
            asm volatile("" ::: "memory");
        }
    }
};
struct EpiResid {
    static constexpr bool PERM = false;
    const float* base; float* out;
    __device__ __forceinline__ void operator()(f32x4 (&acc)[2][2][4][2], const Unit& u, int wr, int wc, int fr, int fq) const {
        const int colt = u.pn * BM + wc * 32 + 4 * fq;
#pragma unroll
        for (int ai = 0; ai < 2; ++ai) {
            f32x4 bv[4][2][2];
#pragma unroll
            for (int m = 0; m < 4; ++m) { const size_t off = (size_t)EPI_ROWS(ai, m) * DM + colt;
#pragma unroll
                for (int bj = 0; bj < 2; ++bj)
#pragma unroll
                    for (int n = 0; n < 2; ++n) bv[m][bj][n] = *(const f32x4*)(base + off + bj * HALF + n * 16); }
            asm volatile("" ::: "memory");
#pragma unroll
            for (int m = 0; m < 4; ++m) { const size_t off = (size_t)EPI_ROWS(ai, m) * DM + colt;
#pragma unroll
                for (int bj = 0; bj < 2; ++bj)
#pragma unroll
                    for (int n = 0; n < 2; ++n) *(f32x4*)(out + off + bj * HALF + n * 16) = bv[m][bj][n] + acc[ai][bj][m][n]; }
            asm volatile("" ::: "memory");
        }
    }
};
#undef EPI_ROWS
}

namespace att {
constexpr int OFF_V = 0, SHM_V = 16384, OFF_KAUX = 32768, OFF_WS = 33280, OFF_KX = 35328, SHM_KX = 2048, OFF_K = 40960;
constexpr float L2E = 1.4426950408889634f, THR2 = 8.f * L2E;
template <int MODE> struct Cfg;
template <> struct Cfg<0> { static constexpr int DK = 64, NQ = 4; static constexpr float SCALE = 0.125f; };
template <> struct Cfg<1> { static constexpr int DK = 128, NQ = 8; static constexpr float SCALE = 0.08838834764831845f; };
template <> struct Cfg<2> { static constexpr int DK = 192, NQ = 12; static constexpr float SCALE = 0.07216878364870322f; };
static_assert(OFF_K + 2 * 64 * 192 * 2 <= RING_BYTES, "attention LDS map");

__device__ __forceinline__ int crow(int r, int hi) { return (r & 3) + 8 * (r >> 2) + 4 * hi; }
#define SBAR() __builtin_amdgcn_sched_barrier(0)
__device__ __forceinline__ void partialSM2(f32x16& p0, f32x16& p1, bool first, float& m_reg, float& alpha) {
    float pmax = p0[0];
#pragma unroll
    for (int r = 1; r < 16; ++r) pmax = fmaxf(pmax, p0[r]);
#pragma unroll
    for (int r = 0; r < 16; ++r) pmax = fmaxf(pmax, p1[r]);
    { auto rr = __builtin_amdgcn_permlane32_swap(__float_as_uint(pmax), __float_as_uint(pmax), false, false);
      pmax = fmaxf(__uint_as_float(rr[0]), __uint_as_float(rr[1])); }
    if (first) {
        m_reg = pmax; alpha = 0.f;
#pragma unroll
        for (int r = 0; r < 16; ++r) { p0[r] -= pmax; p1[r] -= pmax; }
    } else if (__builtin_expect(__all(pmax <= THR2), 1)) { alpha = 1.f; }
    else { const float delta = fmaxf(pmax, 0.f); alpha = __builtin_amdgcn_exp2f(-delta); m_reg += delta;
#pragma unroll
        for (int r = 0; r < 16; ++r) { p0[r] -= delta; p1[r] -= delta; } }
#pragma unroll
    for (int r = 0; r < 16; ++r) p0[r] = __builtin_amdgcn_exp2f(p0[r]);
}
__device__ __forceinline__ void finishSM(f32x16& p0, f32x16& p1, float alpha, float& l_reg, bf16x8& pa0, bf16x8& pa1, bf16x8& pa2, bf16x8& pa3) {
#pragma unroll
    for (int r = 0; r < 16; ++r) p1[r] = __builtin_amdgcn_exp2f(p1[r]);
    float ps = 0;
#pragma unroll
    for (int r = 0; r < 16; ++r) ps += p0[r];
#pragma unroll
    for (int r = 0; r < 16; ++r) ps += p1[r];
    { auto rr = __builtin_amdgcn_permlane32_swap(__float_as_uint(ps), __float_as_uint(ps), false, false);
      ps = __uint_as_float(rr[0]) + __uint_as_float(rr[1]); }
    l_reg = l_reg * alpha + ps;
#define PK4(P, BASE, OUT) do { unsigned a0 = cvt_pk_bf16(P[BASE + 0], P[BASE + 1]), a1 = cvt_pk_bf16(P[BASE + 2], P[BASE + 3]);   \
    unsigned b0 = cvt_pk_bf16(P[BASE + 4], P[BASE + 5]), b1 = cvt_pk_bf16(P[BASE + 6], P[BASE + 7]);                              \
    auto r0 = __builtin_amdgcn_permlane32_swap(a0, b0, false, false); auto r1 = __builtin_amdgcn_permlane32_swap(a1, b1, false, false); \
    u32x4 w = {r0[0], r1[0], r0[1], r1[1]}; OUT = *reinterpret_cast<bf16x8*>(&w); } while (0)
    PK4(p0, 0, pa0); PK4(p0, 8, pa1); PK4(p1, 0, pa2); PK4(p1, 8, pa3);
#undef PK4
}
__device__ __forceinline__ int v_st(int k, int c) { const int kk = (k & ~0xC) | ((k & 4) << 1) | ((k & 8) >> 1); return ((kk >> 3) * 4 + (c >> 5)) * 512 + ((kk & 7) * 32 + (c & 31)) * 2; }
__device__ __forceinline__ int v_rd_base(int lane) { return ((lane & 3) << 3) | (((lane >> 2) & 3) << 6) | (((lane >> 4) & 1) << 5) | (((lane >> 5) & 1) << 8); }
constexpr int v_rd_off(int d0, int ks, int half) { return d0 * 512 + ks * 4096 + half * 2048; }
template <int OFF> __device__ __forceinline__ s16x4 tr_read(int vb) {
    s16x4 r; asm volatile("ds_read_b64_tr_b16 %0, %1 offset:%2" : "=&v"(r) : "v"(vb), "i"(OFF) : "memory"); return r;
}
struct VFrag { s16x4 l0, h0, l1, h1, l2, h2, l3, h3; };
template <int D0> __device__ __forceinline__ void v_load(VFrag& f, int vb) {
    f.l0 = tr_read<v_rd_off(D0, 0, 0)>(vb); f.h0 = tr_read<v_rd_off(D0, 0, 1)>(vb); f.l1 = tr_read<v_rd_off(D0, 1, 0)>(vb); f.h1 = tr_read<v_rd_off(D0, 1, 1)>(vb);
    f.l2 = tr_read<v_rd_off(D0, 2, 0)>(vb); f.h2 = tr_read<v_rd_off(D0, 2, 1)>(vb); f.l3 = tr_read<v_rd_off(D0, 3, 0)>(vb); f.h3 = tr_read<v_rd_off(D0, 3, 1)>(vb);
}
__device__ __forceinline__ void pv_mma(f32x16& od, const VFrag& f, bf16x8 pa0, bf16x8 pa1, bf16x8 pa2, bf16x8 pa3) {
#define PK(L, H) (bf16x8){L[0], L[1], L[2], L[3], H[0], H[1], H[2], H[3]}
    od = __builtin_amdgcn_mfma_f32_32x32x16_bf16(pa0, PK(f.l0, f.h0), od, 0, 0, 0);
    od = __builtin_amdgcn_mfma_f32_32x32x16_bf16(pa1, PK(f.l1, f.h1), od, 0, 0, 0);
    od = __builtin_amdgcn_mfma_f32_32x32x16_bf16(pa2, PK(f.l2, f.h2), od, 0, 0, 0);
    od = __builtin_amdgcn_mfma_f32_32x32x16_bf16(pa3, PK(f.l3, f.h3), od, 0, 0, 0);
#undef PK
}
__device__ __forceinline__ void pv_all(f32x16 (&o)[4], int vb, bf16x8 pa0, bf16x8 pa1, bf16x8 pa2, bf16x8 pa3) {
    VFrag fa, fb;
    v_load<0>(fa, vb); v_load<1>(fb, vb);
    asm volatile("s_waitcnt lgkmcnt(8)" ::: "memory"); SBAR(); pv_mma(o[0], fa, pa0, pa1, pa2, pa3); SBAR();
    v_load<2>(fa, vb);
    asm volatile("s_waitcnt lgkmcnt(8)" ::: "memory"); SBAR(); pv_mma(o[1], fb, pa0, pa1, pa2, pa3); SBAR();
    v_load<3>(fb, vb);
    asm volatile("s_waitcnt lgkmcnt(8)" ::: "memory"); SBAR(); pv_mma(o[2], fa, pa0, pa1, pa2, pa3); SBAR();
    asm volatile("s_waitcnt lgkmcnt(0)" ::: "memory"); SBAR(); pv_mma(o[3], fb, pa0, pa1, pa2, pa3);
}

struct AttnP {
    const bf16_t* proj; const bf16_t* qm; const bf16_t* knv; const bf16_t* krot; const int* positions; const float* ckS;
    bf16_t* obuf; bf16_t* oscr;
};

template <int MODE>
__device__ __forceinline__ void attn_unit(const AttnP& P, int b, int h, int x, LAS char* lds) {
    constexpr int DK = Cfg<MODE>::DK, NQ = Cfg<MODE>::NQ, RS = DK * 2, SHM_K = 64 * RS;
    constexpr bool HAS_N = (MODE != 0);
    constexpr int RCOL = (MODE == 2) ? 128 : 0;
    constexpr bool HAS_R = (MODE != 1);
    constexpr bool HAS_AUX = (MODE != 2);
    int tid = threadIdx.x; asm volatile("" : "+v"(tid));
    const int wid = __builtin_amdgcn_readfirstlane(tid >> 6), lane = tid & 63, r32 = lane & 31, hi = lane >> 5;
    const size_t tok0 = (size_t)b * SEQ;
    const int q0w = x * 256 + wid * 32;
    const int NT = 4 * x + 4, jmax = 4 * x + (wid >> 1);
    LAS float* ws = (LAS float*)(lds + OFF_WS) + wid * 64; LAS float* li_l = ws; LAS float* al_l = ws + 32;
    const int sr = tid >> 4, sc = (tid & 15) * 8, vst0 = v_st(sr, sc), vst1 = v_st(32 + sr, sc);
    const int vb0 = (int)(uintptr_t)(lds + OFF_V) + v_rd_base(lane);
    const int rrow = tid >> 3, rcol = (tid & 7) * 8;
#define KSWZ(row, colB) ((row) * RS + ((colB) ^ (((row) & 7) << 4)))
    const int kstN0 = KSWZ(sr, sc * 2), kstN1 = KSWZ(32 + sr, sc * 2), kstR = KSWZ(rrow, (RCOL + rcol) * 2);
    int kb[4];
#pragma unroll
    for (int c = 0; c < 4; ++c) kb[c] = KSWZ(r32, c * 32 + hi * 16);
    constexpr int ldN = (MODE == 2) ? 2048 : LDP, ldR = (MODE == 2) ? 64 : LDP, ldV = (MODE == 2) ? 2048 : LDP, ldQ = (MODE == 2) ? 1536 : LDP;
    const bf16_t *srcN = nullptr, *srcR = nullptr, *srcV = nullptr, *srcQ = nullptr;
    if (MODE == 0) { srcR = P.proj + tok0 * LDP + PC_AK + h * 128; srcV = P.proj + tok0 * LDP + PC_AV + h * 128; srcQ = P.proj + tok0 * LDP + PC_AQ + h * 128; }
    if (MODE == 1) { srcN = P.proj + tok0 * LDP + PC_BK + h * 128; srcV = P.proj + tok0 * LDP + PC_BV + h * 128; srcQ = P.proj + tok0 * LDP + PC_BQ + h * 128; }
    if (MODE == 2) { srcN = P.knv + tok0 * 2048 + h * 128; srcR = P.krot + tok0 * 64; srcV = P.knv + tok0 * 2048 + 1024 + h * 128; srcQ = P.qm + tok0 * 1536 + h * 192; }
    float qaux = 0.f, slope2 = 0.f, xref = 0.f;
    if (MODE == 0) { qaux = (float)P.positions[tok0 + q0w + r32]; slope2 = exp2f(-(float)(h + 1)) * L2E; xref = (float)P.positions[tok0 + x * 256]; }
    if (MODE == 1) xref = P.ckS[((size_t)b * 8 + h) * SEQ + x * 256];
    bf16x8 qx = bf16x8{}; if (hi == 0) { qx[0] = (short)0x3F80; qx[1] = (short)0x3F80; }
    f32x16 o[4]; float m_reg, l_reg; bf16x8 qr[NQ];
    constexpr int NMAP = (MODE == 0) ? 2 : 1;
    for (int mp = 0; mp < NMAP; ++mp) {
#pragma unroll
        for (int d = 0; d < 4; ++d) o[d] = f32x16{};
        m_reg = 0.f; l_reg = 0.f;
        { const bf16_t* Qw = srcQ + (size_t)(q0w + r32) * ldQ + mp * 64 + hi * 8;
#pragma unroll
          for (int d0 = 0; d0 < NQ; ++d0) qr[d0] = *(const bf16x8*)(Qw + d0 * 16); }
        const char* gN = (const char*)srcN; const char* gR = (const char*)(srcR + mp * 64); const char* gV = (const char*)srcV;
        const unsigned oN = (unsigned)(sr * ldN + sc) * 2u, oR = (unsigned)(rrow * ldR + rcol) * 2u, oV = (unsigned)(sr * ldV + sc) * 2u;
        bf16x8 sN0, sN1, sR, sV0, sV1; float sAux = 0.f; int tload = 0;
#define SLOAD() do { if (HAS_N) { sN0 = *(const bf16x8*)(gN + oN); sN1 = *(const bf16x8*)(gN + (size_t)32 * ldN * 2 + oN); gN += (size_t)64 * ldN * 2; } \
        if (HAS_R) { sR = *(const bf16x8*)(gR + oR); gR += (size_t)64 * ldR * 2; } \
        sV0 = *(const bf16x8*)(gV + oV); sV1 = *(const bf16x8*)(gV + (size_t)32 * ldV * 2 + oV); gV += (size_t)64 * ldV * 2; \
        if (HAS_AUX && tid < 64) { if (MODE == 0) sAux = (float)P.positions[tok0 + tload * 64 + tid]; else sAux = P.ckS[((size_t)b * 8 + h) * SEQ + tload * 64 + tid]; } \
        ++tload; } while (0)
#define SWRITE(bf) do { LAS char* Kb = lds + OFF_K + (bf) * SHM_K; LAS char* Vb = lds + OFF_V + (bf) * SHM_V; \
        if (HAS_N) { *(LAS bf16x8*)(Kb + kstN0) = sN0; *(LAS bf16x8*)(Kb + kstN1) = sN1; } if (HAS_R) *(LAS bf16x8*)(Kb + kstR) = sR; \
        *(LAS bf16x8*)(Vb + vst0) = sV0; *(LAS bf16x8*)(Vb + vst1) = sV1; \
        if (HAS_AUX && tid < 64) { const float val = (MODE == 0) ? slope2 * (sAux - xref) : (xref - sAux) * L2E; const unsigned vh = cvt_pk_bf16(val, 0.f) & 0xffffu; \
            const unsigned vl = cvt_pk_bf16(val - __uint_as_float(vh << 16), 0.f) & 0xffffu; LAS u32x4* kx = (LAS u32x4*)(lds + OFF_KX + (bf) * SHM_KX + tid * 32); \
            kx[0] = (u32x4){vh | (vl << 16), 0u, 0u, 0u}; kx[1] = (u32x4){0u, 0u, 0u, 0u}; \
            if (MODE == 0) ((LAS float*)(lds + OFF_KAUX))[(bf) * 64 + tid] = sAux; } } while (0)
        __syncthreads();
        SLOAD(); SWRITE(0); SLOAD();
        for (int j = 0; j < NT; ++j) {
            __syncthreads();
            const int bf = j & 1;
            if (j <= jmax) {
                const bool first = (j == 0);
                f32x16 p0, p1; { const float ini = first ? 0.f : -m_reg;
#pragma unroll
                  for (int r = 0; r < 16; ++r) { p0[r] = ini; p1[r] = ini; } }
                {
                  const LAS char* Kb = lds + OFF_K + bf * SHM_K;
                  const LAS char* kx = lds + OFF_KX + bf * SHM_KX + r32 * 32 + hi * 16;
                  constexpr int NS = NQ + (HAS_AUX ? 1 : 0);
                  bf16x8 ra[3], rb[3];
#define QLOAD(s_) do { if ((s_) < NQ) { const LAS char* kp = Kb + kb[(s_) & 3] + ((s_) >> 2) * 128; ra[(s_) % 3] = *(const LAS bf16x8*)kp; rb[(s_) % 3] = *(const LAS bf16x8*)(kp + 32 * RS); } \
                      else { ra[(s_) % 3] = *(const LAS bf16x8*)kx; rb[(s_) % 3] = *(const LAS bf16x8*)(kx + 1024); } } while (0)
                  QLOAD(0); QLOAD(1);
#pragma unroll
                  for (int st = 0; st < NS; ++st) {
                      if (st + 2 < NS) QLOAD(st + 2);
                      SBAR();
                      const bf16x8 qb = (st < NQ) ? qr[st < NQ ? st : 0] : qx;
                      p0 = __builtin_amdgcn_mfma_f32_32x32x16_bf16(ra[st % 3], qb, p0, 0, 0, 0);
                      p1 = __builtin_amdgcn_mfma_f32_32x32x16_bf16(rb[st % 3], qb, p1, 0, 0, 0);
                      SBAR(); }
#undef QLOAD
                }
                if (MODE == 0 && j == jmax) {
                    const LAS float* ka = (const LAS float*)(lds + OFF_KAUX) + bf * 64 + 4 * hi; const float s2 = 2.f * slope2;
#pragma unroll
                    for (int g = 0; g < 4; ++g) { const f32x4 a0 = *(const LAS f32x4*)(ka + 8 * g), a1 = *(const LAS f32x4*)(ka + 32 + 8 * g);
#pragma unroll
                        for (int i = 0; i < 4; ++i) { p0[4 * g + i] = fmaf(s2, fminf(qaux - a0[i], 0.f), p0[4 * g + i]); p1[4 * g + i] = fmaf(s2, fminf(qaux - a1[i], 0.f), p1[4 * g + i]); } }
                }
                if (MODE == 1 && j == jmax) {
                    const int rowt = q0w - 64 * j + r32;
#pragma unroll
                    for (int r = 0; r < 16; ++r) { const int kk = crow(r, hi); if (kk > rowt) p0[r] = -__builtin_inff(); if (kk + 32 > rowt) p1[r] = -__builtin_inff(); }
                }
                float alpha; partialSM2(p0, p1, first, m_reg, alpha);
                if (__any(alpha < 1.f)) { if (hi == 0) al_l[r32] = alpha; LDS_WAIT();
#pragma unroll
                    for (int d = 0; d < 4; ++d)
#pragma unroll
                        for (int r = 0; r < 16; ++r) o[d][r] *= al_l[crow(r, hi)]; }
                bf16x8 pa0, pa1, pa2, pa3; finishSM(p0, p1, alpha, l_reg, pa0, pa1, pa2, pa3); SBAR();
                const int vb = vb0 + bf * SHM_V;
                pv_all(o, vb, pa0, pa1, pa2, pa3);
            }
            if (j + 1 < NT) { SWRITE(bf ^ 1); if (j + 2 < NT) SLOAD(); }
        }
#undef SLOAD
#undef SWRITE
        if (hi == 0) li_l[r32] = l_reg; LDS_WAIT();
        float rli[16];
#pragma unroll
        for (int r = 0; r < 16; ++r) rli[r] = __builtin_amdgcn_rcpf(li_l[crow(r, hi)]);
        LDS_WAIT();
        bf16_t* Ob = (MODE == 0) ? P.oscr + (tok0 + q0w) * 2048 + mp * 1024 + h * 128 : P.obuf + (tok0 + q0w) * 3072 + MODE * 1024 + h * 128;
        constexpr int LDO = (MODE == 0) ? 2048 : 3072;
        int hi4 = hi * 4; asm volatile("" : "+v"(hi4));
#pragma unroll
        for (int r = 0; r < 16; ++r) { const unsigned voff = (unsigned)(((r & 3) + 8 * (r >> 2) + hi4) * LDO + r32) * 2u;
#pragma unroll
            for (int d = 0; d < 4; ++d) *(bf16_t*)((char*)Ob + voff + d * 64) = (bf16_t)(cvt_pk_bf16(o[d][r] * rli[r], 0.f) & 0xffffu); }
    }
#undef KSWZ
}
#undef SBAR
}

__device__ __forceinline__ int wsrc_in(int n) {
    if (n < 6144) return n;
    if (n < 7168) return 6152 + (n - 6144);
    if (n < 13312) return 7240 + (n - 7168);
    if (n < 13376) { const int j = n - 13312; return 7176 + (j & 1) * 32 + (j >> 1); }
    if (n < 13384) return 6144 + (n - 13376);
    return -1;
}
__device__ __forceinline__ int wsrc_uq(int n) { const int h = n / 192, d = n % 192; if (d < 128) return n; const int j = d - 128; return h * 192 + 128 + (j & 1) * 32 + (j >> 1); }
template <int KIND>
__device__ __forceinline__ void wconv_job(const float* W, const float* W2, int ldw, int K, int ndst, int nz, size_t wzs, size_t bzs, bf16_t* Bt, const float* ks, int kzs, LAS float* scr, int vcu, int G, int tid) {
    const int lane = tid & 63, wave = __builtin_amdgcn_readfirstlane(tid >> 6);
    const int nkb = K / 64, nnb = ndst / 64, per = nkb * nnb, ntile = per * nz, stride = G * 8;
    LAS char* img = (LAS char*)scr + wave * 9216;
    float v[64]; int src = 0; float cs = 1.0f;
#define WC_LOAD(t_) do { const int z_ = (t_) / per, r_ = (t_) % per, kb_ = r_ / nnb, nb_ = r_ % nnb, nd_ = nb_ * 64 + lane; \
        const float* Wp_ = W + (size_t)z_ * wzs; src = nd_; \
        if (KIND == 1) { src = wsrc_in(nd_); cs = (nd_ < 1024) ? att::Cfg<0>::SCALE * att::L2E : ((nd_ >= PC_BQ && nd_ < PC_BK) ? att::Cfg<1>::SCALE * att::L2E : 1.0f); }     \
        if (KIND == 2) src = wsrc_uq(nd_); \
        if (KIND == 3) { Wp_ = (((nb_ >> 1) & 1) ? W2 : W) + (size_t)z_ * wzs; src = (nb_ >> 2) * 128 + (nb_ & 1) * 64 + lane; } \
        const float* col_ = Wp_ + (size_t)(kb_ * 64) * ldw + (src >= 0 ? src : 0); \
        _Pragma("unroll") for (int i = 0; i < 64; ++i) v[i] = __builtin_nontemporal_load(col_ + (size_t)i * ldw); } while (0)
    int t = vcu * 8 + wave;
    if (t < ntile) WC_LOAD(t);
    while (t < ntile) {
        const int z = t / per, r = t % per, kb = r / nnb, nb = r % nnb, k0 = kb * 64, n0 = nb * 64;
        if (src < 0) {
#pragma unroll
            for (int i = 0; i < 64; ++i) v[i] = 0.f;
        }
        if (KIND == 1) {
#pragma unroll
            for (int i = 0; i < 64; ++i) v[i] *= cs; }
        if (ks) { const float* ksp = ks + (size_t)z * kzs + k0;
#pragma unroll
            for (int i = 0; i < 64; ++i) v[i] *= ksp[i]; }
#pragma unroll
        for (int c = 0; c < 8; ++c) { u32x4 o; o.x = cvt_pk_bf16(v[8 * c], v[8 * c + 1]); o.y = cvt_pk_bf16(v[8 * c + 2], v[8 * c + 3]); o.z = cvt_pk_bf16(v[8 * c + 4], v[8 * c + 5]); o.w = cvt_pk_bf16(v[8 * c + 6], v[8 * c + 7]);
            *(LAS u32x4*)(img + lane * 144 + c * 16) = o; }
        const int tn = t + stride;
        if (tn < ntile) WC_LOAD(tn);
        asm volatile("s_waitcnt lgkmcnt(0)" ::: "memory");
        bf16_t* dst = Bt + (size_t)z * bzs + (size_t)(n0 + (lane >> 3)) * K + k0 + (lane & 7) * 8;
#pragma unroll
        for (int i = 0; i < 8; ++i) { const u32x4 o = *(const LAS u32x4*)(img + ((lane >> 3) + 8 * i) * 144 + (lane & 7) * 16); *(u32x4*)(dst + (size_t)(8 * i) * K) = o; }
        asm volatile("s_waitcnt lgkmcnt(0)" ::: "memory");
        t = tn;
    }
#undef WC_LOAD
}
__device__ __forceinline__ void rmsnorm_rows(const float* x, const float* g, bf16_t* out, int vcu, int G, int wave, int lane) {
    f32x4 gv[8];
#pragma unroll
    for (int j = 0; j < 8; ++j) gv[j] = *((const f32x4*)g + lane + 64 * j);
    for (int m = vcu * 8 + wave; m < T; m += G * 8) {
        const f32x4* xr = (const f32x4*)(x + (size_t)m * DM) + lane; f32x4 v[8]; float s = 0.f;
#pragma unroll
        for (int j = 0; j < 8; ++j) { v[j] = xr[64 * j]; s += (v[j][0] * v[j][0] + v[j][1] * v[j][1]) + (v[j][2] * v[j][2] + v[j][3] * v[j][3]); }
        const float rstd = __builtin_amdgcn_rsqf(wave_sum(s) * (1.0f / DM) + NORM_EPS);
        u32x2* o8 = (u32x2*)(out + (size_t)m * DM) + lane;
#pragma unroll
        for (int j = 0; j < 8; ++j) { const f32x4 y = v[j] * rstd * gv[j]; u32x2 w; w.x = cvt_pk_bf16(y[0], y[1]); w.y = cvt_pk_bf16(y[2], y[3]); o8[64 * j] = w; }
    }
}
__device__ __forceinline__ void prep_phase(const bf16_t* proj, const float* tail, const int* positions, const float* fbias,
                                           float* rstdq, float* rstdkv, bf16_t* krot, float* ckS, LAS float* scr, int vcu, int G, int tid, int wave, int lane) {
    const float rfreq = __builtin_amdgcn_exp2f(-(float)(lane & 31) * 0.41524101186092f) * 0.15915494309189535f;
    for (int m = vcu * 8 + wave; m < T; m += G * 8) {
        const u32x4 a = *(const u32x4*)(proj + (size_t)m * LDP + PC_CQ + 8 * lane), b = *(const u32x4*)(proj + (size_t)m * LDP + PC_CKV + 8 * lane);
        float sa = 0.f, sb = 0.f;
#pragma unroll
        for (int i = 0; i < 4; ++i) { const float a0 = bflo(a[i]), a1 = bfhi(a[i]), b0 = bflo(b[i]), b1 = bfhi(b[i]); sa += a0 * a0 + a1 * a1; sb += b0 * b0 + b1 * b1; }
        sa = wave_sum(sa); sb = wave_sum(sb);
        if (lane == 0) { rstdq[m] = __builtin_amdgcn_rsqf(sa * (1.0f / 512.0f) + NORM_EPS); rstdkv[m] = __builtin_amdgcn_rsqf(sb * (1.0f / 512.0f) + NORM_EPS); }
        if (lane < 32) { const f32x2 xv = *((const f32x2*)(tail + (size_t)m * TAILW) + lane); const float rev = (float)positions[m] * rfreq, frc = rev - floorf(rev);
            const float cs = __builtin_amdgcn_cosf(frc), sn = __builtin_amdgcn_sinf(frc);
            ((unsigned*)(krot + (size_t)m * 64))[lane] = cvt_pk_bf16(xv.x * cs - xv.y * sn, xv.y * cs + xv.x * sn); }
    }
    for (int u = vcu; u < NB * 8; u += G) {
        const int b = u >> 3, h = u & 7; const float fb = fbias[h]; float v[8]; float run = 0.f;
#pragma unroll
        for (int i = 0; i < 8; ++i) { const float f = tail[((size_t)b * SEQ + tid * 8 + i) * TAILW + 64 + h] + fb;
            const float ls = -(fmaxf(-f, 0.f) + log1pf(__expf(-fabsf(f)))); run += ls; v[i] = run; }
        __syncthreads();
        scr[tid] = run; __syncthreads();
        for (int o = 1; o < 512; o <<= 1) { float t = (tid >= o) ? scr[tid - o] : 0.f; __syncthreads(); scr[tid] += t; __syncthreads(); }
        const float excl = scr[tid] - run;
#pragma unroll
        for (int i = 0; i < 8; ++i) ckS[((size_t)b * 8 + h) * SEQ + tid * 8 + i] = excl + v[i];
        __syncthreads();
    }
}

__device__ __forceinline__ void diff_combine(const bf16_t* oscr, const float* g, float lam, float out_scale, bf16_t* obuf, int vcu, int G, int wave, int lane) {
    f32x4 g0 = *(const f32x4*)(g + (lane & 15) * 8), g1 = *(const f32x4*)(g + (lane & 15) * 8 + 4);
    for (int m = vcu * 8 + wave; m < T; m += G * 8) {
#pragma unroll
        for (int c = 0; c < 2; ++c) {
            const u32x4 a = *(const u32x4*)(oscr + (size_t)m * 2048 + c * 512 + lane * 8), b = *(const u32x4*)(oscr + (size_t)m * 2048 + 1024 + c * 512 + lane * 8);
            float v[8]; float ss = 0.f;
#pragma unroll
            for (int i = 0; i < 4; ++i) { v[2 * i] = bflo(a[i]) - lam * bflo(b[i]); v[2 * i + 1] = bfhi(a[i]) - lam * bfhi(b[i]); ss += v[2 * i] * v[2 * i] + v[2 * i + 1] * v[2 * i + 1]; }
            ss = row_sum16(ss);
            const float rs = __builtin_amdgcn_rsqf(ss * (1.0f / 128.0f) + NORM_EPS) * out_scale;
            u32x4 w; w.x = cvt_pk_bf16(v[0] * rs * g0[0], v[1] * rs * g0[1]); w.y = cvt_pk_bf16(v[2] * rs * g0[2], v[3] * rs * g0[3]);
            w.z = cvt_pk_bf16(v[4] * rs * g1[0], v[5] * rs * g1[1]); w.w = cvt_pk_bf16(v[6] * rs * g1[2], v[7] * rs * g1[3]);
            *(u32x4*)(obuf + (size_t)m * 3072 + c * 512 + lane * 8) = w;
        }
    }
}

#define LADD(p, v) (void)__hip_atomic_fetch_add((p), (v), __ATOMIC_RELAXED, __HIP_MEMORY_SCOPE_WORKGROUP)
__device__ __forceinline__ void moe_route(const float* x, const float* g, const float* router_w, int* route, float* rstd2, unsigned* cnt, LAS unsigned char* lds, int vcu, int G, int tid, int wave, int lane) {
    LAS float* Wt = (LAS float*)lds; LAS unsigned* elist = (LAS unsigned*)(lds + 65536);
    for (int idx = tid; idx < DM * 8; idx += 512) Wt[(idx & 7) * DM + (idx >> 3)] = router_w[idx];
    __syncthreads();
    const int TPW = (T + G - 1) / G, t0 = vcu * TPW, t1 = (t0 + TPW < T) ? t0 + TPW : T;
    f32x4 gv[8];
#pragma unroll
    for (int j = 0; j < 8; ++j) gv[j] = *((const f32x4*)g + lane + 64 * j);
    for (int m = t0 + wave; m < t1; m += 8) {
        const f32x4* xr = (const f32x4*)(x + (size_t)m * DM) + lane; f32x4 v[8]; float s = 0.f;
#pragma unroll
        for (int j = 0; j < 8; ++j) { v[j] = xr[64 * j]; s += (v[j][0] * v[j][0] + v[j][1] * v[j][1]) + (v[j][2] * v[j][2] + v[j][3] * v[j][3]); }
        const float rstd = __builtin_amdgcn_rsqf(wave_sum(s) * (1.0f / DM) + NORM_EPS);
#pragma unroll
        for (int j = 0; j < 8; ++j) v[j] = v[j] * rstd * gv[j];
        float lg[8];
#pragma unroll
        for (int e = 0; e < 8; ++e) { float a = 0.f;
#pragma unroll
            for (int j = 0; j < 8; ++j) { const f32x4 w = *((const LAS f32x4*)(Wt + e * DM) + lane + 64 * j); a += (v[j][0] * w[0] + v[j][1] * w[1]) + (v[j][2] * w[2] + v[j][3] * w[3]); }
            lg[e] = wave_sum(a); }
        int e0 = 0; float v0 = lg[0];
#pragma unroll
        for (int e = 1; e < 8; ++e) if (lg[e] > v0) { v0 = lg[e]; e0 = e; }
        int e1 = -1; float v1 = -__builtin_inff();
#pragma unroll
        for (int e = 0; e < 8; ++e) if (e != e0 && lg[e] > v1) { v1 = lg[e]; e1 = e; }
        const float ex = __expf(v1 - v0), w0 = 1.0f / (1.0f + ex), w1 = ex * w0;
        if (lane == 0) { i32x4 r; r.x = e0; r.y = e1; r.z = __float_as_int(w0); r.w = __float_as_int(w1); *((i32x4*)route + m) = r; rstd2[m] = rstd; elist[m - t0] = (unsigned)e0 | ((unsigned)e1 << 8); }
    }
    __syncthreads();
    if (tid < 8) { unsigned c = 0; for (int i = 0; i < t1 - t0; ++i) { const unsigned w = elist[i]; c += ((w & 255u) == (unsigned)tid) + ((w >> 8) == (unsigned)tid); } cnt[vcu * 8 + tid] = c; }
    __syncthreads();
}
__device__ __forceinline__ void moe_gather(const float* x, const float* g, const int* route, const float* rstd2, const unsigned* cnt, int* slots, int* moe_off, bf16_t* hs,
                                           LAS unsigned char* lds, int vcu, int G, int tid, int wave, int lane) {
    LAS unsigned* tot = (LAS unsigned*)lds; LAS unsigned* base = tot + 8; LAS int* offp = (LAS int*)(tot + 16); LAS unsigned* elist = tot + 32; LAS int* slotl = (LAS int*)(tot + 32 + 1024);
    if (tid < 16) tot[tid] = 0u;
    __syncthreads();
    for (int w = tid; w < G; w += 512) { const u32x4 c0 = *((const u32x4*)cnt + 2 * w), c1 = *((const u32x4*)cnt + 2 * w + 1);
#pragma unroll
        for (int e = 0; e < 4; ++e) { LADD(&tot[e], c0[e]); LADD(&tot[4 + e], c1[e]); if (w < vcu) { LADD(&base[e], c0[e]); LADD(&base[4 + e], c1[e]); } } }
    __syncthreads();
    if (tid == 0) { int o = 0; for (int e = 0; e < 8; ++e) { offp[e] = o; o += (int)((tot[e] + 255u) & ~255u); } offp[8] = o; }
    __syncthreads();
    if (vcu == 0 && tid < 9) moe_off[tid] = offp[tid];
    const int TPW = (T + G - 1) / G, t0 = vcu * TPW, t1 = (t0 + TPW < T) ? t0 + TPW : T, nt = t1 - t0;
    for (int i = tid; i < nt; i += 512) { const i32x4 r = *((const i32x4*)route + t0 + i); elist[i] = (unsigned)r.x | ((unsigned)r.y << 8); }
    __syncthreads();
    for (int i = tid; i < nt; i += 512) { const unsigned w = elist[i], e0 = w & 255u, e1 = w >> 8; int r0 = 0, r1 = 0;
        for (int k = 0; k < i; ++k) { const unsigned q = elist[k], a = q & 255u, b = q >> 8; r0 += (a == e0) + (b == e0); r1 += (a == e1) + (b == e1); }
        const int s0 = offp[e0] + (int)base[e0] + r0, s1 = offp[e1] + (int)base[e1] + r1;
        slotl[2 * i] = s0; slotl[2 * i + 1] = s1; slots[2 * (t0 + i)] = s0; slots[2 * (t0 + i) + 1] = s1; }
    __syncthreads();
    f32x4 gv[8];
#pragma unroll
    for (int j = 0; j < 8; ++j) gv[j] = *((const f32x4*)g + lane + 64 * j);
    for (int m = t0 + wave; m < t1; m += 8) {
        const f32x4* xr = (const f32x4*)(x + (size_t)m * DM) + lane; const float rstd = rstd2[m]; const int s0 = slotl[2 * (m - t0)], s1 = slotl[2 * (m - t0) + 1];
        u32x2* o0 = (u32x2*)(hs + (size_t)s0 * DM) + lane; u32x2* o1 = (u32x2*)(hs + (size_t)s1 * DM) + lane;
#pragma unroll
        for (int j = 0; j < 8; ++j) { const f32x4 y = xr[64 * j] * rstd * gv[j]; u32x2 w; w.x = cvt_pk_bf16(y[0], y[1]); w.y = cvt_pk_bf16(y[2], y[3]); o0[64 * j] = w; o1[64 * j] = w; }
    }
    __syncthreads();
}
__device__ __forceinline__ void final_phase(const float* x, const bf16_t* ys, const int* route, const int* slots, const float* g, float* out, int vcu, int G, int wave, int lane) {
    f32x4 gv[8];
#pragma unroll
    for (int j = 0; j < 8; ++j) gv[j] = *((const f32x4*)g + lane + 64 * j);
    for (int m = vcu * 8 + wave; m < T; m += G * 8) {
        const i32x4 r = *((const i32x4*)route + m); const float w0 = __int_as_float(r.z), w1 = __int_as_float(r.w); const int s0 = slots[2 * m], s1 = slots[2 * m + 1];
        const f32x4* xr = (const f32x4*)(x + (size_t)m * DM) + lane; const u32x2* y0 = (const u32x2*)(ys + (size_t)s0 * DM) + lane; const u32x2* y1 = (const u32x2*)(ys + (size_t)s1 * DM) + lane;
        f32x4 v[8]; float s = 0.f;
#pragma unroll
        for (int j = 0; j < 8; ++j) { const u32x2 a = y0[64 * j], b = y1[64 * j]; f32x4 t = xr[64 * j];
            t[0] += w0 * bflo(a.x) + w1 * bflo(b.x); t[1] += w0 * bfhi(a.x) + w1 * bfhi(b.x); t[2] += w0 * bflo(a.y) + w1 * bflo(b.y); t[3] += w0 * bfhi(a.y) + w1 * bfhi(b.y);
            v[j] = t; s += (t[0] * t[0] + t[1] * t[1]) + (t[2] * t[2] + t[3] * t[3]); }
        const float rstd = __builtin_amdgcn_rsqf(wave_sum(s) * (1.0f / DM) + NORM_EPS);
        f32x4* o = (f32x4*)(out + (size_t)m * DM) + lane;
#pragma unroll
        for (int j = 0; j < 8; ++j) o[64 * j] = v[j] * rstd * gv[j];
    }
}

constexpr int NWAVES = 8, PH_PER_LAYER = 13, NPH = 1 + 2 * PH_PER_LAYER;
struct Args {
    const float* x; const int* positions; const float* attn_norm_g; const float* w_in; const float* diff_lambda; const float* diff_subln_g; const float* fox_bias;
    const float* q_norm_g; const float* kv_norm_g; const float* w_uq; const float* w_uk; const float* w_uv; const float* w_branch; const float* w_out; const float* ffn_norm_g;
    const float* dense_w1; const float* dense_w3; const float* dense_w2; const float* router_w; const float* expert_w1; const float* expert_w3; const float* expert_w2; const float* final_norm_g;
    float* out; unsigned char* ws; int ph_lo, ph_hi, li, pad;
};
__host__ __device__ constexpr bool phase_exists(int k) {
    if (k == 0) return true;
    const int l = (k - 1) / PH_PER_LAYER, p = (k - 1) % PH_PER_LAYER;
    if (l == 0) return p >= 1 && p <= 10;
    return true;
}

typedef const __attribute__((address_space(4))) Args* KArgs;
__device__ __forceinline__ KArgs kargs() { KArgs p = (KArgs)__builtin_amdgcn_kernarg_segment_ptr(); asm volatile("" : "+s"(p)); return p; }

__global__ void __launch_bounds__(NWAVES * 64, 2) mega_fwd(Args a) {
    extern __shared__ __attribute__((aligned(16))) unsigned char lds_raw[];
    LAS unsigned char* lds = (LAS unsigned char*)lds_raw;
    const int G = gridDim.x, bx = blockIdx.x, vcu = (G % 8 == 0) ? (bx % 8) * (G / 8) + bx / 8 : bx;
    volatile LAS unsigned* MISC = (volatile LAS unsigned*)(lds + MISC_OFF);
    for (int u = threadIdx.x; u < (LDS_BYTES - LDSCTL_OFF) / 4; u += NWAVES * 64) ((LAS unsigned*)(lds + LDSCTL_OFF))[u] = 0u;
    __syncthreads();
    XcdBarrier bar = xcd_barrier_post((unsigned*)(a.ws + WS_CTL) + CW_BAR + a.li * XCD_BAR_WORDS, MISC + 8);
    const int lo = a.ph_lo, hi = a.ph_hi;
#ifndef ATT_MODES
#define ATT_MODES 7
#endif
#ifndef PH_ENABLE
#define PH_ENABLE 0xFFFFFFFFu
#endif
#define IN(k) (lo <= (k) && (k) < hi)
#define EN(kind) (((PH_ENABLE) >> (kind)) & 1u)
#ifndef PROBE_REP_MASK
#define PROBE_REP_MASK 0u
#endif
#define REPS(kind) for (int rep_ = 0; rep_ < ((((PROBE_REP_MASK) >> (kind)) & 1u) ? PROBE_REP_N : 1); ++rep_)
#ifndef PROBE_REP_N
#define PROBE_REP_N 2
#endif
#ifndef PROBE_BAR2
#define PROBE_BAR2 0
#endif
#define SEAM(k) do { if (IN(k) && (k) + 1 < hi) { xcd_barrier(bar); if (PROBE_BAR2) xcd_barrier(bar); } } while (0)
#define PHASE_LOCALS KArgs A = kargs(); unsigned char* ws = A->ws; int tid = threadIdx.x; asm volatile("" : "+v"(tid)); const int lane = tid & 63, wave = __builtin_amdgcn_readfirstlane(tid >> 6); (void)lane; (void)wave; (void)ws
#define WSP(T_, off) ((T_*)(ws + (off)))

    if (EN(0) && IN(0)) REPS(0) {
        PHASE_LOCALS; LAS float* scr = (LAS float*)lds;
        wconv_job<1>(A->w_in, nullptr, N_IN_SRC, DM, NIN, 2, (size_t)DM * N_IN_SRC, (size_t)NIN * DM, WSP(bf16_t, WS_WIN), nullptr, 0, scr, vcu, G, tid);
        wconv_job<2>(A->w_uq, nullptr, 1536, 512, 1536, 2, (size_t)512 * 1536, (size_t)1536 * 512, WSP(bf16_t, WS_WUQ), A->q_norm_g, 512, scr, vcu, G, tid);
        wconv_job<0>(A->w_uk, nullptr, 1024, 512, 1024, 2, (size_t)512 * 1024, (size_t)2048 * 512, WSP(bf16_t, WS_WUKV), A->kv_norm_g, 512, scr, vcu, G, tid);
        wconv_job<0>(A->w_uv, nullptr, 1024, 512, 1024, 2, (size_t)512 * 1024, (size_t)2048 * 512, WSP(bf16_t, WS_WUKV) + (size_t)1024 * 512, A->kv_norm_g, 512, scr, vcu, G, tid);
        wconv_job<0>(A->w_branch, nullptr, DM, 1024, DM, 6, (size_t)1024 * DM, (size_t)DM * 1024, WSP(bf16_t, WS_WBR), nullptr, 0, scr, vcu, G, tid);
        wconv_job<0>(A->w_out, nullptr, DM, DM, DM, 2, (size_t)DM * DM, (size_t)DM * DM, WSP(bf16_t, WS_WOUT), nullptr, 0, scr, vcu, G, tid);
        wconv_job<3>(A->dense_w1, A->dense_w3, DFF, DM, 2 * DFF, 1, 0, 0, WSP(bf16_t, WS_WD13), nullptr, 0, scr, vcu, G, tid);
        wconv_job<0>(A->dense_w2, nullptr, DM, DFF, DM, 1, 0, 0, WSP(bf16_t, WS_WD2), nullptr, 0, scr, vcu, G, tid);
        rmsnorm_rows(A->x, A->attn_norm_g, WSP(bf16_t, WS_H), vcu, G, wave, lane);
    }
    SEAM(0);

    for (int l = 0; l < DEPTH; ++l) {
        const int pb = 1 + l * PH_PER_LAYER;
        if (hi <= pb || lo >= pb + PH_PER_LAYER) continue;

        if (l > 0) { if (EN(1) && IN(pb + 0)) REPS(1) { PHASE_LOCALS; rmsnorm_rows(A->out, A->attn_norm_g + l * DM, WSP(bf16_t, WS_H), vcu, G, wave, lane); } SEAM(pb + 0); }

        if (EN(2) && IN(pb + 1)) REPS(2) {
            PHASE_LOCALS;
            pg8::Gemm g{WSP(bf16_t, WS_H), DM, 0, WSP(bf16_t, WS_WIN + (size_t)l * SZ_WIN), DM, 0}; pg8::StaticOrder S; S.init(T / 256, NIN / 256, G, bx);
            pg8::EpiProj E{WSP(bf16_t, WS_PROJ), WSP(float, WS_TAIL)};
            pg8::gemm_phase(lds, g, S, E);
        }
        SEAM(pb + 1);

        if (EN(3) && IN(pb + 2)) REPS(3) { PHASE_LOCALS;
            prep_phase(WSP(bf16_t, WS_PROJ), WSP(float, WS_TAIL), A->positions, A->fox_bias + l * 8, WSP(float, MS_RSTDQ), WSP(float, MS_RSTDKV), WSP(bf16_t, WS_KROT), WSP(float, MS_CKS),
                       (LAS float*)lds, vcu, G, tid, wave, lane); }
        SEAM(pb + 2);

        if (EN(4) && IN(pb + 3)) REPS(4) {
            { PHASE_LOCALS;
              pg8::Gemm g{WSP(bf16_t, WS_PROJ) + PC_CQ, LDP, 0, WSP(bf16_t, WS_WUQ + (size_t)l * SZ_WUQ), 512, 0}; pg8::StaticOrder S; S.init(T / 256, 1536 / 256, G, bx);
              pg8::EpiQ E{WSP(bf16_t, WS_QM), WSP(float, MS_RSTDQ), A->positions, att::Cfg<2>::SCALE * att::L2E};
              pg8::gemm_phase(lds, g, S, E); }
            { PHASE_LOCALS;
              pg8::Gemm g{WSP(bf16_t, WS_PROJ) + PC_CKV, LDP, 0, WSP(bf16_t, WS_WUKV + (size_t)l * SZ_WUKV), 512, 0}; pg8::StaticOrder S; S.init(T / 256, 2048 / 256, G, bx);
              pg8::EpiBf16 E{WSP(bf16_t, WS_KNV), 2048, WSP(float, MS_RSTDKV)};
              pg8::gemm_phase(lds, g, S, E); }
        }
        SEAM(pb + 3);

        const float lam_init = (l == 0) ? 0.2f : 0.35550906759f;
        if (EN(5) && IN(pb + 4)) REPS(5) {
            PHASE_LOCALS;
            att::AttnP P{WSP(bf16_t, WS_PROJ), WSP(bf16_t, WS_QM), WSP(bf16_t, WS_KNV), WSP(bf16_t, WS_KROT), A->positions, WSP(float, MS_CKS), WSP(bf16_t, WS_OBUF), WSP(bf16_t, WS_MERGED)};
            if (ATT_MODES & 1) for (int u = vcu; u < 512; u += G) for (int hf = 0; hf < 2; ++hf) att::attn_unit<0>(P, u >> 6, (u >> 3) & 7, hf ? 15 - (u & 7) : (u & 7), (LAS char*)lds);
            if (ATT_MODES & 2) for (int u = vcu; u < 512; u += G) for (int hf = 0; hf < 2; ++hf) att::attn_unit<1>(P, u >> 6, (u >> 3) & 7, hf ? 15 - (u & 7) : (u & 7), (LAS char*)lds);
            if (ATT_MODES & 4) for (int u = vcu; u < 512; u += G) for (int hf = 0; hf < 2; ++hf) att::attn_unit<2>(P, u >> 6, (u >> 3) & 7, hf ? 15 - (u & 7) : (u & 7), (LAS char*)lds);
            __syncthreads();
        }
        SEAM(pb + 4);

        if (EN(16) && IN(pb + 5)) REPS(16) {
            PHASE_LOCALS;
            const float* dl = A->diff_lambda + l * 256; const float p = dl[lane] * dl[64 + lane], q = dl[128 + lane] * dl[192 + lane];
            const float lam = __expf(wave_sum(p)) - __expf(wave_sum(q)) + lam_init;
            diff_combine(WSP(bf16_t, WS_MERGED), A->diff_subln_g + l * 128, lam, 1.0f - lam_init, WSP(bf16_t, WS_OBUF), vcu, G, wave, lane);
        }
        SEAM(pb + 5);

        if (EN(6) && IN(pb + 6)) REPS(6) {
            PHASE_LOCALS;
            pg8::Gemm g{WSP(bf16_t, WS_OBUF), 3072, 1024, WSP(bf16_t, WS_WBR + (size_t)l * SZ_WBR), 1024, (size_t)DM * 1024}; pg8::Z3Order S; S.init(T / 256, DM / 256, G, bx);
            pg8::EpiBranch E{WSP(bf16_t, WS_MERGED), WSP(bf16_t, WS_PROJ)};
            pg8::gemm_phase(lds, g, S, E);
        }
        SEAM(pb + 6);

        if (EN(7) && IN(pb + 7)) REPS(7) {
            PHASE_LOCALS;
            pg8::Gemm g{WSP(bf16_t, WS_MERGED), DM, 0, WSP(bf16_t, WS_WOUT + (size_t)l * SZ_WOUT), DM, 0}; pg8::StaticOrder S; S.init(T / 256, DM / 256, G, bx);
            pg8::EpiResid E{(l == 0) ? A->x : (const float*)A->out, (((PROBE_REP_MASK >> 7) & 1u) && rep_ == 0) ? WSP(float, WS_QM) : A->out};
            pg8::gemm_phase(lds, g, S, E);
        }
        SEAM(pb + 7);

        if (l == 0) {
            if (EN(8) && IN(pb + 8)) REPS(8) { PHASE_LOCALS; rmsnorm_rows(A->out, A->ffn_norm_g, WSP(bf16_t, WS_H), vcu, G, wave, lane); }
            SEAM(pb + 8);
            if (EN(9) && IN(pb + 9)) REPS(9) {
                PHASE_LOCALS;
                pg8::Gemm g{WSP(bf16_t, WS_H), DM, 0, WSP(bf16_t, WS_WD13), DM, 0}; pg8::StaticOrder S; S.init(T / 256, 2 * DFF / 256, G, bx);
                pg8::EpiSwiglu E{WSP(bf16_t, WS_UD), DFF};
                pg8::gemm_phase(lds, g, S, E);
            }
            SEAM(pb + 9);
            if (EN(10) && IN(pb + 10)) REPS(10) {
                PHASE_LOCALS;
                pg8::Gemm g{WSP(bf16_t, WS_UD), DFF, 0, WSP(bf16_t, WS_WD2), DFF, 0}; pg8::StaticOrder S; S.init(T / 256, DM / 256, G, bx);
                pg8::EpiResid E{A->out, (((PROBE_REP_MASK >> 10) & 1u) && rep_ == 0) ? WSP(float, WS_QM) : A->out};
                pg8::gemm_phase(lds, g, S, E);
            }
            SEAM(pb + 10);
        } else {
            if (EN(11) && IN(pb + 8)) REPS(11) {
                PHASE_LOCALS; LAS float* scr = (LAS float*)lds;
                wconv_job<3>(A->expert_w1, A->expert_w3, DFFE, DM, 2 * DFFE, NEXP, (size_t)DM * DFFE, (size_t)2 * DFFE * DM, WSP(bf16_t, WS_EW13), nullptr, 0, scr, vcu, G, tid);
                wconv_job<0>(A->expert_w2, nullptr, DM, DFFE, DM, NEXP, (size_t)DFFE * DM, (size_t)DM * DFFE, WSP(bf16_t, WS_EW2), nullptr, 0, scr, vcu, G, tid);
                __syncthreads();
                moe_route(A->out, A->ffn_norm_g + DM, A->router_w, WSP(int, MS_ROUTE), WSP(float, MS_RSTD2), WSP(unsigned, MS_CNT), lds, vcu, G, tid, wave, lane);
            }
            SEAM(pb + 8);
            if (EN(12) && IN(pb + 9)) REPS(12) { PHASE_LOCALS;
                moe_gather(A->out, A->ffn_norm_g + DM, WSP(int, MS_ROUTE), WSP(float, MS_RSTD2), WSP(unsigned, MS_CNT), WSP(int, MS_SLOTS), WSP(int, MS_MOEOFF), WSP(bf16_t, WS_HS), lds, vcu, G, tid, wave, lane); }
            SEAM(pb + 9);
            if (EN(13) && IN(pb + 10)) REPS(13) {
                PHASE_LOCALS;
                pg8::MoeOrder S; const int* moe_off = WSP(int, MS_MOEOFF);
#pragma unroll
                for (int e = 0; e < 9; ++e) S.off[e] = __builtin_amdgcn_readfirstlane(moe_off[e]);
                S.init(S.off[8] / 256, 2 * DFFE / 256, G, bx);
                pg8::Gemm g{WSP(bf16_t, WS_HS), DM, 0, WSP(bf16_t, WS_EW13), DM, (size_t)2 * DFFE * DM};
                pg8::EpiSwiglu E{WSP(bf16_t, WS_UM), DFFE};
                pg8::gemm_phase(lds, g, S, E);
            }
            SEAM(pb + 10);
            if (EN(14) && IN(pb + 11)) REPS(14) {
                PHASE_LOCALS;
                pg8::MoeOrder S; const int* moe_off = WSP(int, MS_MOEOFF);
#pragma unroll
                for (int e = 0; e < 9; ++e) S.off[e] = __builtin_amdgcn_readfirstlane(moe_off[e]);
                S.init(S.off[8] / 256, DM / 256, G, bx);
                pg8::Gemm g{WSP(bf16_t, WS_UM), DFFE, 0, WSP(bf16_t, WS_EW2), DFFE, (size_t)DM * DFFE};
                pg8::EpiBf16 E{WSP(bf16_t, WS_HS), DM, nullptr};
                pg8::gemm_phase(lds, g, S, E);
            }
            SEAM(pb + 11);
            if (EN(15) && IN(pb + 12)) REPS(15) { PHASE_LOCALS; final_phase(A->out, WSP(bf16_t, WS_HS), WSP(int, MS_ROUTE), WSP(int, MS_SLOTS), A->final_norm_g, A->out, vcu, G, wave, lane); }
        }
    }
#undef IN
#undef EN
#undef SEAM
#undef PHASE_LOCALS
#undef WSP
}

extern "C" void kernel_launch(void* const* d_in, const int* in_sizes, int n_in, void* d_out, int out_size, void* d_ws, size_t ws_size, hipStream_t stream) {
    static int grid = 0;
    if (grid == 0) {
        if (n_in != 23 || in_sizes[0] != T * DM || out_size != T * DM || ws_size < WS_NEED) {
            fprintf(stderr, "kernel_launch: shape mismatch: n_in %d in0 %d out %d ws %zu (need %zu)\n", n_in, n_in > 0 ? in_sizes[0] : -1, out_size, ws_size, (size_t)WS_NEED); grid = -1; return; }
        int dev = 0, cus = 0, per_cu = 0;
        if (hipGetDevice(&dev) != hipSuccess || hipDeviceGetAttribute(&cus, hipDeviceAttributeMultiprocessorCount, dev) != hipSuccess) { fprintf(stderr, "kernel_launch: device query failed\n"); grid = -1; return; }
        if (hipFuncSetAttribute((const void*)mega_fwd, hipFuncAttributeMaxDynamicSharedMemorySize, LDS_BYTES) != hipSuccess) { fprintf(stderr, "kernel_launch: hipFuncSetAttribute failed\n"); grid = -1; return; }
        if (hipOccupancyMaxActiveBlocksPerMultiprocessor(&per_cu, (const void*)mega_fwd, NWAVES * 64, LDS_BYTES) != hipSuccess || per_cu < 1)
            fprintf(stderr, "kernel_launch: note: occupancy query reports %d workgroups per CU\n", per_cu);
        (void)hipGetLastError();
        grid = cus;
    }
    if (grid < 0) return;
    if (hipMemsetAsync((char*)d_ws + WS_CTL, 0, CTL_ZERO_BYTES, stream) != hipSuccess) { fprintf(stderr, "kernel_launch: memset failed\n"); return; }
    Args a{};
    a.x = (const float*)d_in[0]; a.positions = (const int*)d_in[1]; a.attn_norm_g = (const float*)d_in[2]; a.w_in = (const float*)d_in[3]; a.diff_lambda = (const float*)d_in[4];
    a.diff_subln_g = (const float*)d_in[5]; a.fox_bias = (const float*)d_in[6]; a.q_norm_g = (const float*)d_in[7]; a.kv_norm_g = (const float*)d_in[8]; a.w_uq = (const float*)d_in[9];
    a.w_uk = (const float*)d_in[10]; a.w_uv = (const float*)d_in[11]; a.w_branch = (const float*)d_in[12]; a.w_out = (const float*)d_in[13]; a.ffn_norm_g = (const float*)d_in[14];
    a.dense_w1 = (const float*)d_in[15]; a.dense_w3 = (const float*)d_in[16]; a.dense_w2 = (const float*)d_in[17]; a.router_w = (const float*)d_in[18]; a.expert_w1 = (const float*)d_in[19];
    a.expert_w3 = (const float*)d_in[20]; a.expert_w2 = (const float*)d_in[21]; a.final_norm_g = (const float*)d_in[22];
    a.out = (float*)d_out; a.ws = (unsigned char*)d_ws;
#if MK_ONE_LAUNCH
    a.ph_lo = 0; a.ph_hi = NPH; a.li = 0;
    hipLaunchKernelGGL(mega_fwd, dim3(grid), dim3(NWAVES * 64), LDS_BYTES, stream, a);
#else
    int li = 0;
    for (int k = 0; k < NPH; ++k) { if (!phase_exists(k)) continue;
        a.ph_lo = k; a.ph_hi = k + 1; a.li = li++;
        hipLaunchKernelGGL(mega_fwd, dim3(grid), dim3(NWAVES * 64), LDS_BYTES, stream, a); }
#endif
    const hipError_t le = hipPeekAtLastError();
    if (le != hipSuccess) fprintf(stderr, "kernel_launch: launch failed: %s\n", hipGetErrorName(le));
}
```

```cpp
#include <hip/hip_runtime.h>
#include <cstdio>
#include <cstdint>

#ifndef MK_ONE_LAUNCH
#define MK_ONE_LAUNCH 1
#endif

#define GAS __attribute__((address_space(1)))
#define LAS __attribute__((address_space(3)))
typedef unsigned short bf16_t;
typedef short bf16x8 __attribute__((ext_vector_type(8)));
typedef short s16x4 __attribute__((ext_vector_type(4)));
typedef float f32x4 __attribute__((ext_vector_type(4)));
typedef float f32x2 __attribute__((ext_vector_type(2)));
typedef float f32x16 __attribute__((ext_vector_type(16)));
typedef unsigned u32x4 __attribute__((ext_vector_type(4)));
typedef unsigned u32x2 __attribute__((ext_vector_type(2)));
typedef int i32x4 __attribute__((ext_vector_type(4)));

constexpr int NB = 8, SEQ = 4096, T = NB * SEQ, DM = 2048, DEPTH = 2;
constexpr int N_IN_SRC = 13384, NIN = 13568, LDP = 13312, TAILW = 256;
constexpr int DFF = 5632, NEXP = 8, DFFE = 7168;
constexpr float NORM_EPS = 1e-6f;
constexpr int PC_AQ = 0, PC_AK = 1024, PC_AV = 2048, PC_BQ = 3072, PC_BK = 4096, PC_BV = 5120, PC_CQ = 6144, PC_CKV = 6656, PC_GATE = 7168;
constexpr int MOE_ROWS = 2 * T + 2048;

constexpr size_t MiB = 1u << 20;
constexpr size_t WS_CTL = 0, CTL_ZERO_BYTES = 1 * MiB;
constexpr size_t WS_MISC = 3 * MiB;
constexpr size_t MS_RSTDQ = WS_MISC, MS_RSTDKV = MS_RSTDQ + (size_t)T * 4, MS_CKS = MS_RSTDKV + (size_t)T * 4, MS_ROUTE = MS_CKS + (size_t)NB * 8 * SEQ * 4,
                 MS_RSTD2 = MS_ROUTE + (size_t)T * 16, MS_SLOTS = MS_RSTD2 + (size_t)T * 4, MS_CNT = MS_SLOTS + (size_t)T * 8, MS_MOEOFF = MS_CNT + 1024 * 8 * 4,
                 MS_LAM = MS_MOEOFF + 256, MS_END = MS_LAM + 256;
static_assert(MS_END <= 8 * MiB, "misc region");
constexpr size_t WS_BASE = 8 * MiB;
constexpr size_t SZ_WIN = (size_t)NIN * DM * 2, SZ_WUQ = (size_t)1536 * 512 * 2, SZ_WUKV = (size_t)2048 * 512 * 2, SZ_WBR = (size_t)3 * 2048 * 1024 * 2, SZ_WOUT = (size_t)DM * DM * 2;
constexpr size_t WS_WIN = WS_BASE, WS_WUQ = WS_WIN + 2 * SZ_WIN, WS_WUKV = WS_WUQ + 2 * SZ_WUQ, WS_WBR = WS_WUKV + 2 * SZ_WUKV, WS_WOUT = WS_WBR + 2 * SZ_WBR,
                 WS_WD13 = WS_WOUT + 2 * SZ_WOUT, WS_WD2 = WS_WD13 + (size_t)2 * DFF * DM * 2, WS_H = WS_WD2 + (size_t)DM * DFF * 2,
                 WS_PROJ = WS_H + (size_t)T * DM * 2, WS_TAIL = WS_PROJ + (size_t)T * LDP * 2, WS_QM = WS_TAIL + (size_t)T * TAILW * 4, WS_KNV = WS_QM + (size_t)T * 1536 * 2,
                 WS_KROT = WS_KNV + (size_t)T * 2048 * 2, WS_OBUF = WS_KROT + (size_t)T * 64 * 2, WS_MERGED = WS_OBUF + (size_t)T * 3072 * 2, WS_MIX_END = WS_MERGED + (size_t)T * DM * 2;
constexpr size_t WS_UD = WS_PROJ;
static_assert((size_t)T * DFF * 2 <= (size_t)T * LDP * 2, "dense hidden fits in proj");
constexpr size_t WS_EW13 = WS_BASE, WS_EW2 = WS_EW13 + (size_t)NEXP * 2 * DFFE * DM * 2, WS_HS = WS_EW2 + (size_t)NEXP * DM * DFFE * 2,
                 WS_UM = WS_HS + (size_t)MOE_ROWS * DM * 2, WS_MOE_END = WS_UM + (size_t)MOE_ROWS * DFFE * 2;
constexpr size_t WS_NEED = WS_MIX_END > WS_MOE_END ? WS_MIX_END : WS_MOE_END;
static_assert(WS_NEED <= 2134232128ull, "workspace map exceeds the guaranteed minimum");
constexpr int CW_TMO = 0, CW_BAR = 4096;

constexpr int RING_BYTES = 131072, LDSCTL_OFF = RING_BYTES, MISC_OFF = LDSCTL_OFF + 320, LDS_BYTES = 147456;

#define RLX_AGENT __ATOMIC_RELAXED, __HIP_MEMORY_SCOPE_AGENT
#define LDS_WAIT() asm volatile("s_waitcnt lgkmcnt(0)" ::: "memory")
#define VM_WAIT() asm volatile("s_waitcnt vmcnt(0)" ::: "memory")
__device__ __forceinline__ unsigned cvt_pk_bf16(float lo, float hi) { unsigned r; asm volatile("v_cvt_pk_bf16_f32 %0, %1, %2" : "=v"(r) : "v"(lo), "v"(hi)); return r; }
__device__ __forceinline__ float bf2f(unsigned short h) { return __uint_as_float((unsigned)h << 16); }
__device__ __forceinline__ float bflo(unsigned w) { return __uint_as_float(w << 16); }
__device__ __forceinline__ float bfhi(unsigned w) { return __uint_as_float(w & 0xffff0000u); }
template <int CTRL> __device__ __forceinline__ float dpp_f(float v) { return __int_as_float(__builtin_amdgcn_update_dpp(0, __float_as_int(v), CTRL, 0xf, 0xf, true)); }
__device__ __forceinline__ float row_sum16(float v) {
    v += dpp_f<0xB1>(v);
    v += dpp_f<0x4E>(v);
    v += dpp_f<0x141>(v);
    v += dpp_f<0x140>(v);
    return v;
}
__device__ __forceinline__ float wave_sum(float v) {
    v = row_sum16(v);
    const int i = __float_as_int(v);
    return (__int_as_float(__builtin_amdgcn_readlane(i, 0)) + __int_as_float(__builtin_amdgcn_readlane(i, 16))) + (__int_as_float(__builtin_amdgcn_readlane(i, 32)) + __int_as_float(__builtin_amdgcn_readlane(i, 48)));
}
__device__ __forceinline__ float sigmoidf_(float x) { return __builtin_amdgcn_rcpf(1.0f + __expf(-x)); }

#define XB_TMO      128
#define XB_XCNT(j)  (256  + 64 * (j))
#define XB_XSUB(j)  (1280 + 64 * (j))
#define XB_XGEN(j)  (2304 + 64 * (j))
#define XB_TOP      3328
#define XB_TOPGEN   3392
#define XCD_BAR_WORDS 3456
#define XB_SPIN_CAP (1u << 22)
__device__ __forceinline__ unsigned xb_ld(unsigned* p)              { return __hip_atomic_load(p, __ATOMIC_RELAXED, __HIP_MEMORY_SCOPE_AGENT); }
__device__ __forceinline__ unsigned xb_add(unsigned* p, unsigned v) { return __hip_atomic_fetch_add(p, v, __ATOMIC_RELAXED, __HIP_MEMORY_SCOPE_AGENT); }
__device__ __forceinline__ unsigned xb_xcc_id() { return (unsigned)__builtin_amdgcn_s_getreg((3 << 11) | 20) & 0xFu; }
#define XB_SPIN(cond, bar) do { unsigned _sp = 0; while (cond) { __builtin_amdgcn_s_sleep(1); \
    if ((++_sp & 255u) == 0u) { if (xb_ld(&(bar)[XB_TMO])) break; if (_sp > XB_SPIN_CAP) { atomicAdd(&(bar)[XB_TMO], 1u); break; } } } } while (0)
struct XcdBarrier { unsigned* bar; unsigned x; volatile LAS unsigned* st; };
__device__ __forceinline__ XcdBarrier xcd_barrier_post(unsigned* bar, volatile LAS unsigned* st) {
    XcdBarrier b; b.bar = bar; b.x = xb_xcc_id(); b.st = st;
    if (threadIdx.x == 0) (void)xb_add(&bar[XB_XCNT(b.x)], 1u);
    return b;
}
__device__ __forceinline__ void xcd_barrier_complete(unsigned* bar, unsigned x, unsigned& nloc, unsigned& nx) {
    const unsigned G = gridDim.x * gridDim.y * gridDim.z;
    unsigned sum, cnt, mine, sp = 0u;
    for (;;) {
        sum = 0u; cnt = 0u; mine = 0u;
#pragma unroll
        for (unsigned j = 0; j < 16; ++j) { const unsigned c = xb_ld(&bar[XB_XCNT(j)]); sum += c; cnt += (c > 0u) ? 1u : 0u; mine = (j == x) ? c : mine; }
        if (sum == G) break;
        __builtin_amdgcn_s_sleep(1);
        if ((++sp & 255u) == 0u) { if (xb_ld(&bar[XB_TMO])) break; if (sp > XB_SPIN_CAP) { atomicAdd(&bar[XB_TMO], 1u); break; } }
    }
    nloc = mine > 0u ? mine : 1u; nx = cnt > 0u ? cnt : 1u;
}
__device__ __forceinline__ void xcd_barrier(const XcdBarrier& b) {
    asm volatile("s_waitcnt vmcnt(0)" ::: "memory");
    __syncthreads();
    if (threadIdx.x == 0) {
        unsigned* bar = b.bar;
        __builtin_amdgcn_s_waitcnt(0);
        unsigned nloc = b.st[0], nx = b.st[1];
        if (nloc == 0u) { xcd_barrier_complete(bar, b.x, nloc, nx); b.st[0] = nloc; b.st[1] = nx; }
        const unsigned old = xb_add(&bar[XB_XSUB(b.x)], 1u);
        const unsigned gen = old / nloc;
        if (old + 1u == (gen + 1u) * nloc) {
            __builtin_amdgcn_fence(__ATOMIC_RELEASE, "agent");
            asm volatile("s_waitcnt vmcnt(0)" ::: "memory");
            const unsigned og = xb_add(&bar[XB_TOP], 1u);
            const unsigned tg = og / nx;
            if (og + 1u == (tg + 1u) * nx) xb_add(&bar[XB_TOPGEN], 1u);
            else XB_SPIN(xb_ld(&bar[XB_TOPGEN]) == tg, bar);
            __builtin_amdgcn_fence(__ATOMIC_ACQUIRE, "agent");
            xb_add(&bar[XB_XGEN(b.x)], 1u);
            asm volatile("s_waitcnt vmcnt(0)" ::: "memory");
        } else {
            XB_SPIN(xb_ld(&bar[XB_XGEN(b.x)]) == gen, bar);
            __builtin_amdgcn_fence(__ATOMIC_ACQUIRE, "agent");
            asm volatile("s_waitcnt vmcnt(0)" ::: "memory");
        }
    }
    __syncthreads();
}

#ifndef PG8_SP2
#define PG8_SP2 1
#endif
namespace pg8 {
constexpr int BM = 256, BK = 64, HALF = 128, HTB = HALF * BK * 2, STAGE_BYTES = 8 * HTB, NXCD = 8, WGM = 4;
__host__ __device__ __forceinline__ int lds_byte(int r, int c) { const int st = (r >> 4) * 2 + (c >> 5), rr = r & 15, cc = c & 31, ob = rr * 64 + cc * 2; return st * 1024 + (ob ^ (((ob >> 9) & 1) << 5)); }
__host__ __device__ __forceinline__ void stage_rc(int b, int& R, int& C) { const int st = b / 1024, sb = b % 1024, swz = sb ^ (((sb >> 9) & 1) << 5); R = (st >> 1) * 16 + swz / 64; C = (st & 1) * 32 + (swz % 64) / 2; }
__host__ __device__ __forceinline__ int perm32(int rho) { const int n = rho >> 4, i = rho & 15; return 8 * (i >> 2) + 4 * n + (i & 3); }

struct Unit { int pm, pn, z; };
struct Gemm { const bf16_t* A; int lda; size_t azs; const bf16_t* Bt; int K; size_t bzs; };

struct StaticOrder {
    int nM, nN, nwg, G, c;
    __device__ void init(int nM_, int nN_, int G_, int c_) { nM = nM_; nN = nN_; nwg = nM * nN; G = G_; c = c_; }
    __device__ __forceinline__ bool tile(int i, int& pm, int& pn) const {
        const long L = (long)i * G + c; if (L >= nwg) return false;
        int wgid = (int)L; { const int q = nwg / NXCD, r = nwg % NXCD, xcd = wgid % NXCD, off = wgid / NXCD; wgid = (xcd < r ? xcd * (q + 1) : r * (q + 1) + (xcd - r) * q) + off; }
        const int nig = WGM * nN, gid = wgid / nig, fm = gid * WGM, gsz = (nM - fm) < WGM ? (nM - fm) : WGM;
        pm = fm + ((wgid % nig) % gsz); pn = (wgid % nig) / gsz; return true;
    }
    __device__ bool next(int i, Unit& u) const { u.z = 0; return tile(i, u.pm, u.pn); }
};
struct Z3Order : StaticOrder {
    __device__ bool next(int i, Unit& u) const { u.z = i % 3; return tile(i / 3, u.pm, u.pn); }
};
struct MoeOrder : StaticOrder {
    int off[9];
    __device__ bool next(int i, Unit& u) const {
        if (!tile(i, u.pm, u.pn)) return false;
        const int r = u.pm * 256; int z = 0;
#pragma unroll
        for (int e = 1; e < 8; ++e) z += (r >= off[e]) ? 1 : 0;
        u.z = z; return true;
    }
};
struct MoeRange : MoeOrder {
    int i0, i1;
    __device__ bool next(int i, Unit& u) const { return (i + i0 < i1) && MoeOrder::next(i + i0, u); }
};

template <class Epi, class Sched>
__device__ __forceinline__ void gemm_phase(LAS unsigned char* lds, const Gemm g, const Sched& S, const Epi& E) {
    int tid = threadIdx.x; asm volatile("" : "+v"(tid));
    const int wid = __builtin_amdgcn_readfirstlane(tid >> 6), lane = tid & 63, wr = wid >> 2, wc = wid & 3, fr = lane & 15, fq = lane >> 4;
    const int K = g.K, nt = K / BK, lda = g.lda;
    unsigned voffA[2], voffB[2];
#pragma unroll
    for (int i = 0; i < 2; ++i) { int R, C; stage_rc(tid * 16 + i * 8192, R, C); const int Rb = Epi::PERM ? ((R & ~31) + perm32(R & 31)) : R;
        voffA[i] = (unsigned)(R * lda + C) * 2u; voffB[i] = (unsigned)(Rb * K + C) * 2u; }
    const size_t kstep = (size_t)(BK * 2);
    const size_t hstepA = (size_t)HALF * lda * 2, hstepB = (size_t)HALF * K * 2;
    const unsigned ldsw = (unsigned)wid * 1024u;
    const int aoff = lds_byte(wr * 64 + fr, fq * 8), boff = lds_byte(wc * 32 + fr, fq * 8);
#define PG8_SA(b, h) (((b) * 2 + (h)) * HTB)
#define PG8_SB(b, h) ((4 + (b) * 2 + (h)) * HTB)
#define PG8_STAGE(bufoff, gbase, voff) do { _Pragma("unroll") for (int _i = 0; _i < 2; ++_i) \
        __builtin_amdgcn_global_load_lds((const unsigned*)((const char*)(gbase) + (voff)[_i]), (LAS unsigned*)(lds + (bufoff) + ldsw + _i * 8192), 16, 0, 0); } while (0)
#define PG8_LDA(dst, b, h) do { _Pragma("unroll") for (int m = 0; m < 4; ++m) _Pragma("unroll") for (int k = 0; k < 2; ++k) dst[m][k] = *(const LAS bf16x8*)(lds + PG8_SA(b, h) + aoff + m * 2048 + k * 1024); } while (0)
#define PG8_LDB(dst, b, h) do { _Pragma("unroll") for (int n = 0; n < 2; ++n) _Pragma("unroll") for (int k = 0; k < 2; ++k) dst[n][k] = *(const LAS bf16x8*)(lds + PG8_SB(b, h) + boff + n * 2048 + k * 1024); } while (0)
#define PG8_MMA(ai, bj, At, Bt) do { __builtin_amdgcn_s_setprio(1); _Pragma("unroll") for (int m = 0; m < 4; ++m) _Pragma("unroll") for (int n = 0; n < 2; ++n) _Pragma("unroll") for (int k = 0; k < 2; ++k) \
        acc[ai][bj][m][n] = __builtin_amdgcn_mfma_f32_16x16x32_bf16(Bt[n][k], At[m][k], acc[ai][bj][m][n], 0, 0, 0); __builtin_amdgcn_s_setprio(0); } while (0)
#define PG8_WAIT_V(n) asm volatile("s_waitcnt vmcnt(" #n ")" ::: "memory")
#define PG8_WAIT_L(n) asm volatile("s_waitcnt lgkmcnt(" #n ")" ::: "memory")
#define PG8_BAR __builtin_amdgcn_s_barrier()
#define PG8_SCHED __builtin_amdgcn_sched_barrier(0)
    Unit cur, nxt; int ui = 0;
    if (!S.next(0, cur)) return;
    f32x4 acc[2][2][4][2];
#pragma unroll
    for (int a = 0; a < 2; ++a)
#pragma unroll
        for (int b = 0; b < 2; ++b)
#pragma unroll
            for (int m = 0; m < 4; ++m)
#pragma unroll
                for (int n = 0; n < 2; ++n) acc[a][b][m][n] = (f32x4){0.f, 0.f, 0.f, 0.f};
    bf16x8 At[4][2], B0[2][2], B1[2][2];
    const char* cA = (const char*)(g.A + (size_t)cur.z * g.azs) + (size_t)cur.pm * 2 * hstepA;
    const char* cB = (const char*)(g.Bt + (size_t)cur.z * g.bzs) + (size_t)cur.pn * 2 * hstepB;
#if PG8_SP2
    PG8_STAGE(PG8_SB(0, 0), cB, voffB); PG8_STAGE(PG8_SB(0, 1), cB + hstepB, voffB); PG8_STAGE(PG8_SA(0, 0), cA, voffA); PG8_STAGE(PG8_SA(0, 1), cA + hstepA, voffA);
    if (wr == 1) PG8_BAR;
    PG8_WAIT_V(2); PG8_BAR;
    PG8_STAGE(PG8_SB(1, 0), cB + kstep, voffB); PG8_STAGE(PG8_SA(1, 0), cA + kstep, voffA); PG8_STAGE(PG8_SB(1, 1), cB + hstepB + kstep, voffB);
    PG8_WAIT_V(6); PG8_BAR;
#else
    PG8_STAGE(PG8_SB(0, 0), cB, voffB); PG8_STAGE(PG8_SA(0, 0), cA, voffA); PG8_STAGE(PG8_SB(0, 1), cB + hstepB, voffB); PG8_STAGE(PG8_SA(0, 1), cA + hstepA, voffA);
    if (wr == 1) PG8_BAR;
    PG8_WAIT_V(4); PG8_BAR;
    PG8_STAGE(PG8_SB(1, 0), cB + kstep, voffB); PG8_STAGE(PG8_SA(1, 0), cA + kstep, voffA); PG8_STAGE(PG8_SB(1, 1), cB + hstepB + kstep, voffB);
    PG8_WAIT_V(6); PG8_BAR;
#endif
    for (;;) {
        const bool has_next = S.next(ui + 1, nxt);
        const char* nA = has_next ? (const char*)(g.A + (size_t)nxt.z * g.azs) + (size_t)nxt.pm * 2 * hstepA : cA;
        const char* nB = has_next ? (const char*)(g.Bt + (size_t)nxt.z * g.bzs) + (size_t)nxt.pn * 2 * hstepB : cB;
        for (int t = 0; t < nt; t += 2) {
            const bool last = (t == nt - 2);
            const char* a1 = cA + (size_t)(t + 1) * kstep;
            const char* a2 = last ? nA : cA + (size_t)(t + 2) * kstep; const char* b2 = last ? nB : cB + (size_t)(t + 2) * kstep;
            const char* a3 = a2 + kstep; const char* b3 = b2 + kstep;
#if PG8_SP2
            PG8_LDB(B0, 0, 0); PG8_LDB(B1, 0, 1); PG8_SCHED; PG8_LDA(At, 0, 0); PG8_STAGE(PG8_SA(1, 1), a1 + hstepA, voffA);
            PG8_WAIT_V(8); PG8_WAIT_L(0); PG8_BAR; PG8_MMA(0, 0, At, B0); PG8_MMA(0, 1, At, B1); PG8_BAR; PG8_SCHED;
            PG8_LDA(At, 0, 1); PG8_STAGE(PG8_SB(0, 0), b2, voffB); PG8_STAGE(PG8_SB(0, 1), b2 + hstepB, voffB); PG8_STAGE(PG8_SA(0, 0), a2, voffA);
            PG8_WAIT_V(8); PG8_WAIT_L(0); PG8_BAR; PG8_MMA(1, 0, At, B0); PG8_MMA(1, 1, At, B1); PG8_BAR; PG8_SCHED;
            PG8_LDB(B0, 1, 0); PG8_LDB(B1, 1, 1); PG8_SCHED; PG8_LDA(At, 1, 0); PG8_STAGE(PG8_SA(0, 1), a2 + hstepA, voffA);
            PG8_WAIT_V(8); PG8_WAIT_L(0); PG8_BAR; PG8_MMA(0, 0, At, B0); PG8_MMA(0, 1, At, B1); PG8_BAR; PG8_SCHED;
            PG8_LDA(At, 1, 1); PG8_STAGE(PG8_SB(1, 0), b3, voffB); PG8_STAGE(PG8_SB(1, 1), b3 + hstepB, voffB); PG8_STAGE(PG8_SA(1, 0), a3, voffA);
            PG8_WAIT_V(8); PG8_WAIT_L(0); PG8_BAR; PG8_MMA(1, 0, At, B0); PG8_MMA(1, 1, At, B1); PG8_BAR; PG8_SCHED;
#else
            PG8_LDB(B0, 0, 0); PG8_SCHED; PG8_LDA(At, 0, 0); PG8_STAGE(PG8_SA(1, 1), a1 + hstepA, voffA);
            PG8_WAIT_L(8); PG8_BAR; PG8_WAIT_L(0); PG8_MMA(0, 0, At, B0); PG8_BAR; PG8_SCHED;
            PG8_LDB(B1, 0, 1); PG8_STAGE(PG8_SB(0, 0), b2, voffB);
            PG8_BAR; PG8_WAIT_L(0); PG8_MMA(0, 1, At, B1); PG8_BAR;
            PG8_LDA(At, 0, 1); PG8_STAGE(PG8_SA(0, 0), a2, voffA);
            PG8_BAR; PG8_WAIT_L(0); PG8_MMA(1, 0, At, B0); PG8_BAR; PG8_SCHED;
            PG8_STAGE(PG8_SB(0, 1), b2 + hstepB, voffB);
            PG8_WAIT_V(6); PG8_BAR; PG8_MMA(1, 1, At, B1); PG8_BAR;
            PG8_LDB(B0, 1, 0); PG8_SCHED; PG8_LDA(At, 1, 0); PG8_STAGE(PG8_SA(0, 1), a2 + hstepA, voffA);
            PG8_WAIT_L(8); PG8_BAR; PG8_WAIT_L(0); PG8_MMA(0, 0, At, B0); PG8_BAR; PG8_SCHED;
            PG8_LDB(B1, 1, 1); PG8_STAGE(PG8_SB(1, 0), b3, voffB);
            PG8_BAR; PG8_WAIT_L(0); PG8_MMA(0, 1, At, B1); PG8_BAR;
            PG8_LDA(At, 1, 1); PG8_STAGE(PG8_SA(1, 0), a3, voffA);
            PG8_BAR; PG8_WAIT_L(0); PG8_MMA(1, 0, At, B0); PG8_BAR; PG8_SCHED;
            PG8_STAGE(PG8_SB(1, 1), b3 + hstepB, voffB);
            PG8_WAIT_V(6); PG8_BAR; PG8_MMA(1, 1, At, B1); PG8_BAR;
#endif
        }
        if (wr == 0) PG8_BAR;
        E(acc, cur, wr, wc, fr, fq);
        if (!has_next) break;
#pragma unroll
        for (int a = 0; a < 2; ++a)
#pragma unroll
            for (int b = 0; b < 2; ++b)
#pragma unroll
                for (int m = 0; m < 4; ++m)
#pragma unroll
                    for (int n = 0; n < 2; ++n) acc[a][b][m][n] = (f32x4){0.f, 0.f, 0.f, 0.f};
        cur = nxt; cA = nA; cB = nB; ++ui;
        if (wr == 1) PG8_BAR;
    }
    PG8_WAIT_V(0);
    PG8_BAR;
#undef PG8_SA
#undef PG8_SB
#undef PG8_STAGE
#undef PG8_LDA
#undef PG8_LDB
#undef PG8_MMA
#undef PG8_WAIT_V
#undef PG8_WAIT_L
#undef PG8_BAR
#undef PG8_SCHED
}

#define EPI_ROWS(ai, m) (u.pm * BM + (ai) * HALF + wr * 64 + (m) * 16 + fr)

struct EpiProj {
    static constexpr bool PERM = true;
    bf16_t* O; float* tail;
    __device__ __forceinline__ void operator()(f32x4 (&acc)[2][2][4][2], const Unit& u, int wr, int wc, int fr, int fq) const {
        const int colt = wc * 32 + 8 * fq;
        if (u.pn < LDP / 256) {
#pragma unroll
            for (int ai = 0; ai < 2; ++ai)
#pragma unroll
                for (int m = 0; m < 4; ++m) { bf16_t* rowp = O + (size_t)EPI_ROWS(ai, m) * LDP + u.pn * BM + colt;
#pragma unroll
                    for (int bj = 0; bj < 2; ++bj) { const f32x4 v0 = acc[ai][bj][m][0], v1 = acc[ai][bj][m][1];
                        u32x4 w; w.x = cvt_pk_bf16(v0[0], v0[1]); w.y = cvt_pk_bf16(v0[2], v0[3]); w.z = cvt_pk_bf16(v1[0], v1[1]); w.w = cvt_pk_bf16(v1[2], v1[3]);
                        *(u32x4*)(rowp + bj * HALF) = w; } }
        } else {
#pragma unroll
            for (int ai = 0; ai < 2; ++ai)
#pragma unroll
                for (int m = 0; m < 4; ++m) { float* rowp = tail + (size_t)EPI_ROWS(ai, m) * TAILW + colt;
#pragma unroll
                    for (int bj = 0; bj < 2; ++bj) { *(f32x4*)(rowp + bj * HALF) = acc[ai][bj][m][0]; *(f32x4*)(rowp + bj * HALF + 4) = acc[ai][bj][m][1]; } }
        }
    }
};
struct EpiBf16 {
    static constexpr bool PERM = true;
    bf16_t* O; int ldc; const float* rowscale;
    __device__ __forceinline__ void operator()(f32x4 (&acc)[2][2][4][2], const Unit& u, int wr, int wc, int fr, int fq) const {
        const int colt = u.pn * BM + wc * 32 + 8 * fq;
#pragma unroll
        for (int ai = 0; ai < 2; ++ai)
#pragma unroll
            for (int m = 0; m < 4; ++m) { const int row = EPI_ROWS(ai, m); const float s = rowscale ? rowscale[row] : 1.0f; bf16_t* rowp = O + (size_t)row * ldc + colt;
#pragma unroll
                for (int bj = 0; bj < 2; ++bj) { const f32x4 v0 = acc[ai][bj][m][0] * s, v1 = acc[ai][bj][m][1] * s;
                    u32x4 w; w.x = cvt_pk_bf16(v0[0], v0[1]); w.y = cvt_pk_bf16(v0[2], v0[3]); w.z = cvt_pk_bf16(v1[0], v1[1]); w.w = cvt_pk_bf16(v1[2], v1[3]);
                    *(u32x4*)(rowp + bj * HALF) = w; } }
    }
};
struct EpiQ {
    static constexpr bool PERM = true;
    bf16_t* O; const float* rowscale; const int* positions; float qscale;
    __device__ __forceinline__ void operator()(f32x4 (&acc)[2][2][4][2], const Unit& u, int wr, int wc, int fr, int fq) const {
        const int colt = u.pn * BM + wc * 32 + 8 * fq;
        float sc[2][4], pf[2][4];
#pragma unroll
        for (int ai = 0; ai < 2; ++ai)
#pragma unroll
            for (int m = 0; m < 4; ++m) { const int row = EPI_ROWS(ai, m); sc[ai][m] = rowscale[row] * qscale; pf[ai][m] = (float)positions[row]; }
        float rf[2][4]; bool rope[2];
#pragma unroll
        for (int bj = 0; bj < 2; ++bj) { const int d = (colt + bj * HALF) % 192; rope[bj] = d >= 128;
#pragma unroll
            for (int k = 0; k < 4; ++k) rf[bj][k] = __builtin_amdgcn_exp2f(-(float)((d - 128) / 2 + k) * 0.41524101186092f) * 0.15915494309189535f; }
#pragma unroll
        for (int ai = 0; ai < 2; ++ai)
#pragma unroll
            for (int m = 0; m < 4; ++m) { const int row = EPI_ROWS(ai, m); const float s = sc[ai][m], p = pf[ai][m]; bf16_t* rowp = O + (size_t)row * 1536 + colt;
#pragma unroll
                for (int bj = 0; bj < 2; ++bj) { f32x4 v[2] = {acc[ai][bj][m][0] * s, acc[ai][bj][m][1] * s};
                    if (rope[bj]) {
#pragma unroll
                        for (int k = 0; k < 4; ++k) { const float rev = p * rf[bj][k], frc = rev - floorf(rev); const float c = __builtin_amdgcn_cosf(frc), sn = __builtin_amdgcn_sinf(frc);
                            const float a0 = v[k >> 1][2 * (k & 1)], b0 = v[k >> 1][2 * (k & 1) + 1];
                            v[k >> 1][2 * (k & 1)] = a0 * c - b0 * sn; v[k >> 1][2 * (k & 1) + 1] = b0 * c + a0 * sn; }
                    }
                    u32x4 w; w.x = cvt_pk_bf16(v[0][0], v[0][1]); w.y = cvt_pk_bf16(v[0][2], v[0][3]); w.z = cvt_pk_bf16(v[1][0], v[1][1]); w.w = cvt_pk_bf16(v[1][2], v[1][3]);
                    *(u32x4*)(rowp + bj * HALF) = w; } }
    }
};
struct EpiSwiglu {
    static constexpr bool PERM = true;
    bf16_t* O; int ldc;
    __device__ __forceinline__ void operator()(f32x4 (&acc)[2][2][4][2], const Unit& u, int wr, int wc, int fr, int fq) const {
        const int colt = u.pn * HALF + wc * 32 + 8 * fq;
#pragma unroll
        for (int ai = 0; ai < 2; ++ai)
#pragma unroll
            for (int m = 0; m < 4; ++m) { bf16_t* rowp = O + (size_t)EPI_ROWS(ai, m) * ldc + colt; float r[8];
#pragma unroll
                for (int n = 0; n < 2; ++n)
#pragma unroll
                    for (int i = 0; i < 4; ++i) { const float a = acc[ai][0][m][n][i], b = acc[ai][1][m][n][i]; r[n * 4 + i] = a * sigmoidf_(a) * b; }
                u32x4 w; w.x = cvt_pk_bf16(r[0], r[1]); w.y = cvt_pk_bf16(r[2], r[3]); w.z = cvt_pk_bf16(r[4], r[5]); w.w = cvt_pk_bf16(r[6], r[7]);
                *(u32x4*)rowp = w; }
    }
};
struct EpiBranch {
    static constexpr bool PERM = true;
    bf16_t* O; const bf16_t* proj;
    __device__ __forceinline__ void operator()(f32x4 (&acc)[2][2][4][2], const Unit& u, int wr, int wc, int fr, int fq) const {
        const int colt = u.pn * BM + wc * 32 + 8 * fq;
#pragma unroll
        for (int ai = 0; ai < 2; ++ai) {
            u32x4 gw[4][2];
#pragma unroll
            for (int m = 0; m < 4; ++m) { const bf16_t* gp = proj + (size_t)EPI_ROWS(ai, m) * LDP + PC_GATE + u.z * DM + colt;
#pragma unroll
                for (int bj = 0; bj < 2; ++bj) gw[m][bj] = *(const u32x4*)(gp + bj * HALF); }
            asm volatile("" ::: "memory");
#pragma unroll
            for (int m = 0; m < 4; ++m)
#pragma unroll
                for (int bj = 0; bj < 2; ++bj) { const u32x4 g = gw[m][bj]; const f32x4 v0 = acc[ai][bj][m][0], v1 = acc[ai][bj][m][1];
                    acc[ai][bj][m][0] = (f32x4){v0[0] * sigmoidf_(bflo(g.x)), v0[1] * sigmoidf_(bfhi(g.x)), v0[2] * sigmoidf_(bflo(g.y)), v0[3] * sigmoidf_(bfhi(g.y))};
                    acc[ai][bj][m][1] = (f32x4){v1[0] * sigmoidf_(bflo(g.z)), v1[1] * sigmoidf_(bfhi(g.z)), v1[2] * sigmoidf_(bflo(g.w)), v1[3] * sigmoidf_(bfhi(g.w))}; }
            if (u.z != 0) {
#pragma unroll
                for (int m = 0; m < 4; ++m) { const bf16_t* rowp = O + (size_t)EPI_ROWS(ai, m) * DM + colt;
#pragma unroll
                    for (int bj = 0; bj < 2; ++bj) gw[m][bj] = *(const u32x4*)(rowp + bj * HALF); }
                asm volatile("" ::: "memory");
#pragma unroll
                for (int m = 0; m < 4; ++m)
#pragma unroll
                    for (int bj = 0; bj < 2; ++bj) { const u32x4 o = gw[m][bj];
                        acc[ai][bj][m][0] += (f32x4){bflo(o.x), bfhi(o.x), bflo(o.y), bfhi(o.y)}; acc[ai][bj][m][1] += (f32x4){bflo(o.z), bfhi(o.z), bflo(o.w), bfhi(o.w)}; }
            }
#pragma unroll
            for (int m = 0; m < 4; ++m) { bf16_t* rowp = O + (size_t)EPI_ROWS(ai, m) * DM + colt;
#pragma unroll
                for (int bj = 0; bj < 2; ++bj) { const f32x4 v0 = acc[ai][bj][m][0], v1 = acc[ai][bj][m][1];
                    u32x4 w; w.x = cvt_pk_bf16(v0[0], v0[1]); w.y = cvt_pk_bf16(v0[2], v0[3]); w.z = cvt_pk_bf16(v1[0], v1[1]); w.w = cvt_pk_bf16(v1[2], v1[3]);
                    *(u32x4*)(rowp + bj * HALF) = w; } }
            asm volatile("" ::: "memory");
        }
    }
};
struct EpiResid {
    static constexpr bool PERM = false;
    const float* base; float* out;
    __device__ __forceinline__ void operator()(f32x4 (&acc)[2][2][4][2], const Unit& u, int wr, int wc, int fr, int fq) const {
        const int colt = u.pn * BM + wc * 32 + 4 * fq;
#pragma unroll
        for (int ai = 0; ai < 2; ++ai) {
            f32x4 bv[4][2][2];
#pragma unroll
            for (int m = 0; m < 4; ++m) { const size_t off = (size_t)EPI_ROWS(ai, m) * DM + colt;
#pragma unroll
                for (int bj = 0; bj < 2; ++bj)
#pragma unroll
                    for (int n = 0; n < 2; ++n) bv[m][bj][n] = *(const f32x4*)(base + off + bj * HALF + n * 16); }
            asm volatile("" ::: "memory");
#pragma unroll
            for (int m = 0; m < 4; ++m) { const size_t off = (size_t)EPI_ROWS(ai, m) * DM + colt;
#pragma unroll
                for (int bj = 0; bj < 2; ++bj)
#pragma unroll
                    for (int n = 0; n < 2; ++n) *(f32x4*)(out + off + bj * HALF + n * 16) = bv[m][bj][n] + acc[ai][bj][m][n]; }
            asm volatile("" ::: "memory");
        }
    }
};
#undef EPI_ROWS
}

namespace att {
constexpr int OFF_V = 0, SHM_V = 16384, OFF_KAUX = 32768, OFF_WS = 33280, OFF_KX = 35328, SHM_KX = 2048, OFF_K = 40960;
constexpr float L2E = 1.4426950408889634f, THR2 = 8.f * L2E;
template <int MODE> struct Cfg;
template <> struct Cfg<0> { static constexpr int DK = 64, NQ = 4; static constexpr float SCALE = 0.125f; };
template <> struct Cfg<1> { static constexpr int DK = 128, NQ = 8; static constexpr float SCALE = 0.08838834764831845f; };
template <> struct Cfg<2> { static constexpr int DK = 192, NQ = 12; static constexpr float SCALE = 0.07216878364870322f; };
static_assert(OFF_K + 2 * 64 * 192 * 2 <= RING_BYTES, "attention LDS map");

__device__ __forceinline__ int crow(int r, int hi) { return (r & 3) + 8 * (r >> 2) + 4 * hi; }
#define SBAR() __builtin_amdgcn_sched_barrier(0)
__device__ __forceinline__ void partialSM2(f32x16& p0, f32x16& p1, bool first, float& m_reg, float& alpha) {
    float pmax = p0[0];
#pragma unroll
    for (int r = 1; r < 16; ++r) pmax = fmaxf(pmax, p0[r]);
#pragma unroll
    for (int r = 0; r < 16; ++r) pmax = fmaxf(pmax, p1[r]);
    { auto rr = __builtin_amdgcn_permlane32_swap(__float_as_uint(pmax), __float_as_uint(pmax), false, false);
      pmax = fmaxf(__uint_as_float(rr[0]), __uint_as_float(rr[1])); }
    if (first) {
        m_reg = pmax; alpha = 0.f;
#pragma unroll
        for (int r = 0; r < 16; ++r) { p0[r] -= pmax; p1[r] -= pmax; }
    } else if (__builtin_expect(__all(pmax <= THR2), 1)) { alpha = 1.f; }
    else { const float delta = fmaxf(pmax, 0.f); alpha = __builtin_amdgcn_exp2f(-delta); m_reg += delta;
#pragma unroll
        for (int r = 0; r < 16; ++r) { p0[r] -= delta; p1[r] -= delta; } }
#pragma unroll
    for (int r = 0; r < 16; ++r) p0[r] = __builtin_amdgcn_exp2f(p0[r]);
}
__device__ __forceinline__ void finishSM(f32x16& p0, f32x16& p1, float alpha, float& l_reg, bf16x8& pa0, bf16x8& pa1, bf16x8& pa2, bf16x8& pa3) {
#pragma unroll
    for (int r = 0; r < 16; ++r) p1[r] = __builtin_amdgcn_exp2f(p1[r]);
    float ps = 0;
#pragma unroll
    for (int r = 0; r < 16; ++r) ps += p0[r];
#pragma unroll
    for (int r = 0; r < 16; ++r) ps += p1[r];
    { auto rr = __builtin_amdgcn_permlane32_swap(__float_as_uint(ps), __float_as_uint(ps), false, false);
      ps = __uint_as_float(rr[0]) + __uint_as_float(rr[1]); }
    l_reg = l_reg * alpha + ps;
#define PK4(P, BASE, OUT) do { unsigned a0 = cvt_pk_bf16(P[BASE + 0], P[BASE + 1]), a1 = cvt_pk_bf16(P[BASE + 2], P[BASE + 3]);   \
    unsigned b0 = cvt_pk_bf16(P[BASE + 4], P[BASE + 5]), b1 = cvt_pk_bf16(P[BASE + 6], P[BASE + 7]);                              \
    auto r0 = __builtin_amdgcn_permlane32_swap(a0, b0, false, false); auto r1 = __builtin_amdgcn_permlane32_swap(a1, b1, false, false); \
    u32x4 w = {r0[0], r1[0], r0[1], r1[1]}; OUT = *reinterpret_cast<bf16x8*>(&w); } while (0)
    PK4(p0, 0, pa0); PK4(p0, 8, pa1); PK4(p1, 0, pa2); PK4(p1, 8, pa3);
#undef PK4
}
__device__ __forceinline__ int v_st(int k, int c) { const int kk = (k & ~0xC) | ((k & 4) << 1) | ((k & 8) >> 1); return ((kk >> 3) * 4 + (c >> 5)) * 512 + ((kk & 7) * 32 + (c & 31)) * 2; }
__device__ __forceinline__ int v_rd_base(int lane) { return ((lane & 3) << 3) | (((lane >> 2) & 3) << 6) | (((lane >> 4) & 1) << 5) | (((lane >> 5) & 1) << 8); }
constexpr int v_rd_off(int d0, int ks, int half) { return d0 * 512 + ks * 4096 + half * 2048; }
template <int OFF> __device__ __forceinline__ s16x4 tr_read(int vb) {
    s16x4 r; asm volatile("ds_read_b64_tr_b16 %0, %1 offset:%2" : "=&v"(r) : "v"(vb), "i"(OFF) : "memory"); return r;
}
struct VFrag { s16x4 l0, h0, l1, h1, l2, h2, l3, h3; };
template <int D0> __device__ __forceinline__ void v_load(VFrag& f, int vb) {
    f.l0 = tr_read<v_rd_off(D0, 0, 0)>(vb); f.h0 = tr_read<v_rd_off(D0, 0, 1)>(vb); f.l1 = tr_read<v_rd_off(D0, 1, 0)>(vb); f.h1 = tr_read<v_rd_off(D0, 1, 1)>(vb);
    f.l2 = tr_read<v_rd_off(D0, 2, 0)>(vb); f.h2 = tr_read<v_rd_off(D0, 2, 1)>(vb); f.l3 = tr_read<v_rd_off(D0, 3, 0)>(vb); f.h3 = tr_read<v_rd_off(D0, 3, 1)>(vb);
}
__device__ __forceinline__ void pv_mma(f32x16& od, const VFrag& f, bf16x8 pa0, bf16x8 pa1, bf16x8 pa2, bf16x8 pa3) {
#define PK(L, H) (bf16x8){L[0], L[1], L[2], L[3], H[0], H[1], H[2], H[3]}
    od = __builtin_amdgcn_mfma_f32_32x32x16_bf16(pa0, PK(f.l0, f.h0), od, 0, 0, 0);
    od = __builtin_amdgcn_mfma_f32_32x32x16_bf16(pa1, PK(f.l1, f.h1), od, 0, 0, 0);
    od = __builtin_amdgcn_mfma_f32_32x32x16_bf16(pa2, PK(f.l2, f.h2), od, 0, 0, 0);
    od = __builtin_amdgcn_mfma_f32_32x32x16_bf16(pa3, PK(f.l3, f.h3), od, 0, 0, 0);
#undef PK
}
__device__ __forceinline__ void pv_all(f32x16 (&o)[4], int vb, bf16x8 pa0, bf16x8 pa1, bf16x8 pa2, bf16x8 pa3) {
    VFrag fa, fb;
    v_load<0>(fa, vb); v_load<1>(fb, vb);
    asm volatile("s_waitcnt lgkmcnt(8)" ::: "memory"); SBAR(); pv_mma(o[0], fa, pa0, pa1, pa2, pa3); SBAR();
    v_load<2>(fa, vb);
    asm volatile("s_waitcnt lgkmcnt(8)" ::: "memory"); SBAR(); pv_mma(o[1], fb, pa0, pa1, pa2, pa3); SBAR();
    v_load<3>(fb, vb);
    asm volatile("s_waitcnt lgkmcnt(8)" ::: "memory"); SBAR(); pv_mma(o[2], fa, pa0, pa1, pa2, pa3); SBAR();
    asm volatile("s_waitcnt lgkmcnt(0)" ::: "memory"); SBAR(); pv_mma(o[3], fb, pa0, pa1, pa2, pa3);
}

struct AttnP {
    const bf16_t* proj; const bf16_t* qm; const bf16_t* knv; const bf16_t* krot; const int* positions; const float* ckS;
    bf16_t* obuf; bf16_t* oscr;
};

template <int MODE>
__device__ __forceinline__ void attn_unit(const AttnP& P, int b, int h, int x, LAS char* lds) {
    constexpr int DK = Cfg<MODE>::DK, NQ = Cfg<MODE>::NQ, RS = DK * 2, SHM_K = 64 * RS;
    constexpr bool HAS_N = (MODE != 0);
    constexpr int RCOL = (MODE == 2) ? 128 : 0;
    constexpr bool HAS_R = (MODE != 1);
    constexpr bool HAS_AUX = (MODE != 2);
    int tid = threadIdx.x; asm volatile("" : "+v"(tid));
    const int wid = __builtin_amdgcn_readfirstlane(tid >> 6), lane = tid & 63, r32 = lane & 31, hi = lane >> 5;
    const size_t tok0 = (size_t)b * SEQ;
    const int q0w = x * 256 + wid * 32;
    const int NT = 4 * x + 4, jmax = 4 * x + (wid >> 1);
    LAS float* ws = (LAS float*)(lds + OFF_WS) + wid * 64; LAS float* li_l = ws; LAS float* al_l = ws + 32;
    const int sr = tid >> 4, sc = (tid & 15) * 8, vst0 = v_st(sr, sc), vst1 = v_st(32 + sr, sc);
    const int vb0 = (int)(uintptr_t)(lds + OFF_V) + v_rd_base(lane);
    const int rrow = tid >> 3, rcol = (tid & 7) * 8;
#define KSWZ(row, colB) ((row) * RS + ((colB) ^ (((row) & 7) << 4)))
    const int kstN0 = KSWZ(sr, sc * 2), kstN1 = KSWZ(32 + sr, sc * 2), kstR = KSWZ(rrow, (RCOL + rcol) * 2);
    int kb[4];
#pragma unroll
    for (int c = 0; c < 4; ++c) kb[c] = KSWZ(r32, c * 32 + hi * 16);
    constexpr int ldN = (MODE == 2) ? 2048 : LDP, ldR = (MODE == 2) ? 64 : LDP, ldV = (MODE == 2) ? 2048 : LDP, ldQ = (MODE == 2) ? 1536 : LDP;
    const bf16_t *srcN = nullptr, *srcR = nullptr, *srcV = nullptr, *srcQ = nullptr;
    if (MODE == 0) { srcR = P.proj + tok0 * LDP + PC_AK + h * 128; srcV = P.proj + tok0 * LDP + PC_AV + h * 128; srcQ = P.proj + tok0 * LDP + PC_AQ + h * 128; }
    if (MODE == 1) { srcN = P.proj + tok0 * LDP + PC_BK + h * 128; srcV = P.proj + tok0 * LDP + PC_BV + h * 128; srcQ = P.proj + tok0 * LDP + PC_BQ + h * 128; }
    if (MODE == 2) { srcN = P.knv + tok0 * 2048 + h * 128; srcR = P.krot + tok0 * 64; srcV = P.knv + tok0 * 2048 + 1024 + h * 128; srcQ = P.qm + tok0 * 1536 + h * 192; }
    float qaux = 0.f, slope2 = 0.f, xref = 0.f;
    if (MODE == 0) { qaux = (float)P.positions[tok0 + q0w + r32]; slope2 = exp2f(-(float)(h + 1)) * L2E; xref = (float)P.positions[tok0 + x * 256]; }
    if (MODE == 1) xref = P.ckS[((size_t)b * 8 + h) * SEQ + x * 256];
    bf16x8 qx = bf16x8{}; if (hi == 0) { qx[0] = (short)0x3F80; qx[1] = (short)0x3F80; }
    f32x16 o[4]; float m_reg, l_reg; bf16x8 qr[NQ];
    constexpr int NMAP = (MODE == 0) ? 2 : 1;
    for (int mp = 0; mp < NMAP; ++mp) {
#pragma unroll
        for (int d = 0; d < 4; ++d) o[d] = f32x16{};
        m_reg = 0.f; l_reg = 0.f;
        { const bf16_t* Qw = srcQ + (size_t)(q0w + r32) * ldQ + mp * 64 + hi * 8;
#pragma unroll
          for (int d0 = 0; d0 < NQ; ++d0) qr[d0] = *(const bf16x8*)(Qw + d0 * 16); }
        const char* gN = (const char*)srcN; const char* gR = (const char*)(srcR + mp * 64); const char* gV = (const char*)srcV;
        const unsigned oN = (unsigned)(sr * ldN + sc) * 2u, oR = (unsigned)(rrow * ldR + rcol) * 2u, oV = (unsigned)(sr * ldV + sc) * 2u;
        bf16x8 sN0, sN1, sR, sV0, sV1; float sAux = 0.f; int tload = 0;
#define SLOAD() do { if (HAS_N) { sN0 = *(const bf16x8*)(gN + oN); sN1 = *(const bf16x8*)(gN + (size_t)32 * ldN * 2 + oN); gN += (size_t)64 * ldN * 2; } \
        if (HAS_R) { sR = *(const bf16x8*)(gR + oR); gR += (size_t)64 * ldR * 2; } \
        sV0 = *(const bf16x8*)(gV + oV); sV1 = *(const bf16x8*)(gV + (size_t)32 * ldV * 2 + oV); gV += (size_t)64 * ldV * 2; \
        if (HAS_AUX && tid < 64) { if (MODE == 0) sAux = (float)P.positions[tok0 + tload * 64 + tid]; else sAux = P.ckS[((size_t)b * 8 + h) * SEQ + tload * 64 + tid]; } \
        ++tload; } while (0)
#define SWRITE(bf) do { LAS char* Kb = lds + OFF_K + (bf) * SHM_K; LAS char* Vb = lds + OFF_V + (bf) * SHM_V; \
        if (HAS_N) { *(LAS bf16x8*)(Kb + kstN0) = sN0; *(LAS bf16x8*)(Kb + kstN1) = sN1; } if (HAS_R) *(LAS bf16x8*)(Kb + kstR) = sR; \
        *(LAS bf16x8*)(Vb + vst0) = sV0; *(LAS bf16x8*)(Vb + vst1) = sV1; \
        if (HAS_AUX && tid < 64) { const float val = (MODE == 0) ? slope2 * (sAux - xref) : (xref - sAux) * L2E; const unsigned vh = cvt_pk_bf16(val, 0.f) & 0xffffu; \
            const unsigned vl = cvt_pk_bf16(val - __uint_as_float(vh << 16), 0.f) & 0xffffu; LAS u32x4* kx = (LAS u32x4*)(lds + OFF_KX + (bf) * SHM_KX + tid * 32); \
            kx[0] = (u32x4){vh | (vl << 16), 0u, 0u, 0u}; kx[1] = (u32x4){0u, 0u, 0u, 0u}; \
            if (MODE == 0) ((LAS float*)(lds + OFF_KAUX))[(bf) * 64 + tid] = sAux; } } while (0)
        __syncthreads();
        SLOAD(); SWRITE(0); SLOAD();
        for (int j = 0; j < NT; ++j) {
            __syncthreads();
            const int bf = j & 1;
            if (j <= jmax) {
                const bool first = (j == 0);
                f32x16 p0, p1; { const float ini = first ? 0.f : -m_reg;
#pragma unroll
                  for (int r = 0; r < 16; ++r) { p0[r] = ini; p1[r] = ini; } }
                {
                  const LAS char* Kb = lds + OFF_K + bf * SHM_K;
                  const LAS char* kx = lds + OFF_KX + bf * SHM_KX + r32 * 32 + hi * 16;
                  constexpr int NS = NQ + (HAS_AUX ? 1 : 0);
                  bf16x8 ra[3], rb[3];
#define QLOAD(s_) do { if ((s_) < NQ) { const LAS char* kp = Kb + kb[(s_) & 3] + ((s_) >> 2) * 128; ra[(s_) % 3] = *(const LAS bf16x8*)kp; rb[(s_) % 3] = *(const LAS bf16x8*)(kp + 32 * RS); } \
                      else { ra[(s_) % 3] = *(const LAS bf16x8*)kx; rb[(s_) % 3] = *(const LAS bf16x8*)(kx + 1024); } } while (0)
                  QLOAD(0); QLOAD(1);
#pragma unroll
                  for (int st = 0; st < NS; ++st) {
                      if (st + 2 < NS) QLOAD(st + 2);
                      SBAR();
                      const bf16x8 qb = (st < NQ) ? qr[st < NQ ? st : 0] : qx;
                      p0 = __builtin_amdgcn_mfma_f32_32x32x16_bf16(ra[st % 3], qb, p0, 0, 0, 0);
                      p1 = __builtin_amdgcn_mfma_f32_32x32x16_bf16(rb[st % 3], qb, p1, 0, 0, 0);
                      SBAR(); }
#undef QLOAD
                }
                if (MODE == 0 && j == jmax) {
                    const LAS float* ka = (const LAS float*)(lds + OFF_KAUX) + bf * 64 + 4 * hi; const float s2 = 2.f * slope2;
#pragma unroll
                    for (int g = 0; g < 4; ++g) { const f32x4 a0 = *(const LAS f32x4*)(ka + 8 * g), a1 = *(const LAS f32x4*)(ka + 32 + 8 * g);
#pragma unroll
                        for (int i = 0; i < 4; ++i) { p0[4 * g + i] = fmaf(s2, fminf(qaux - a0[i], 0.f), p0[4 * g + i]); p1[4 * g + i] = fmaf(s2, fminf(qaux - a1[i], 0.f), p1[4 * g + i]); } }
                }
                if (MODE == 1 && j == jmax) {
                    const int rowt = q0w - 64 * j + r32;
#pragma unroll
                    for (int r = 0; r < 16; ++r) { const int kk = crow(r, hi); if (kk > rowt) p0[r] = -__builtin_inff(); if (kk + 32 > rowt) p1[r] = -__builtin_inff(); }
                }
                float alpha; partialSM2(p0, p1, first, m_reg, alpha);
                if (__any(alpha < 1.f)) { if (hi == 0) al_l[r32] = alpha; LDS_WAIT();
#pragma unroll
                    for (int d = 0; d < 4; ++d)
#pragma unroll
                        for (int r = 0; r < 16; ++r) o[d][r] *= al_l[crow(r, hi)]; }
                bf16x8 pa0, pa1, pa2, pa3; finishSM(p0, p1, alpha, l_reg, pa0, pa1, pa2, pa3); SBAR();
                const int vb = vb0 + bf * SHM_V;
                pv_all(o, vb, pa0, pa1, pa2, pa3);
            }
            if (j + 1 < NT) { SWRITE(bf ^ 1); if (j + 2 < NT) SLOAD(); }
        }
#undef SLOAD
#undef SWRITE
        if (hi == 0) li_l[r32] = l_reg; LDS_WAIT();
        float rli[16];
#pragma unroll
        for (int r = 0; r < 16; ++r) rli[r] = __builtin_amdgcn_rcpf(li_l[crow(r, hi)]);
        LDS_WAIT();
        bf16_t* Ob = (MODE == 0) ? P.oscr + (tok0 + q0w) * 2048 + mp * 1024 + h * 128 : P.obuf + (tok0 + q0w) * 3072 + MODE * 1024 + h * 128;
        constexpr int LDO = (MODE == 0) ? 2048 : 3072;
        int hi4 = hi * 4; asm volatile("" : "+v"(hi4));
#pragma unroll
        for (int r = 0; r < 16; ++r) { const unsigned voff = (unsigned)(((r & 3) + 8 * (r >> 2) + hi4) * LDO + r32) * 2u;
#pragma unroll
            for (int d = 0; d < 4; ++d) *(bf16_t*)((char*)Ob + voff + d * 64) = (bf16_t)(cvt_pk_bf16(o[d][r] * rli[r], 0.f) & 0xffffu); }
    }
#undef KSWZ
}
#undef SBAR
}

__device__ __forceinline__ int wsrc_in(int n) {
    if (n < 6144) return n;
    if (n < 7168) return 6152 + (n - 6144);
    if (n < 13312) return 7240 + (n - 7168);
    if (n < 13376) { const int j = n - 13312; return 7176 + (j & 1) * 32 + (j >> 1); }
    if (n < 13384) return 6144 + (n - 13376);
    return -1;
}
__device__ __forceinline__ int wsrc_uq(int n) { const int h = n / 192, d = n % 192; if (d < 128) return n; const int j = d - 128; return h * 192 + 128 + (j & 1) * 32 + (j >> 1); }
template <int KIND>
__device__ __forceinline__ void wconv_job(const float* W, const float* W2, int ldw, int K, int ndst, int nz, size_t wzs, size_t bzs, bf16_t* Bt, const float* ks, int kzs, LAS float* scr, int vcu, int G, int tid) {
    const int lane = tid & 63, wave = __builtin_amdgcn_readfirstlane(tid >> 6);
    const int nkb = K / 64, nnb = ndst / 64, per = nkb * nnb, ntile = per * nz, stride = G * 8;
    LAS char* img = (LAS char*)scr + wave * 9216;
    float v[64]; int src = 0; float cs = 1.0f;
#define WC_LOAD(t_) do { const int z_ = (t_) / per, r_ = (t_) % per, kb_ = r_ / nnb, nb_ = r_ % nnb, nd_ = nb_ * 64 + lane; \
        const float* Wp_ = W + (size_t)z_ * wzs; src = nd_; \
        if (KIND == 1) { src = wsrc_in(nd_); cs = (nd_ < 1024) ? att::Cfg<0>::SCALE * att::L2E : ((nd_ >= PC_BQ && nd_ < PC_BK) ? att::Cfg<1>::SCALE * att::L2E : 1.0f); }     \
        if (KIND == 2) src = wsrc_uq(nd_); \
        if (KIND == 3) { Wp_ = (((nb_ >> 1) & 1) ? W2 : W) + (size_t)z_ * wzs; src = (nb_ >> 2) * 128 + (nb_ & 1) * 64 + lane; } \
        const float* col_ = Wp_ + (size_t)(kb_ * 64) * ldw + (src >= 0 ? src : 0); \
        _Pragma("unroll") for (int i = 0; i < 64; ++i) v[i] = __builtin_nontemporal_load(col_ + (size_t)i * ldw); } while (0)
    int t = vcu * 8 + wave;
    if (t < ntile) WC_LOAD(t);
    while (t < ntile) {
        const int z = t / per, r = t % per, kb = r / nnb, nb = r % nnb, k0 = kb * 64, n0 = nb * 64;
        if (src < 0) {
#pragma unroll
            for (int i = 0; i < 64; ++i) v[i] = 0.f;
        }
        if (KIND == 1) {
#pragma unroll
            for (int i = 0; i < 64; ++i) v[i] *= cs; }
        if (ks) { const float* ksp = ks + (size_t)z * kzs + k0;
#pragma unroll
            for (int i = 0; i < 64; ++i) v[i] *= ksp[i]; }
#pragma unroll
        for (int c = 0; c < 8; ++c) { u32x4 o; o.x = cvt_pk_bf16(v[8 * c], v[8 * c + 1]); o.y = cvt_pk_bf16(v[8 * c + 2], v[8 * c + 3]); o.z = cvt_pk_bf16(v[8 * c + 4], v[8 * c + 5]); o.w = cvt_pk_bf16(v[8 * c + 6], v[8 * c + 7]);
            *(LAS u32x4*)(img + lane * 144 + c * 16) = o; }
        const int tn = t + stride;
        if (tn < ntile) WC_LOAD(tn);
        asm volatile("s_waitcnt lgkmcnt(0)" ::: "memory");
        bf16_t* dst = Bt + (size_t)z * bzs + (size_t)(n0 + (lane >> 3)) * K + k0 + (lane & 7) * 8;
#pragma unroll
        for (int i = 0; i < 8; ++i) { const u32x4 o = *(const LAS u32x4*)(img + ((lane >> 3) + 8 * i) * 144 + (lane & 7) * 16); *(u32x4*)(dst + (size_t)(8 * i) * K) = o; }
        asm volatile("s_waitcnt lgkmcnt(0)" ::: "memory");
        t = tn;
    }
#undef WC_LOAD
}
__device__ __forceinline__ void rmsnorm_rows(const float* x, const float* g, bf16_t* out, int vcu, int G, int wave, int lane) {
    f32x4 gv[8];
#pragma unroll
    for (int j = 0; j < 8; ++j) gv[j] = *((const f32x4*)g + lane + 64 * j);
    for (int m = vcu * 8 + wave; m < T; m += G * 8) {
        const f32x4* xr = (const f32x4*)(x + (size_t)m * DM) + lane; f32x4 v[8]; float s = 0.f;
#pragma unroll
        for (int j = 0; j < 8; ++j) { v[j] = xr[64 * j]; s += (v[j][0] * v[j][0] + v[j][1] * v[j][1]) + (v[j][2] * v[j][2] + v[j][3] * v[j][3]); }
        const float rstd = __builtin_amdgcn_rsqf(wave_sum(s) * (1.0f / DM) + NORM_EPS);
        u32x2* o8 = (u32x2*)(out + (size_t)m * DM) + lane;
#pragma unroll
        for (int j = 0; j < 8; ++j) { const f32x4 y = v[j] * rstd * gv[j]; u32x2 w; w.x = cvt_pk_bf16(y[0], y[1]); w.y = cvt_pk_bf16(y[2], y[3]); o8[64 * j] = w; }
    }
}
__device__ __forceinline__ void prep_phase(const bf16_t* proj, const float* tail, const int* positions, const float* fbias,
                                           float* rstdq, float* rstdkv, bf16_t* krot, float* ckS, LAS float* scr, int vcu, int G, int tid, int wave, int lane) {
    const float rfreq = __builtin_amdgcn_exp2f(-(float)(lane & 31) * 0.41524101186092f) * 0.15915494309189535f;
    for (int m = vcu * 8 + wave; m < T; m += G * 8) {
        const u32x4 a = *(const u32x4*)(proj + (size_t)m * LDP + PC_CQ + 8 * lane), b = *(const u32x4*)(proj + (size_t)m * LDP + PC_CKV + 8 * lane);
        float sa = 0.f, sb = 0.f;
#pragma unroll
        for (int i = 0; i < 4; ++i) { const float a0 = bflo(a[i]), a1 = bfhi(a[i]), b0 = bflo(b[i]), b1 = bfhi(b[i]); sa += a0 * a0 + a1 * a1; sb += b0 * b0 + b1 * b1; }
        sa = wave_sum(sa); sb = wave_sum(sb);
        if (lane == 0) { rstdq[m] = __builtin_amdgcn_rsqf(sa * (1.0f / 512.0f) + NORM_EPS); rstdkv[m] = __builtin_amdgcn_rsqf(sb * (1.0f / 512.0f) + NORM_EPS); }
        if (lane < 32) { const f32x2 xv = *((const f32x2*)(tail + (size_t)m * TAILW) + lane); const float rev = (float)positions[m] * rfreq, frc = rev - floorf(rev);
            const float cs = __builtin_amdgcn_cosf(frc), sn = __builtin_amdgcn_sinf(frc);
            ((unsigned*)(krot + (size_t)m * 64))[lane] = cvt_pk_bf16(xv.x * cs - xv.y * sn, xv.y * cs + xv.x * sn); }
    }
    for (int u = vcu; u < NB * 8; u += G) {
        const int b = u >> 3, h = u & 7; const float fb = fbias[h]; float v[8]; float run = 0.f;
#pragma unroll
        for (int i = 0; i < 8; ++i) { const float f = tail[((size_t)b * SEQ + tid * 8 + i) * TAILW + 64 + h] + fb;
            const float ls = -(fmaxf(-f, 0.f) + log1pf(__expf(-fabsf(f)))); run += ls; v[i] = run; }
        __syncthreads();
        scr[tid] = run; __syncthreads();
        for (int o = 1; o < 512; o <<= 1) { float t = (tid >= o) ? scr[tid - o] : 0.f; __syncthreads(); scr[tid] += t; __syncthreads(); }
        const float excl = scr[tid] - run;
#pragma unroll
        for (int i = 0; i < 8; ++i) ckS[((size_t)b * 8 + h) * SEQ + tid * 8 + i] = excl + v[i];
        __syncthreads();
    }
}

__device__ __forceinline__ void diff_combine(const bf16_t* oscr, const float* g, float lam, float out_scale, bf16_t* obuf, int vcu, int G, int wave, int lane) {
    f32x4 g0 = *(const f32x4*)(g + (lane & 15) * 8), g1 = *(const f32x4*)(g + (lane & 15) * 8 + 4);
    for (int m = vcu * 8 + wave; m < T; m += G * 8) {
#pragma unroll
        for (int c = 0; c < 2; ++c) {
            const u32x4 a = *(const u32x4*)(oscr + (size_t)m * 2048 + c * 512 + lane * 8), b = *(const u32x4*)(oscr + (size_t)m * 2048 + 1024 + c * 512 + lane * 8);
            float v[8]; float ss = 0.f;
#pragma unroll
            for (int i = 0; i < 4; ++i) { v[2 * i] = bflo(a[i]) - lam * bflo(b[i]); v[2 * i + 1] = bfhi(a[i]) - lam * bfhi(b[i]); ss += v[2 * i] * v[2 * i] + v[2 * i + 1] * v[2 * i + 1]; }
            ss = row_sum16(ss);
            const float rs = __builtin_amdgcn_rsqf(ss * (1.0f / 128.0f) + NORM_EPS) * out_scale;
            u32x4 w; w.x = cvt_pk_bf16(v[0] * rs * g0[0], v[1] * rs * g0[1]); w.y = cvt_pk_bf16(v[2] * rs * g0[2], v[3] * rs * g0[3]);
            w.z = cvt_pk_bf16(v[4] * rs * g1[0], v[5] * rs * g1[1]); w.w = cvt_pk_bf16(v[6] * rs * g1[2], v[7] * rs * g1[3]);
            *(u32x4*)(obuf + (size_t)m * 3072 + c * 512 + lane * 8) = w;
        }
    }
}

#define LADD(p, v) (void)__hip_atomic_fetch_add((p), (v), __ATOMIC_RELAXED, __HIP_MEMORY_SCOPE_WORKGROUP)
__device__ __forceinline__ void moe_route(const float* x, const float* g, const float* router_w, int* route, float* rstd2, unsigned* cnt, LAS unsigned char* lds, int vcu, int G, int tid, int wave, int lane) {
    LAS float* Wt = (LAS float*)lds; LAS unsigned* elist = (LAS unsigned*)(lds + 65536);
    for (int idx = tid; idx < DM * 8; idx += 512) Wt[(idx & 7) * DM + (idx >> 3)] = router_w[idx];
    __syncthreads();
    const int TPW = (T + G - 1) / G, t0 = vcu * TPW, t1 = (t0 + TPW < T) ? t0 + TPW : T;
    f32x4 gv[8];
#pragma unroll
    for (int j = 0; j < 8; ++j) gv[j] = *((const f32x4*)g + lane + 64 * j);
    for (int m = t0 + wave; m < t1; m += 8) {
        const f32x4* xr = (const f32x4*)(x + (size_t)m * DM) + lane; f32x4 v[8]; float s = 0.f;
#pragma unroll
        for (int j = 0; j < 8; ++j) { v[j] = xr[64 * j]; s += (v[j][0] * v[j][0] + v[j][1] * v[j][1]) + (v[j][2] * v[j][2] + v[j][3] * v[j][3]); }
        const float rstd = __builtin_amdgcn_rsqf(wave_sum(s) * (1.0f / DM) + NORM_EPS);
#pragma unroll
        for (int j = 0; j < 8; ++j) v[j] = v[j] * rstd * gv[j];
        float lg[8];
#pragma unroll
        for (int e = 0; e < 8; ++e) { float a = 0.f;
#pragma unroll
            for (int j = 0; j < 8; ++j) { const f32x4 w = *((const LAS f32x4*)(Wt + e * DM) + lane + 64 * j); a += (v[j][0] * w[0] + v[j][1] * w[1]) + (v[j][2] * w[2] + v[j][3] * w[3]); }
            lg[e] = wave_sum(a); }
        int e0 = 0; float v0 = lg[0];
#pragma unroll
        for (int e = 1; e < 8; ++e) if (lg[e] > v0) { v0 = lg[e]; e0 = e; }
        int e1 = -1; float v1 = -__builtin_inff();
#pragma unroll
        for (int e = 0; e < 8; ++e) if (e != e0 && lg[e] > v1) { v1 = lg[e]; e1 = e; }
        const float ex = __expf(v1 - v0), w0 = 1.0f / (1.0f + ex), w1 = ex * w0;
        if (lane == 0) { i32x4 r; r.x = e0; r.y = e1; r.z = __float_as_int(w0); r.w = __float_as_int(w1); *((i32x4*)route + m) = r; rstd2[m] = rstd; elist[m - t0] = (unsigned)e0 | ((unsigned)e1 << 8); }
    }
    __syncthreads();
    if (tid < 8) { unsigned c = 0; for (int i = 0; i < t1 - t0; ++i) { const unsigned w = elist[i]; c += ((w & 255u) == (unsigned)tid) + ((w >> 8) == (unsigned)tid); } cnt[vcu * 8 + tid] = c; }
    __syncthreads();
}
__device__ __forceinline__ void moe_gather(const float* x, const float* g, const int* route, const float* rstd2, const unsigned* cnt, int* slots, int* moe_off, bf16_t* hs,
                                           LAS unsigned char* lds, int vcu, int G, int tid, int wave, int lane) {
    LAS unsigned* tot = (LAS unsigned*)lds; LAS unsigned* base = tot + 8; LAS int* offp = (LAS int*)(tot + 16); LAS unsigned* elist = tot + 32; LAS int* slotl = (LAS int*)(tot + 32 + 1024);
    if (tid < 16) tot[tid] = 0u;
    __syncthreads();
    for (int w = tid; w < G; w += 512) { const u32x4 c0 = *((const u32x4*)cnt + 2 * w), c1 = *((const u32x4*)cnt + 2 * w + 1);
#pragma unroll
        for (int e = 0; e < 4; ++e) { LADD(&tot[e], c0[e]); LADD(&tot[4 + e], c1[e]); if (w < vcu) { LADD(&base[e], c0[e]); LADD(&base[4 + e], c1[e]); } } }
    __syncthreads();
    if (tid == 0) { int o = 0; for (int e = 0; e < 8; ++e) { offp[e] = o; o += (int)((tot[e] + 255u) & ~255u); } offp[8] = o; }
    __syncthreads();
    if (vcu == 0 && tid < 9) moe_off[tid] = offp[tid];
    const int TPW = (T + G - 1) / G, t0 = vcu * TPW, t1 = (t0 + TPW < T) ? t0 + TPW : T, nt = t1 - t0;
    for (int i = tid; i < nt; i += 512) { const i32x4 r = *((const i32x4*)route + t0 + i); elist[i] = (unsigned)r.x | ((unsigned)r.y << 8); }
    __syncthreads();
    for (int i = tid; i < nt; i += 512) { const unsigned w = elist[i], e0 = w & 255u, e1 = w >> 8; int r0 = 0, r1 = 0;
        for (int k = 0; k < i; ++k) { const unsigned q = elist[k], a = q & 255u, b = q >> 8; r0 += (a == e0) + (b == e0); r1 += (a == e1) + (b == e1); }
        const int s0 = offp[e0] + (int)base[e0] + r0, s1 = offp[e1] + (int)base[e1] + r1;
        slotl[2 * i] = s0; slotl[2 * i + 1] = s1; slots[2 * (t0 + i)] = s0; slots[2 * (t0 + i) + 1] = s1; }
    __syncthreads();
    f32x4 gv[8];
#pragma unroll
    for (int j = 0; j < 8; ++j) gv[j] = *((const f32x4*)g + lane + 64 * j);
    for (int m = t0 + wave; m < t1; m += 8) {
        const f32x4* xr = (const f32x4*)(x + (size_t)m * DM) + lane; const float rstd = rstd2[m]; const int s0 = slotl[2 * (m - t0)], s1 = slotl[2 * (m - t0) + 1];
        u32x2* o0 = (u32x2*)(hs + (size_t)s0 * DM) + lane; u32x2* o1 = (u32x2*)(hs + (size_t)s1 * DM) + lane;
#pragma unroll
        for (int j = 0; j < 8; ++j) { const f32x4 y = xr[64 * j] * rstd * gv[j]; u32x2 w; w.x = cvt_pk_bf16(y[0], y[1]); w.y = cvt_pk_bf16(y[2], y[3]); o0[64 * j] = w; o1[64 * j] = w; }
    }
    __syncthreads();
}
__device__ __forceinline__ void final_phase(const float* x, const bf16_t* ys, const int* route, const int* slots, const float* g, float* out, const LAS int* late, bool want_late, int vcu, int G, int wave, int lane) {
    f32x4 gv[8];
#pragma unroll
    for (int j = 0; j < 8; ++j) gv[j] = *((const f32x4*)g + lane + 64 * j);
    for (int m = vcu * 8 + wave; m < T; m += G * 8) {
        const int s0 = __builtin_amdgcn_readfirstlane(slots[2 * m]), s1 = __builtin_amdgcn_readfirstlane(slots[2 * m + 1]);
        if (((late[s0 >> 8] | late[s1 >> 8]) != 0) != want_late) continue;
        const i32x4 r = *((const i32x4*)route + m); const float w0 = __int_as_float(r.z), w1 = __int_as_float(r.w);
        const f32x4* xr = (const f32x4*)(x + (size_t)m * DM) + lane; const u32x2* y0 = (const u32x2*)(ys + (size_t)s0 * DM) + lane; const u32x2* y1 = (const u32x2*)(ys + (size_t)s1 * DM) + lane;
        f32x4 v[8]; float s = 0.f;
#pragma unroll
        for (int j = 0; j < 8; ++j) { const u32x2 a = y0[64 * j], b = y1[64 * j]; f32x4 t = xr[64 * j];
            t[0] += w0 * bflo(a.x) + w1 * bflo(b.x); t[1] += w0 * bfhi(a.x) + w1 * bfhi(b.x); t[2] += w0 * bflo(a.y) + w1 * bflo(b.y); t[3] += w0 * bfhi(a.y) + w1 * bfhi(b.y);
            v[j] = t; s += (t[0] * t[0] + t[1] * t[1]) + (t[2] * t[2] + t[3] * t[3]); }
        const float rstd = __builtin_amdgcn_rsqf(wave_sum(s) * (1.0f / DM) + NORM_EPS);
        f32x4* o = (f32x4*)(out + (size_t)m * DM) + lane;
#pragma unroll
        for (int j = 0; j < 8; ++j) o[64 * j] = v[j] * rstd * gv[j];
    }
}

constexpr int NWAVES = 8, PH_PER_LAYER = 13, NPH = 1 + 2 * PH_PER_LAYER;
struct Args {
    const float* x; const int* positions; const float* attn_norm_g; const float* w_in; const float* diff_lambda; const float* diff_subln_g; const float* fox_bias;
    const float* q_norm_g; const float* kv_norm_g; const float* w_uq; const float* w_uk; const float* w_uv; const float* w_branch; const float* w_out; const float* ffn_norm_g;
    const float* dense_w1; const float* dense_w3; const float* dense_w2; const float* router_w; const float* expert_w1; const float* expert_w3; const float* expert_w2; const float* final_norm_g;
    float* out; unsigned char* ws; int ph_lo, ph_hi, li, pad;
};
__host__ __device__ constexpr bool phase_exists(int k) {
    if (k == 0) return true;
    const int l = (k - 1) / PH_PER_LAYER, p = (k - 1) % PH_PER_LAYER;
    if (l == 0) return p >= 1 && p <= 10;
    return true;
}

typedef const __attribute__((address_space(4))) Args* KArgs;
__device__ __forceinline__ KArgs kargs() { KArgs p = (KArgs)__builtin_amdgcn_kernarg_segment_ptr(); asm volatile("" : "+s"(p)); return p; }

__global__ void __launch_bounds__(NWAVES * 64, 2) mega_fwd(Args a) {
    extern __shared__ __attribute__((aligned(16))) unsigned char lds_raw[];
    LAS unsigned char* lds = (LAS unsigned char*)lds_raw;
    const int G = gridDim.x, bx = blockIdx.x, vcu = (G % 8 == 0) ? (bx % 8) * (G / 8) + bx / 8 : bx;
    volatile LAS unsigned* MISC = (volatile LAS unsigned*)(lds + MISC_OFF);
    for (int u = threadIdx.x; u < (LDS_BYTES - LDSCTL_OFF) / 4; u += NWAVES * 64) ((LAS unsigned*)(lds + LDSCTL_OFF))[u] = 0u;
    __syncthreads();
    XcdBarrier bar = xcd_barrier_post((unsigned*)(a.ws + WS_CTL) + CW_BAR + a.li * XCD_BAR_WORDS, MISC + 8);
    const int lo = a.ph_lo, hi = a.ph_hi;
#ifndef ATT_MODES
#define ATT_MODES 7
#endif
#ifndef PH_ENABLE
#define PH_ENABLE 0xFFFFFFFFu
#endif
#define IN(k) (lo <= (k) && (k) < hi)
#define EN(kind) (((PH_ENABLE) >> (kind)) & 1u)
#ifndef PROBE_REP_MASK
#define PROBE_REP_MASK 0u
#endif
#define REPS(kind) for (int rep_ = 0; rep_ < ((((PROBE_REP_MASK) >> (kind)) & 1u) ? PROBE_REP_N : 1); ++rep_)
#ifndef PROBE_REP_N
#define PROBE_REP_N 2
#endif
#ifndef PROBE_BAR2
#define PROBE_BAR2 0
#endif
#define SEAM(k) do { if (IN(k) && (k) + 1 < hi) { xcd_barrier(bar); if (PROBE_BAR2) xcd_barrier(bar); } } while (0)
#define PHASE_LOCALS KArgs A = kargs(); unsigned char* ws = A->ws; int tid = threadIdx.x; asm volatile("" : "+v"(tid)); const int lane = tid & 63, wave = __builtin_amdgcn_readfirstlane(tid >> 6); (void)lane; (void)wave; (void)ws
#define WSP(T_, off) ((T_*)(ws + (off)))

    if (EN(0) && IN(0)) REPS(0) {
        PHASE_LOCALS; LAS float* scr = (LAS float*)lds;
        wconv_job<1>(A->w_in, nullptr, N_IN_SRC, DM, NIN, 2, (size_t)DM * N_IN_SRC, (size_t)NIN * DM, WSP(bf16_t, WS_WIN), nullptr, 0, scr, vcu, G, tid);
        wconv_job<2>(A->w_uq, nullptr, 1536, 512, 1536, 2, (size_t)512 * 1536, (size_t)1536 * 512, WSP(bf16_t, WS_WUQ), A->q_norm_g, 512, scr, vcu, G, tid);
        wconv_job<0>(A->w_uk, nullptr, 1024, 512, 1024, 2, (size_t)512 * 1024, (size_t)2048 * 512, WSP(bf16_t, WS_WUKV), A->kv_norm_g, 512, scr, vcu, G, tid);
        wconv_job<0>(A->w_uv, nullptr, 1024, 512, 1024, 2, (size_t)512 * 1024, (size_t)2048 * 512, WSP(bf16_t, WS_WUKV) + (size_t)1024 * 512, A->kv_norm_g, 512, scr, vcu, G, tid);
        wconv_job<0>(A->w_branch, nullptr, DM, 1024, DM, 6, (size_t)1024 * DM, (size_t)DM * 1024, WSP(bf16_t, WS_WBR), nullptr, 0, scr, vcu, G, tid);
        wconv_job<0>(A->w_out, nullptr, DM, DM, DM, 2, (size_t)DM * DM, (size_t)DM * DM, WSP(bf16_t, WS_WOUT), nullptr, 0, scr, vcu, G, tid);
        wconv_job<3>(A->dense_w1, A->dense_w3, DFF, DM, 2 * DFF, 1, 0, 0, WSP(bf16_t, WS_WD13), nullptr, 0, scr, vcu, G, tid);
        wconv_job<0>(A->dense_w2, nullptr, DM, DFF, DM, 1, 0, 0, WSP(bf16_t, WS_WD2), nullptr, 0, scr, vcu, G, tid);
        rmsnorm_rows(A->x, A->attn_norm_g, WSP(bf16_t, WS_H), vcu, G, wave, lane);
    }
    SEAM(0);

    for (int l = 0; l < DEPTH; ++l) {
        const int pb = 1 + l * PH_PER_LAYER;
        if (hi <= pb || lo >= pb + PH_PER_LAYER) continue;

        if (l > 0) { if (EN(1) && IN(pb + 0)) REPS(1) { PHASE_LOCALS; rmsnorm_rows(A->out, A->attn_norm_g + l * DM, WSP(bf16_t, WS_H), vcu, G, wave, lane); } SEAM(pb + 0); }

        if (EN(2) && IN(pb + 1)) REPS(2) {
            PHASE_LOCALS;
            pg8::Gemm g{WSP(bf16_t, WS_H), DM, 0, WSP(bf16_t, WS_WIN + (size_t)l * SZ_WIN), DM, 0}; pg8::StaticOrder S; S.init(T / 256, NIN / 256, G, bx);
            pg8::EpiProj E{WSP(bf16_t, WS_PROJ), WSP(float, WS_TAIL)};
            pg8::gemm_phase(lds, g, S, E);
        }
        SEAM(pb + 1);

        if (EN(3) && IN(pb + 2)) REPS(3) { PHASE_LOCALS;
            prep_phase(WSP(bf16_t, WS_PROJ), WSP(float, WS_TAIL), A->positions, A->fox_bias + l * 8, WSP(float, MS_RSTDQ), WSP(float, MS_RSTDKV), WSP(bf16_t, WS_KROT), WSP(float, MS_CKS),
                       (LAS float*)lds, vcu, G, tid, wave, lane); }
        SEAM(pb + 2);

        if (EN(4) && IN(pb + 3)) REPS(4) {
            { PHASE_LOCALS;
              pg8::Gemm g{WSP(bf16_t, WS_PROJ) + PC_CQ, LDP, 0, WSP(bf16_t, WS_WUQ + (size_t)l * SZ_WUQ), 512, 0}; pg8::StaticOrder S; S.init(T / 256, 1536 / 256, G, bx);
              pg8::EpiQ E{WSP(bf16_t, WS_QM), WSP(float, MS_RSTDQ), A->positions, att::Cfg<2>::SCALE * att::L2E};
              pg8::gemm_phase(lds, g, S, E); }
            { PHASE_LOCALS;
              pg8::Gemm g{WSP(bf16_t, WS_PROJ) + PC_CKV, LDP, 0, WSP(bf16_t, WS_WUKV + (size_t)l * SZ_WUKV), 512, 0}; pg8::StaticOrder S; S.init(T / 256, 2048 / 256, G, bx);
              pg8::EpiBf16 E{WSP(bf16_t, WS_KNV), 2048, WSP(float, MS_RSTDKV)};
              pg8::gemm_phase(lds, g, S, E); }
        }
        SEAM(pb + 3);

        const float lam_init = (l == 0) ? 0.2f : 0.35550906759f;
        if (EN(5) && IN(pb + 4)) REPS(5) {
            PHASE_LOCALS;
            att::AttnP P{WSP(bf16_t, WS_PROJ), WSP(bf16_t, WS_QM), WSP(bf16_t, WS_KNV), WSP(bf16_t, WS_KROT), A->positions, WSP(float, MS_CKS), WSP(bf16_t, WS_OBUF), WSP(bf16_t, WS_MERGED)};
            if (ATT_MODES & 1) for (int u = vcu; u < 512; u += G) for (int hf = 0; hf < 2; ++hf) att::attn_unit<0>(P, u >> 6, (u >> 3) & 7, hf ? 15 - (u & 7) : (u & 7), (LAS char*)lds);
            if (ATT_MODES & 2) for (int u = vcu; u < 512; u += G) for (int hf = 0; hf < 2; ++hf) att::attn_unit<1>(P, u >> 6, (u >> 3) & 7, hf ? 15 - (u & 7) : (u & 7), (LAS char*)lds);
            if (ATT_MODES & 4) for (int u = vcu; u < 512; u += G) for (int hf = 0; hf < 2; ++hf) att::attn_unit<2>(P, u >> 6, (u >> 3) & 7, hf ? 15 - (u & 7) : (u & 7), (LAS char*)lds);
            __syncthreads();
        }
        SEAM(pb + 4);

        if (EN(16) && IN(pb + 5)) REPS(16) {
            PHASE_LOCALS;
            const float* dl = A->diff_lambda + l * 256; const float p = dl[lane] * dl[64 + lane], q = dl[128 + lane] * dl[192 + lane];
            const float lam = __expf(wave_sum(p)) - __expf(wave_sum(q)) + lam_init;
            diff_combine(WSP(bf16_t, WS_MERGED), A->diff_subln_g + l * 128, lam, 1.0f - lam_init, WSP(bf16_t, WS_OBUF), vcu, G, wave, lane);
        }
        SEAM(pb + 5);

        if (EN(6) && IN(pb + 6)) REPS(6) {
            PHASE_LOCALS;
            pg8::Gemm g{WSP(bf16_t, WS_OBUF), 3072, 1024, WSP(bf16_t, WS_WBR + (size_t)l * SZ_WBR), 1024, (size_t)DM * 1024}; pg8::Z3Order S; S.init(T / 256, DM / 256, G, bx);
            pg8::EpiBranch E{WSP(bf16_t, WS_MERGED), WSP(bf16_t, WS_PROJ)};
            pg8::gemm_phase(lds, g, S, E);
        }
        SEAM(pb + 6);

        if (EN(7) && IN(pb + 7)) REPS(7) {
            PHASE_LOCALS;
            pg8::Gemm g{WSP(bf16_t, WS_MERGED), DM, 0, WSP(bf16_t, WS_WOUT + (size_t)l * SZ_WOUT), DM, 0}; pg8::StaticOrder S; S.init(T / 256, DM / 256, G, bx);
            pg8::EpiResid E{(l == 0) ? A->x : (const float*)A->out, (((PROBE_REP_MASK >> 7) & 1u) && rep_ == 0) ? WSP(float, WS_QM) : A->out};
            pg8::gemm_phase(lds, g, S, E);
        }
        SEAM(pb + 7);

        if (l == 0) {
            if (EN(8) && IN(pb + 8)) REPS(8) { PHASE_LOCALS; rmsnorm_rows(A->out, A->ffn_norm_g, WSP(bf16_t, WS_H), vcu, G, wave, lane); }
            SEAM(pb + 8);
            if (EN(9) && IN(pb + 9)) REPS(9) {
                PHASE_LOCALS;
                pg8::Gemm g{WSP(bf16_t, WS_H), DM, 0, WSP(bf16_t, WS_WD13), DM, 0}; pg8::StaticOrder S; S.init(T / 256, 2 * DFF / 256, G, bx);
                pg8::EpiSwiglu E{WSP(bf16_t, WS_UD), DFF};
                pg8::gemm_phase(lds, g, S, E);
            }
            SEAM(pb + 9);
            if (EN(10) && IN(pb + 10)) REPS(10) {
                PHASE_LOCALS;
                pg8::Gemm g{WSP(bf16_t, WS_UD), DFF, 0, WSP(bf16_t, WS_WD2), DFF, 0}; pg8::StaticOrder S; S.init(T / 256, DM / 256, G, bx);
                pg8::EpiResid E{A->out, (((PROBE_REP_MASK >> 10) & 1u) && rep_ == 0) ? WSP(float, WS_QM) : A->out};
                pg8::gemm_phase(lds, g, S, E);
            }
            SEAM(pb + 10);
        } else {
            if (EN(11) && IN(pb + 8)) REPS(11) {
                PHASE_LOCALS; LAS float* scr = (LAS float*)lds;
                wconv_job<3>(A->expert_w1, A->expert_w3, DFFE, DM, 2 * DFFE, NEXP, (size_t)DM * DFFE, (size_t)2 * DFFE * DM, WSP(bf16_t, WS_EW13), nullptr, 0, scr, vcu, G, tid);
                wconv_job<0>(A->expert_w2, nullptr, DM, DFFE, DM, NEXP, (size_t)DFFE * DM, (size_t)DM * DFFE, WSP(bf16_t, WS_EW2), nullptr, 0, scr, vcu, G, tid);
                __syncthreads();
                moe_route(A->out, A->ffn_norm_g + DM, A->router_w, WSP(int, MS_ROUTE), WSP(float, MS_RSTD2), WSP(unsigned, MS_CNT), lds, vcu, G, tid, wave, lane);
            }
            SEAM(pb + 8);
            if (EN(12) && IN(pb + 9)) REPS(12) { PHASE_LOCALS;
                moe_gather(A->out, A->ffn_norm_g + DM, WSP(int, MS_ROUTE), WSP(float, MS_RSTD2), WSP(unsigned, MS_CNT), WSP(int, MS_SLOTS), WSP(int, MS_MOEOFF), WSP(bf16_t, WS_HS), lds, vcu, G, tid, wave, lane); }
            SEAM(pb + 9);
            if (EN(13) && IN(pb + 10)) REPS(13) {
                PHASE_LOCALS;
                pg8::MoeOrder S; const int* moe_off = WSP(int, MS_MOEOFF);
#pragma unroll
                for (int e = 0; e < 9; ++e) S.off[e] = __builtin_amdgcn_readfirstlane(moe_off[e]);
                S.init(S.off[8] / 256, 2 * DFFE / 256, G, bx);
                pg8::Gemm g{WSP(bf16_t, WS_HS), DM, 0, WSP(bf16_t, WS_EW13), DM, (size_t)2 * DFFE * DM};
                pg8::EpiSwiglu E{WSP(bf16_t, WS_UM), DFFE};
                pg8::gemm_phase(lds, g, S, E);
            }
            SEAM(pb + 10);
            if (EN(14) && IN(pb + 11)) REPS(14) {
                PHASE_LOCALS;
                pg8::MoeRange S; const int* moe_off = WSP(int, MS_MOEOFF);
#pragma unroll
                for (int e = 0; e < 9; ++e) S.off[e] = __builtin_amdgcn_readfirstlane(moe_off[e]);
                S.init(S.off[8] / 256, DM / 256, G, bx); S.i0 = 0; S.i1 = S.nwg / G;
                pg8::Gemm g{WSP(bf16_t, WS_UM), DFFE, 0, WSP(bf16_t, WS_EW2), DFFE, (size_t)DM * DFFE};
                pg8::EpiBf16 E{WSP(bf16_t, WS_HS), DM, nullptr};
                pg8::gemm_phase(lds, g, S, E);
            }
            SEAM(pb + 11);
            if (EN(15) && IN(pb + 12)) REPS(15) { PHASE_LOCALS;
                pg8::MoeRange S; const int* moe_off = WSP(int, MS_MOEOFF);
#pragma unroll
                for (int e = 0; e < 9; ++e) S.off[e] = __builtin_amdgcn_readfirstlane(moe_off[e]);
                S.init(S.off[8] / 256, DM / 256, G, bx);
                const int R = S.nwg / G, Lc = S.nwg - R * G;
                LAS int* late = (LAS int*)(lds + LDSCTL_OFF + 8192);
                for (int u = tid; u < 512; u += NWAVES * 64) late[u] = 0;
                __syncthreads();
                if (tid < Lc) { pg8::StaticOrder Q; Q.init(S.nM, S.nN, G, tid); int pm, pn; if (Q.tile(R, pm, pn)) late[pm] = 1; }
                __syncthreads();
                if (bx < Lc) {
                    S.i0 = R; S.i1 = R + 1;
                    pg8::Gemm g{WSP(bf16_t, WS_UM), DFFE, 0, WSP(bf16_t, WS_EW2), DFFE, (size_t)DM * DFFE};
                    pg8::EpiBf16 E{WSP(bf16_t, WS_HS), DM, nullptr};
                    pg8::gemm_phase(lds, g, S, E);
                } else final_phase(A->out, WSP(bf16_t, WS_HS), WSP(int, MS_ROUTE), WSP(int, MS_SLOTS), A->final_norm_g, A->out, late, false, bx - Lc, G - Lc, wave, lane);
                xcd_barrier(bar);
                final_phase(A->out, WSP(bf16_t, WS_HS), WSP(int, MS_ROUTE), WSP(int, MS_SLOTS), A->final_norm_g, A->out, late, true, vcu, G, wave, lane);
            }
        }
    }
#undef IN
#undef EN
#undef SEAM
#undef PHASE_LOCALS
#undef WSP
}

extern "C" void kernel_launch(void* const* d_in, const int* in_sizes, int n_in, void* d_out, int out_size, void* d_ws, size_t ws_size, hipStream_t stream) {
    static int grid = 0;
    if (grid == 0) {
        if (n_in != 23 || in_sizes[0] != T * DM || out_size != T * DM || ws_size < WS_NEED) {
            fprintf(stderr, "kernel_launch: shape mismatch: n_in %d in0 %d out %d ws %zu (need %zu)\n", n_in, n_in > 0 ? in_sizes[0] : -1, out_size, ws_size, (size_t)WS_NEED); grid = -1; return; }
        int dev = 0, cus = 0, per_cu = 0;
        if (hipGetDevice(&dev) != hipSuccess || hipDeviceGetAttribute(&cus, hipDeviceAttributeMultiprocessorCount, dev) != hipSuccess) { fprintf(stderr, "kernel_launch: device query failed\n"); grid = -1; return; }
        if (hipFuncSetAttribute((const void*)mega_fwd, hipFuncAttributeMaxDynamicSharedMemorySize, LDS_BYTES) != hipSuccess) { fprintf(stderr, "kernel_launch: hipFuncSetAttribute failed\n"); grid = -1; return; }
        if (hipOccupancyMaxActiveBlocksPerMultiprocessor(&per_cu, (const void*)mega_fwd, NWAVES * 64, LDS_BYTES) != hipSuccess || per_cu < 1)
            fprintf(stderr, "kernel_launch: note: occupancy query reports %d workgroups per CU\n", per_cu);
        (void)hipGetLastError();
        grid = cus;
    }
    if (grid < 0) return;
    if (hipMemsetAsync((char*)d_ws + WS_CTL, 0, CTL_ZERO_BYTES, stream) != hipSuccess) { fprintf(stderr, "kernel_launch: memset failed\n"); return; }
    Args a{};
    a.x = (const float*)d_in[0]; a.positions = (const int*)d_in[1]; a.attn_norm_g = (const float*)d_in[2]; a.w_in = (const float*)d_in[3]; a.diff_lambda = (const float*)d_in[4];
    a.diff_subln_g = (const float*)d_in[5]; a.fox_bias = (const float*)d_in[6]; a.q_norm_g = (const float*)d_in[7]; a.kv_norm_g = (const float*)d_in[8]; a.w_uq = (const float*)d_in[9];
    a.w_uk = (const float*)d_in[10]; a.w_uv = (const float*)d_in[11]; a.w_branch = (const float*)d_in[12]; a.w_out = (const float*)d_in[13]; a.ffn_norm_g = (const float*)d_in[14];
    a.dense_w1 = (const float*)d_in[15]; a.dense_w3 = (const float*)d_in[16]; a.dense_w2 = (const float*)d_in[17]; a.router_w = (const float*)d_in[18]; a.expert_w1 = (const float*)d_in[19];
    a.expert_w3 = (const float*)d_in[20]; a.expert_w2 = (const float*)d_in[21]; a.final_norm_g = (const float*)d_in[22];
    a.out = (float*)d_out; a.ws = (unsigned char*)d_ws;
#if MK_ONE_LAUNCH
    a.ph_lo = 0; a.ph_hi = NPH; a.li = 0;
    hipLaunchKernelGGL(mega_fwd, dim3(grid), dim3(NWAVES * 64), LDS_BYTES, stream, a);
#else
    int li = 0;
    for (int k = 0; k < NPH; ++k) { if (!phase_exists(k)) continue;
        a.ph_lo = k; a.ph_hi = k + 1; a.li = li++;
        hipLaunchKernelGGL(mega_fwd, dim3(grid), dim3(NWAVES * 64), LDS_BYTES, stream, a); }
#endif
    const hipError_t le = hipPeekAtLastError();
    if (le != hipSuccess) fprintf(stderr, "kernel_launch: launch failed: %s\n", hipGetErrorName(le));
}
```

```cpp
#include <hip/hip_runtime.h>
#include <cstdio>
#include <cstdint>

#ifndef MK_ONE_LAUNCH
#define MK_ONE_LAUNCH 1
#endif

#define GAS __attribute__((address_space(1)))
#define LAS __attribute__((address_space(3)))
typedef unsigned short bf16_t;
typedef short bf16x8 __attribute__((ext_vector_type(8)));
typedef short s16x4 __attribute__((ext_vector_type(4)));
typedef float f32x4 __attribute__((ext_vector_type(4)));
typedef float f32x2 __attribute__((ext_vector_type(2)));
typedef float f32x16 __attribute__((ext_vector_type(16)));
typedef unsigned u32x4 __attribute__((ext_vector_type(4)));
typedef unsigned u32x2 __attribute__((ext_vector_type(2)));
typedef int i32x4 __attribute__((ext_vector_type(4)));

constexpr int NB = 8, SEQ = 4096, T = NB * SEQ, DM = 2048, DEPTH = 2;
constexpr int N_IN_SRC = 13384, NIN = 13568, LDP = 13312, TAILW = 256;
constexpr int DFF = 5632, NEXP = 8, DFFE = 7168;
constexpr float NORM_EPS = 1e-6f;
constexpr int PC_AQ = 0, PC_AK = 1024, PC_AV = 2048, PC_BQ = 3072, PC_BK = 4096, PC_BV = 5120, PC_CQ = 6144, PC_CKV = 6656, PC_GATE = 7168;
constexpr int MOE_ROWS = 2 * T + 2048;

constexpr size_t MiB = 1u << 20;
constexpr size_t WS_CTL = 0, CTL_ZERO_BYTES = 1 * MiB;
constexpr size_t WS_MISC = 3 * MiB;
constexpr size_t MS_RSTDQ = WS_MISC, MS_RSTDKV = MS_RSTDQ + (size_t)T * 4, MS_CKS = MS_RSTDKV + (size_t)T * 4, MS_ROUTE = MS_CKS + (size_t)NB * 8 * SEQ * 4,
                 MS_RSTD2 = MS_ROUTE + (size_t)T * 16, MS_SLOTS = MS_RSTD2 + (size_t)T * 4, MS_CNT = MS_SLOTS + (size_t)T * 8, MS_MOEOFF = MS_CNT + 1024 * 8 * 4,
                 MS_LAM = MS_MOEOFF + 256, MS_END = MS_LAM + 256;
static_assert(MS_END <= 8 * MiB, "misc region");
constexpr size_t WS_BASE = 8 * MiB;
constexpr size_t SZ_WIN = (size_t)NIN * DM * 2, SZ_WUQ = (size_t)1536 * 512 * 2, SZ_WUKV = (size_t)2048 * 512 * 2, SZ_WBR = (size_t)3 * 2048 * 1024 * 2, SZ_WOUT = (size_t)DM * DM * 2;
constexpr size_t WS_WIN = WS_BASE, WS_WD13 = WS_WIN + 2 * SZ_WIN, WS_WD2 = WS_WD13 + (size_t)2 * DFF * DM * 2, WS_H = WS_WD2 + (size_t)DM * DFF * 2,
                 WS_WUQ = WS_H + (size_t)T * DM * 2, WS_WUKV = WS_WUQ + 2 * SZ_WUQ, WS_TAIL = WS_WUKV + 2 * SZ_WUKV, WS_EARLY_END = WS_TAIL + (size_t)T * TAILW * 4 + (size_t)T * DM * 2  ,
                 WS_WBR = WS_EARLY_END, WS_WOUT = WS_WBR + 2 * SZ_WBR,
                 WS_PROJ = WS_WOUT + 2 * SZ_WOUT, WS_QM = WS_PROJ + (size_t)T * LDP * 2, WS_KNV = WS_QM + (size_t)T * 1536 * 2,
                 WS_KROT = WS_KNV + (size_t)T * 2048 * 2, WS_OBUF = WS_KROT + (size_t)T * 64 * 2, WS_MIX_END = WS_OBUF + (size_t)T * 3072 * 2;
constexpr size_t WS_MERGED = WS_QM;
static_assert((size_t)T * DM * 2 <= (size_t)T * (1536 + 2048) * 2, "merged fits in qm | knv");
constexpr size_t WS_TAIL1 = WS_OBUF;
constexpr size_t WS_UD = WS_PROJ;
static_assert((size_t)T * DFF * 2 <= (size_t)T * LDP * 2, "dense hidden fits in proj");
constexpr size_t WS_EW13 = WS_BASE, WS_HS = WS_EW13 + (size_t)NEXP * 2 * DFFE * DM * 2,
                 WS_UM = WS_HS + (size_t)MOE_ROWS * DM * 2, WS_MOE_END = WS_UM + (size_t)MOE_ROWS * DFFE * 2;
constexpr size_t WS_EW2 = WS_MIX_END > WS_MOE_END ? WS_MIX_END : WS_MOE_END;
constexpr size_t WS_NEED = WS_EW2 + (size_t)NEXP * DM * DFFE * 2;
constexpr int EARLY_EXP = 8;
static_assert(WS_EW13 + (size_t)EARLY_EXP * 2 * DFFE * DM * 2 <= WS_EARLY_END, "the early experts' copies must stay inside [WIN, WD13, WD2, H, WUQ, WUKV, TAIL, spare]");
static_assert(WS_NEED <= 2134232128ull, "workspace map exceeds the guaranteed minimum");
constexpr int CW_TMO = 0, CW_BAR = 4096;

constexpr int RING_BYTES = 131072, LDSCTL_OFF = RING_BYTES, MISC_OFF = LDSCTL_OFF + 320, LDS_BYTES = 147456;

#define RLX_AGENT __ATOMIC_RELAXED, __HIP_MEMORY_SCOPE_AGENT
#define LDS_WAIT() asm volatile("s_waitcnt lgkmcnt(0)" ::: "memory")
#define VM_WAIT() asm volatile("s_waitcnt vmcnt(0)" ::: "memory")
__device__ __forceinline__ unsigned cvt_pk_bf16(float lo, float hi) { unsigned r; asm volatile("v_cvt_pk_bf16_f32 %0, %1, %2" : "=v"(r) : "v"(lo), "v"(hi)); return r; }
__device__ __forceinline__ float bf2f(unsigned short h) { return __uint_as_float((unsigned)h << 16); }
__device__ __forceinline__ float bflo(unsigned w) { return __uint_as_float(w << 16); }
__device__ __forceinline__ float bfhi(unsigned w) { return __uint_as_float(w & 0xffff0000u); }
template <int CTRL> __device__ __forceinline__ float dpp_f(float v) { return __int_as_float(__builtin_amdgcn_update_dpp(0, __float_as_int(v), CTRL, 0xf, 0xf, true)); }
__device__ __forceinline__ float row_sum16(float v) {
    v += dpp_f<0xB1>(v);
    v += dpp_f<0x4E>(v);
    v += dpp_f<0x141>(v);
    v += dpp_f<0x140>(v);
    return v;
}
__device__ __forceinline__ float wave_sum(float v) {
    v = row_sum16(v);
    const int i = __float_as_int(v);
    return (__int_as_float(__builtin_amdgcn_readlane(i, 0)) + __int_as_float(__builtin_amdgcn_readlane(i, 16))) + (__int_as_float(__builtin_amdgcn_readlane(i, 32)) + __int_as_float(__builtin_amdgcn_readlane(i, 48)));
}
__device__ __forceinline__ float sigmoidf_(float x) { return __builtin_amdgcn_rcpf(1.0f + __expf(-x)); }

#define XB_TMO      128
#define XB_XCNT(j)  (256  + 64 * (j))
#define XB_XSUB(j)  (1280 + 64 * (j))
#define XB_XGEN(j)  (2304 + 64 * (j))
#define XB_TOP      3328
#define XB_TOPGEN   3392
#define XCD_BAR_WORDS 3456
#define XB_SPIN_CAP (1u << 22)
__device__ __forceinline__ unsigned xb_ld(unsigned* p)              { return __hip_atomic_load(p, __ATOMIC_RELAXED, __HIP_MEMORY_SCOPE_AGENT); }
__device__ __forceinline__ unsigned xb_add(unsigned* p, unsigned v) { return __hip_atomic_fetch_add(p, v, __ATOMIC_RELAXED, __HIP_MEMORY_SCOPE_AGENT); }
__device__ __forceinline__ unsigned xb_xcc_id() { return (unsigned)__builtin_amdgcn_s_getreg((3 << 11) | 20) & 0xFu; }
#define XB_SPIN(cond, bar) do { unsigned _sp = 0; while (cond) { __builtin_amdgcn_s_sleep(1); \
    if ((++_sp & 255u) == 0u) { if (xb_ld(&(bar)[XB_TMO])) break; if (_sp > XB_SPIN_CAP) { atomicAdd(&(bar)[XB_TMO], 1u); break; } } } } while (0)
struct XcdBarrier { unsigned* bar; unsigned x; volatile LAS unsigned* st; };
__device__ __forceinline__ XcdBarrier xcd_barrier_post(unsigned* bar, volatile LAS unsigned* st) {
    XcdBarrier b; b.bar = bar; b.x = xb_xcc_id(); b.st = st;
    if (threadIdx.x == 0) (void)xb_add(&bar[XB_XCNT(b.x)], 1u);
    return b;
}
__device__ __forceinline__ void xcd_barrier_complete(unsigned* bar, unsigned x, unsigned& nloc, unsigned& nx) {
    const unsigned G = gridDim.x * gridDim.y * gridDim.z;
    unsigned sum, cnt, mine, sp = 0u;
    for (;;) {
        sum = 0u; cnt = 0u; mine = 0u;
#pragma unroll
        for (unsigned j = 0; j < 16; ++j) { const unsigned c = xb_ld(&bar[XB_XCNT(j)]); sum += c; cnt += (c > 0u) ? 1u : 0u; mine = (j == x) ? c : mine; }
        if (sum == G) break;
        __builtin_amdgcn_s_sleep(1);
        if ((++sp & 255u) == 0u) { if (xb_ld(&bar[XB_TMO])) break; if (sp > XB_SPIN_CAP) { atomicAdd(&bar[XB_TMO], 1u); break; } }
    }
    nloc = mine > 0u ? mine : 1u; nx = cnt > 0u ? cnt : 1u;
}
__device__ __forceinline__ void xcd_barrier(const XcdBarrier& b) {
    asm volatile("s_waitcnt vmcnt(0)" ::: "memory");
    __syncthreads();
    if (threadIdx.x == 0) {
        unsigned* bar = b.bar;
        __builtin_amdgcn_s_waitcnt(0);
        unsigned nloc = b.st[0], nx = b.st[1];
        if (nloc == 0u) { xcd_barrier_complete(bar, b.x, nloc, nx); b.st[0] = nloc; b.st[1] = nx; }
        const unsigned old = xb_add(&bar[XB_XSUB(b.x)], 1u);
        const unsigned gen = old / nloc;
        if (old + 1u == (gen + 1u) * nloc) {
            __builtin_amdgcn_fence(__ATOMIC_RELEASE, "agent");
            asm volatile("s_waitcnt vmcnt(0)" ::: "memory");
            const unsigned og = xb_add(&bar[XB_TOP], 1u);
            const unsigned tg = og / nx;
            if (og + 1u == (tg + 1u) * nx) xb_add(&bar[XB_TOPGEN], 1u);
            else XB_SPIN(xb_ld(&bar[XB_TOPGEN]) == tg, bar);
            __builtin_amdgcn_fence(__ATOMIC_ACQUIRE, "agent");
            xb_add(&bar[XB_XGEN(b.x)], 1u);
            asm volatile("s_waitcnt vmcnt(0)" ::: "memory");
        } else {
            XB_SPIN(xb_ld(&bar[XB_XGEN(b.x)]) == gen, bar);
            __builtin_amdgcn_fence(__ATOMIC_ACQUIRE, "agent");
            asm volatile("s_waitcnt vmcnt(0)" ::: "memory");
        }
    }
    __syncthreads();
}

#ifndef PG8_SP2
#define PG8_SP2 1
#endif
namespace pg8 {
constexpr int BM = 256, BK = 64, HALF = 128, HTB = HALF * BK * 2, STAGE_BYTES = 8 * HTB, NXCD = 8, WGM = 4;
__host__ __device__ __forceinline__ int lds_byte(int r, int c) { const int st = (r >> 4) * 2 + (c >> 5), rr = r & 15, cc = c & 31, ob = rr * 64 + cc * 2; return st * 1024 + (ob ^ (((ob >> 9) & 1) << 5)); }
__host__ __device__ __forceinline__ void stage_rc(int b, int& R, int& C) { const int st = b / 1024, sb = b % 1024, swz = sb ^ (((sb >> 9) & 1) << 5); R = (st >> 1) * 16 + swz / 64; C = (st & 1) * 32 + (swz % 64) / 2; }
__host__ __device__ __forceinline__ int perm32(int rho) { const int n = rho >> 4, i = rho & 15; return 8 * (i >> 2) + 4 * n + (i & 3); }

struct Unit { int pm, pn, z; };
struct Gemm { const bf16_t* A; int lda; size_t azs; const bf16_t* Bt; int K; size_t bzs; int ldb = 0; };

struct StaticOrder {
    int nM, nN, nwg, G, c;
    __device__ void init(int nM_, int nN_, int G_, int c_) { nM = nM_; nN = nN_; nwg = nM * nN; G = G_; c = c_; }
    __device__ __forceinline__ bool tile(int i, int& pm, int& pn) const {
        const long L = (long)i * G + c; if (L >= nwg) return false;
        int wgid = (int)L; { const int q = nwg / NXCD, r = nwg % NXCD, xcd = wgid % NXCD, off = wgid / NXCD; wgid = (xcd < r ? xcd * (q + 1) : r * (q + 1) + (xcd - r) * q) + off; }
        const int nig = WGM * nN, gid = wgid / nig, fm = gid * WGM, gsz = (nM - fm) < WGM ? (nM - fm) : WGM;
        pm = fm + ((wgid % nig) % gsz); pn = (wgid % nig) / gsz; return true;
    }
    __device__ bool next(int i, Unit& u) const { u.z = 0; return tile(i, u.pm, u.pn); }
};
struct Z3Order : StaticOrder {
    __device__ bool next(int i, Unit& u) const { u.z = i % 3; return tile(i / 3, u.pm, u.pn); }
};
struct TailSplit {
    int G, c;
    __device__ bool next(int i, Unit& u) const { const int id = i * G + c; if (id >= 2 * (T / 256)) return false; u.pm = id >> 1; u.pn = 0; u.z = id & 1; return true; }
};
struct MoeOrder : StaticOrder {
    int off[9];
    __device__ bool next(int i, Unit& u) const {
        if (!tile(i, u.pm, u.pn)) return false;
        const int r = u.pm * 256; int z = 0;
#pragma unroll
        for (int e = 1; e < 8; ++e) z += (r >= off[e]) ? 1 : 0;
        u.z = z; return true;
    }
};
struct MoeRange : MoeOrder {
    int i0, i1;
    __device__ bool next(int i, Unit& u) const { return (i + i0 < i1) && MoeOrder::next(i + i0, u); }
};
struct MoeOne : MoeOrder {
    int pm1, pn1;
    __device__ bool next(int i, Unit& u) const {
        if (i != 0) return false;
        u.pm = pm1; u.pn = pn1; const int r = pm1 * 256; int z = 0;
#pragma unroll
        for (int e = 1; e < 8; ++e) z += (r >= off[e]) ? 1 : 0;
        u.z = z; return true;
    }
};

template <class Epi, class Sched>
__device__ __forceinline__ void gemm_phase(LAS unsigned char* lds, const Gemm g, const Sched& S, const Epi& E) {
    int tid = threadIdx.x; asm volatile("" : "+v"(tid));
    const int wid = __builtin_amdgcn_readfirstlane(tid >> 6), lane = tid & 63, wr = wid >> 2, wc = wid & 3, fr = lane & 15, fq = lane >> 4;
    const int K = g.K, nt = K / BK, lda = g.lda, ldb = g.ldb ? g.ldb : K;
    unsigned voffA[2], voffB[2];
#pragma unroll
    for (int i = 0; i < 2; ++i) { int R, C; stage_rc(tid * 16 + i * 8192, R, C); const int Rb = Epi::PERM ? ((R & ~31) + perm32(R & 31)) : R;
        voffA[i] = (unsigned)(R * lda + C) * 2u; voffB[i] = (unsigned)(Rb * ldb + C) * 2u; }
    const size_t kstep = (size_t)(BK * 2);
    const size_t hstepA = (size_t)HALF * lda * 2, hstepB = (size_t)HALF * ldb * 2;
    const unsigned ldsw = (unsigned)wid * 1024u;
    const int aoff = lds_byte(wr * 64 + fr, fq * 8), boff = lds_byte(wc * 32 + fr, fq * 8);
#define PG8_SA(b, h) (((b) * 2 + (h)) * HTB)
#define PG8_SB(b, h) ((4 + (b) * 2 + (h)) * HTB)
#define PG8_STAGE(bufoff, gbase, voff) do { _Pragma("unroll") for (int _i = 0; _i < 2; ++_i) \
        __builtin_amdgcn_global_load_lds((const unsigned*)((const char*)(gbase) + (voff)[_i]), (LAS unsigned*)(lds + (bufoff) + ldsw + _i * 8192), 16, 0, 0); } while (0)
#define PG8_LDA(dst, b, h) do { _Pragma("unroll") for (int m = 0; m < 4; ++m) _Pragma("unroll") for (int k = 0; k < 2; ++k) dst[m][k] = *(const LAS bf16x8*)(lds + PG8_SA(b, h) + aoff + m * 2048 + k * 1024); } while (0)
#define PG8_LDB(dst, b, h) do { _Pragma("unroll") for (int n = 0; n < 2; ++n) _Pragma("unroll") for (int k = 0; k < 2; ++k) dst[n][k] = *(const LAS bf16x8*)(lds + PG8_SB(b, h) + boff + n * 2048 + k * 1024); } while (0)
#define PG8_MMA(ai, bj, At, Bt) do { __builtin_amdgcn_s_setprio(1); _Pragma("unroll") for (int m = 0; m < 4; ++m) _Pragma("unroll") for (int n = 0; n < 2; ++n) _Pragma("unroll") for (int k = 0; k < 2; ++k) \
        acc[ai][bj][m][n] = __builtin_amdgcn_mfma_f32_16x16x32_bf16(Bt[n][k], At[m][k], acc[ai][bj][m][n], 0, 0, 0); __builtin_amdgcn_s_setprio(0); } while (0)
#define PG8_WAIT_V(n) asm volatile("s_waitcnt vmcnt(" #n ")" ::: "memory")
#define PG8_WAIT_L(n) asm volatile("s_waitcnt lgkmcnt(" #n ")" ::: "memory")
#define PG8_WAIT_VR(t_, ui_) asm volatile("s_waitcnt vmcnt(16)\n\ts_cmp_lg_u32 %0, 0\n\ts_cbranch_scc1 .Lpg8s%=\n\ts_cmp_lg_u32 %1, 0\n\ts_cbranch_scc1 .Lpg8r%=\n.Lpg8s%=:\n\ts_waitcnt vmcnt(8)\n.Lpg8r%=:" :: "s"(t_), "s"(ui_) : "memory", "scc")
#define PG8_BAR __builtin_amdgcn_s_barrier()
#define PG8_SCHED __builtin_amdgcn_sched_barrier(0)
    Unit cur, nxt; int ui = 0;
    if (!S.next(0, cur)) return;
    f32x4 acc[2][2][4][2];
#pragma unroll
    for (int a = 0; a < 2; ++a)
#pragma unroll
        for (int b = 0; b < 2; ++b)
#pragma unroll
            for (int m = 0; m < 4; ++m)
#pragma unroll
                for (int n = 0; n < 2; ++n) acc[a][b][m][n] = (f32x4){0.f, 0.f, 0.f, 0.f};
    bf16x8 At[4][2], B0[2][2], B1[2][2];
    const char* cA = (const char*)(g.A + (size_t)cur.z * g.azs) + (size_t)cur.pm * 2 * hstepA;
    const char* cB = (const char*)(g.Bt + (size_t)cur.z * g.bzs) + (size_t)cur.pn * 2 * hstepB;
#if PG8_SP2
    PG8_STAGE(PG8_SB(0, 0), cB, voffB); PG8_STAGE(PG8_SB(0, 1), cB + hstepB, voffB); PG8_STAGE(PG8_SA(0, 0), cA, voffA); PG8_STAGE(PG8_SA(0, 1), cA + hstepA, voffA);
    if (wr == 1) PG8_BAR;
    PG8_WAIT_V(2); PG8_BAR;
    PG8_STAGE(PG8_SB(1, 0), cB + kstep, voffB); PG8_STAGE(PG8_SA(1, 0), cA + kstep, voffA); PG8_STAGE(PG8_SB(1, 1), cB + hstepB + kstep, voffB);
    PG8_WAIT_V(6); PG8_BAR;
#else
    PG8_STAGE(PG8_SB(0, 0), cB, voffB); PG8_STAGE(PG8_SA(0, 0), cA, voffA); PG8_STAGE(PG8_SB(0, 1), cB + hstepB, voffB); PG8_STAGE(PG8_SA(0, 1), cA + hstepA, voffA);
    if (wr == 1) PG8_BAR;
    PG8_WAIT_V(4); PG8_BAR;
    PG8_STAGE(PG8_SB(1, 0), cB + kstep, voffB); PG8_STAGE(PG8_SA(1, 0), cA + kstep, voffA); PG8_STAGE(PG8_SB(1, 1), cB + hstepB + kstep, voffB);
    PG8_WAIT_V(6); PG8_BAR;
#endif
    for (;;) {
        const bool has_next = S.next(ui + 1, nxt);
        const char* nA = has_next ? (const char*)(g.A + (size_t)nxt.z * g.azs) + (size_t)nxt.pm * 2 * hstepA : cA;
        const char* nB = has_next ? (const char*)(g.Bt + (size_t)nxt.z * g.bzs) + (size_t)nxt.pn * 2 * hstepB : cB;
        for (int t = 0; t < nt; t += 2) {
            const bool last = (t == nt - 2);
            const char* a1 = cA + (size_t)(t + 1) * kstep;
            const char* a2 = last ? nA : cA + (size_t)(t + 2) * kstep; const char* b2 = last ? nB : cB + (size_t)(t + 2) * kstep;
            const char* a3 = a2 + kstep; const char* b3 = b2 + kstep;
#if PG8_SP2
            PG8_LDB(B0, 0, 0); PG8_LDB(B1, 0, 1); PG8_SCHED; PG8_LDA(At, 0, 0); PG8_STAGE(PG8_SA(1, 1), a1 + hstepA, voffA);
            PG8_WAIT_VR(t, ui);
            PG8_WAIT_L(0); PG8_BAR; PG8_MMA(0, 0, At, B0); PG8_MMA(0, 1, At, B1); PG8_BAR; PG8_SCHED;
            PG8_LDA(At, 0, 1); PG8_STAGE(PG8_SB(0, 0), b2, voffB); PG8_STAGE(PG8_SB(0, 1), b2 + hstepB, voffB); PG8_STAGE(PG8_SA(0, 0), a2, voffA);
            PG8_WAIT_VR(t, ui);
            PG8_WAIT_L(0); PG8_BAR; PG8_MMA(1, 0, At, B0); PG8_MMA(1, 1, At, B1); PG8_BAR; PG8_SCHED;
            PG8_LDB(B0, 1, 0); PG8_LDB(B1, 1, 1); PG8_SCHED; PG8_LDA(At, 1, 0); PG8_STAGE(PG8_SA(0, 1), a2 + hstepA, voffA);
            PG8_WAIT_V(8); PG8_WAIT_L(0); PG8_BAR; PG8_MMA(0, 0, At, B0); PG8_MMA(0, 1, At, B1); PG8_BAR; PG8_SCHED;
            PG8_LDA(At, 1, 1); PG8_STAGE(PG8_SB(1, 0), b3, voffB); PG8_STAGE(PG8_SB(1, 1), b3 + hstepB, voffB); PG8_STAGE(PG8_SA(1, 0), a3, voffA);
            PG8_WAIT_V(8); PG8_WAIT_L(0); PG8_BAR; PG8_MMA(1, 0, At, B0); PG8_MMA(1, 1, At, B1); PG8_BAR; PG8_SCHED;
#else
            PG8_LDB(B0, 0, 0); PG8_SCHED; PG8_LDA(At, 0, 0); PG8_STAGE(PG8_SA(1, 1), a1 + hstepA, voffA);
            PG8_WAIT_L(8); PG8_BAR; PG8_WAIT_L(0); PG8_MMA(0, 0, At, B0); PG8_BAR; PG8_SCHED;
            PG8_LDB(B1, 0, 1); PG8_STAGE(PG8_SB(0, 0), b2, voffB);
            PG8_BAR; PG8_WAIT_L(0); PG8_MMA(0, 1, At, B1); PG8_BAR;
            PG8_LDA(At, 0, 1); PG8_STAGE(PG8_SA(0, 0), a2, voffA);
            PG8_BAR; PG8_WAIT_L(0); PG8_MMA(1, 0, At, B0); PG8_BAR; PG8_SCHED;
            PG8_STAGE(PG8_SB(0, 1), b2 + hstepB, voffB);
            PG8_WAIT_V(6); PG8_BAR; PG8_MMA(1, 1, At, B1); PG8_BAR;
            PG8_LDB(B0, 1, 0); PG8_SCHED; PG8_LDA(At, 1, 0); PG8_STAGE(PG8_SA(0, 1), a2 + hstepA, voffA);
            PG8_WAIT_L(8); PG8_BAR; PG8_WAIT_L(0); PG8_MMA(0, 0, At, B0); PG8_BAR; PG8_SCHED;
            PG8_LDB(B1, 1, 1); PG8_STAGE(PG8_SB(1, 0), b3, voffB);
            PG8_BAR; PG8_WAIT_L(0); PG8_MMA(0, 1, At, B1); PG8_BAR;
            PG8_LDA(At, 1, 1); PG8_STAGE(PG8_SA(1, 0), a3, voffA);
            PG8_BAR; PG8_WAIT_L(0); PG8_MMA(1, 0, At, B0); PG8_BAR; PG8_SCHED;
            PG8_STAGE(PG8_SB(1, 1), b3 + hstepB, voffB);
            PG8_WAIT_V(6); PG8_BAR; PG8_MMA(1, 1, At, B1); PG8_BAR;
#endif
        }
        if (wr == 0) PG8_BAR;
        E(acc, cur, wr, wc, fr, fq);
        if (!has_next) break;
#pragma unroll
        for (int a = 0; a < 2; ++a)
#pragma unroll
            for (int b = 0; b < 2; ++b)
#pragma unroll
                for (int m = 0; m < 4; ++m)
#pragma unroll
                    for (int n = 0; n < 2; ++n) acc[a][b][m][n] = (f32x4){0.f, 0.f, 0.f, 0.f};
        cur = nxt; cA = nA; cB = nB; ++ui;
        if (wr == 1) PG8_BAR;
    }
    PG8_WAIT_V(0);
    PG8_BAR;
#undef PG8_SA
#undef PG8_SB
#undef PG8_STAGE
#undef PG8_LDA
#undef PG8_LDB
#undef PG8_MMA
#undef PG8_WAIT_V
#undef PG8_WAIT_L
#undef PG8_WAIT_VR
#undef PG8_BAR
#undef PG8_SCHED
}

#define EPI_ROWS(ai, m) (u.pm * BM + (ai) * HALF + wr * 64 + (m) * 16 + fr)

struct EpiProj {
    static constexpr bool PERM = true;
    bf16_t* O; float* tail;
    __device__ __forceinline__ void operator()(f32x4 (&acc)[2][2][4][2], const Unit& u, int wr, int wc, int fr, int fq) const {
        const int colt = wc * 32 + 8 * fq;
        if (u.pn < LDP / 256) {
#pragma unroll
            for (int ai = 0; ai < 2; ++ai)
#pragma unroll
                for (int m = 0; m < 4; ++m) { bf16_t* rowp = O + (size_t)EPI_ROWS(ai, m) * LDP + u.pn * BM + colt;
#pragma unroll
                    for (int bj = 0; bj < 2; ++bj) { const f32x4 v0 = acc[ai][bj][m][0], v1 = acc[ai][bj][m][1];
                        u32x4 w; w.x = cvt_pk_bf16(v0[0], v0[1]); w.y = cvt_pk_bf16(v0[2], v0[3]); w.z = cvt_pk_bf16(v1[0], v1[1]); w.w = cvt_pk_bf16(v1[2], v1[3]);
                        *(u32x4*)(rowp + bj * HALF) = w; } }
        } else {
#pragma unroll
            for (int ai = 0; ai < 2; ++ai)
#pragma unroll
                for (int m = 0; m < 4; ++m) { float* rowp = tail + (size_t)EPI_ROWS(ai, m) * TAILW + colt;
#pragma unroll
                    for (int bj = 0; bj < 2; ++bj) { *(f32x4*)(rowp + bj * HALF) = acc[ai][bj][m][0]; *(f32x4*)(rowp + bj * HALF + 4) = acc[ai][bj][m][1]; } }
        }
    }
};
struct EpiTail {
    static constexpr bool PERM = true;
    float* t0; float* t1;
    __device__ __forceinline__ void operator()(f32x4 (&acc)[2][2][4][2], const Unit& u, int wr, int wc, int fr, int fq) const {
        const int colt = wc * 32 + 8 * fq; float* tail = u.z ? t1 : t0;
#pragma unroll
        for (int ai = 0; ai < 2; ++ai)
#pragma unroll
            for (int m = 0; m < 4; ++m) { float* rowp = tail + (size_t)EPI_ROWS(ai, m) * TAILW + colt;
#pragma unroll
                for (int bj = 0; bj < 2; ++bj) { *(f32x4*)(rowp + bj * HALF) = acc[ai][bj][m][0]; *(f32x4*)(rowp + bj * HALF + 4) = acc[ai][bj][m][1]; } }
    }
};
struct EpiBf16 {
    static constexpr bool PERM = true;
    bf16_t* O; int ldc; const float* rowscale;
    __device__ __forceinline__ void operator()(f32x4 (&acc)[2][2][4][2], const Unit& u, int wr, int wc, int fr, int fq) const {
        const int colt = u.pn * BM + wc * 32 + 8 * fq;
#pragma unroll
        for (int ai = 0; ai < 2; ++ai)
#pragma unroll
            for (int m = 0; m < 4; ++m) { const int row = EPI_ROWS(ai, m); const float s = rowscale ? rowscale[row] : 1.0f; bf16_t* rowp = O + (size_t)row * ldc + colt;
#pragma unroll
                for (int bj = 0; bj < 2; ++bj) { const f32x4 v0 = acc[ai][bj][m][0] * s, v1 = acc[ai][bj][m][1] * s;
                    u32x4 w; w.x = cvt_pk_bf16(v0[0], v0[1]); w.y = cvt_pk_bf16(v0[2], v0[3]); w.z = cvt_pk_bf16(v1[0], v1[1]); w.w = cvt_pk_bf16(v1[2], v1[3]);
                    *(u32x4*)(rowp + bj * HALF) = w; } }
    }
};
struct EpiQ {
    static constexpr bool PERM = true;
    bf16_t* O; const float* rowscale; const int* positions; float qscale;
    __device__ __forceinline__ void operator()(f32x4 (&acc)[2][2][4][2], const Unit& u, int wr, int wc, int fr, int fq) const {
        const int colt = u.pn * BM + wc * 32 + 8 * fq;
        float sc[2][4], pf[2][4];
#pragma unroll
        for (int ai = 0; ai < 2; ++ai)
#pragma unroll
            for (int m = 0; m < 4; ++m) { const int row = EPI_ROWS(ai, m); sc[ai][m] = rowscale[row] * qscale; pf[ai][m] = (float)positions[row]; }
        float rf[2][4]; bool rope[2];
#pragma unroll
        for (int bj = 0; bj < 2; ++bj) { const int d = (colt + bj * HALF) % 192; rope[bj] = d >= 128;
#pragma unroll
            for (int k = 0; k < 4; ++k) rf[bj][k] = __builtin_amdgcn_exp2f(-(float)((d - 128) / 2 + k) * 0.41524101186092f) * 0.15915494309189535f; }
#pragma unroll
        for (int ai = 0; ai < 2; ++ai)
#pragma unroll
            for (int m = 0; m < 4; ++m) { const int row = EPI_ROWS(ai, m); const float s = sc[ai][m], p = pf[ai][m]; bf16_t* rowp = O + (size_t)row * 1536 + colt;
#pragma unroll
                for (int bj = 0; bj < 2; ++bj) { f32x4 v[2] = {acc[ai][bj][m][0] * s, acc[ai][bj][m][1] * s};
                    if (rope[bj]) {
#pragma unroll
                        for (int k = 0; k < 4; ++k) { const float rev = p * rf[bj][k], frc = rev - floorf(rev); const float c = __builtin_amdgcn_cosf(frc), sn = __builtin_amdgcn_sinf(frc);
                            const float a0 = v[k >> 1][2 * (k & 1)], b0 = v[k >> 1][2 * (k & 1) + 1];
                            v[k >> 1][2 * (k & 1)] = a0 * c - b0 * sn; v[k >> 1][2 * (k & 1) + 1] = b0 * c + a0 * sn; }
                    }
                    u32x4 w; w.x = cvt_pk_bf16(v[0][0], v[0][1]); w.y = cvt_pk_bf16(v[0][2], v[0][3]); w.z = cvt_pk_bf16(v[1][0], v[1][1]); w.w = cvt_pk_bf16(v[1][2], v[1][3]);
                    *(u32x4*)(rowp + bj * HALF) = w; } }
    }
};
struct EpiSwiglu {
    static constexpr bool PERM = true;
    bf16_t* O; int ldc;
    __device__ __forceinline__ void operator()(f32x4 (&acc)[2][2][4][2], const Unit& u, int wr, int wc, int fr, int fq) const {
        const int colt = u.pn * HALF + wc * 32 + 8 * fq;
#pragma unroll
        for (int ai = 0; ai < 2; ++ai)
#pragma unroll
            for (int m = 0; m < 4; ++m) { bf16_t* rowp = O + (size_t)EPI_ROWS(ai, m) * ldc + colt; float r[8];
#pragma unroll
                for (int n = 0; n < 2; ++n)
#pragma unroll
                    for (int i = 0; i < 4; ++i) { const float a = acc[ai][0][m][n][i], b = acc[ai][1][m][n][i]; r[n * 4 + i] = a * sigmoidf_(a) * b; }
                u32x4 w; w.x = cvt_pk_bf16(r[0], r[1]); w.y = cvt_pk_bf16(r[2], r[3]); w.z = cvt_pk_bf16(r[4], r[5]); w.w = cvt_pk_bf16(r[6], r[7]);
                *(u32x4*)rowp = w; }
    }
};
struct EpiBranch {
    static constexpr bool PERM = true;
    bf16_t* O; const bf16_t* proj;
    __device__ __forceinline__ void operator()(f32x4 (&acc)[2][2][4][2], const Unit& u, int wr, int wc, int fr, int fq) const {
        const int colt = u.pn * BM + wc * 32 + 8 * fq;
#pragma unroll
        for (int ai = 0; ai < 2; ++ai) {
            u32x4 gw[4][2];
#pragma unroll
            for (int m = 0; m < 4; ++m) { const bf16_t* gp = proj + (size_t)EPI_ROWS(ai, m) * LDP + PC_GATE + u.z * DM + colt;
#pragma unroll
                for (int bj = 0; bj < 2; ++bj) gw[m][bj] = *(const u32x4*)(gp + bj * HALF); }
            asm volatile("" ::: "memory");
#pragma unroll
            for (int m = 0; m < 4; ++m)
#pragma unroll
                for (int bj = 0; bj < 2; ++bj) { const u32x4 g = gw[m][bj]; const f32x4 v0 = acc[ai][bj][m][0], v1 = acc[ai][bj][m][1];
                    acc[ai][bj][m][0] = (f32x4){v0[0] * sigmoidf_(bflo(g.x)), v0[1] * sigmoidf_(bfhi(g.x)), v0[2] * sigmoidf_(bflo(g.y)), v0[3] * sigmoidf_(bfhi(g.y))};
                    acc[ai][bj][m][1] = (f32x4){v1[0] * sigmoidf_(bflo(g.z)), v1[1] * sigmoidf_(bfhi(g.z)), v1[2] * sigmoidf_(bflo(g.w)), v1[3] * sigmoidf_(bfhi(g.w))}; }
            if (u.z != 0) {
#pragma unroll
                for (int m = 0; m < 4; ++m) { const bf16_t* rowp = O + (size_t)EPI_ROWS(ai, m) * DM + colt;
#pragma unroll
                    for (int bj = 0; bj < 2; ++bj) gw[m][bj] = *(const u32x4*)(rowp + bj * HALF); }
                asm volatile("" ::: "memory");
#pragma unroll
                for (int m = 0; m < 4; ++m)
#pragma unroll
                    for (int bj = 0; bj < 2; ++bj) { const u32x4 o = gw[m][bj];
                        acc[ai][bj][m][0] += (f32x4){bflo(o.x), bfhi(o.x), bflo(o.y), bfhi(o.y)}; acc[ai][bj][m][1] += (f32x4){bflo(o.z), bfhi(o.z), bflo(o.w), bfhi(o.w)}; }
            }
#pragma unroll
            for (int m = 0; m < 4; ++m) { bf16_t* rowp = O + (size_t)EPI_ROWS(ai, m) * DM + colt;
#pragma unroll
                for (int bj = 0; bj < 2; ++bj) { const f32x4 v0 = acc[ai][bj][m][0], v1 = acc[ai][bj][m][1];
                    u32x4 w; w.x = cvt_pk_bf16(v0[0], v0[1]); w.y = cvt_pk_bf16(v0[2], v0[3]); w.z = cvt_pk_bf16(v1[0], v1[1]); w.w = cvt_pk_bf16(v1[2], v1[3]);
                    *(u32x4*)(rowp + bj * HALF) = w; } }
            asm volatile("" ::: "memory");
        }
    }
};
struct EpiResid {
    static constexpr bool PERM = false;
    const float* base; float* out;
    __device__ __forceinline__ void operator()(f32x4 (&acc)[2][2][4][2], const Unit& u, int wr, int wc, int fr, int fq) const {
        const int colt = u.pn * BM + wc * 32 + 4 * fq;
#pragma unroll
        for (int ai = 0; ai < 2; ++ai) {
            f32x4 bv[4][2][2];
#pragma unroll
            for (int m = 0; m < 4; ++m) { const size_t off = (size_t)EPI_ROWS(ai, m) * DM + colt;
#pragma unroll
                for (int bj = 0; bj < 2; ++bj)
#pragma unroll
                    for (int n = 0; n < 2; ++n) bv[m][bj][n] = *(const f32x4*)(base + off + bj * HALF + n * 16); }
            asm volatile("" ::: "memory");
#pragma unroll
            for (int m = 0; m < 4; ++m) { const size_t off = (size_t)EPI_ROWS(ai, m) * DM + colt;
#pragma unroll
                for (int bj = 0; bj < 2; ++bj)
#pragma unroll
                    for (int n = 0; n < 2; ++n) *(f32x4*)(out + off + bj * HALF + n * 16) = bv[m][bj][n] + acc[ai][bj][m][n]; }
            asm volatile("" ::: "memory");
        }
    }
};
#undef EPI_ROWS
}

namespace att {
constexpr int OFF_V = 0, SHM_V = 16384, OFF_KAUX = 32768, OFF_WS = 33280, OFF_KX = 35328, SHM_KX = 2048, OFF_K = 40960;
constexpr float L2E = 1.4426950408889634f, THR2 = 8.f * L2E;
template <int MODE> struct Cfg;
template <> struct Cfg<0> { static constexpr int DK = 64, NQ = 4; static constexpr float SCALE = 0.125f; };
template <> struct Cfg<1> { static constexpr int DK = 128, NQ = 8; static constexpr float SCALE = 0.08838834764831845f; };
template <> struct Cfg<2> { static constexpr int DK = 192, NQ = 12; static constexpr float SCALE = 0.07216878364870322f; };
static_assert(OFF_K + 2 * 64 * 192 * 2 <= RING_BYTES, "attention LDS map");

__device__ __forceinline__ int crow(int r, int hi) { return (r & 3) + 8 * (r >> 2) + 4 * hi; }
#define SBAR() __builtin_amdgcn_sched_barrier(0)
__device__ __forceinline__ void partialSM2(f32x16& p0, f32x16& p1, bool first, float& m_reg, float& alpha) {
    float pmax = p0[0];
#pragma unroll
    for (int r = 1; r < 16; ++r) pmax = fmaxf(pmax, p0[r]);
#pragma unroll
    for (int r = 0; r < 16; ++r) pmax = fmaxf(pmax, p1[r]);
    { auto rr = __builtin_amdgcn_permlane32_swap(__float_as_uint(pmax), __float_as_uint(pmax), false, false);
      pmax = fmaxf(__uint_as_float(rr[0]), __uint_as_float(rr[1])); }
    if (first) {
        m_reg = pmax; alpha = 0.f;
#pragma unroll
        for (int r = 0; r < 16; ++r) { p0[r] -= pmax; p1[r] -= pmax; }
    } else if (__builtin_expect(__all(pmax <= THR2), 1)) { alpha = 1.f; }
    else { const float delta = fmaxf(pmax, 0.f); alpha = __builtin_amdgcn_exp2f(-delta); m_reg += delta;
#pragma unroll
        for (int r = 0; r < 16; ++r) { p0[r] -= delta; p1[r] -= delta; } }
#pragma unroll
    for (int r = 0; r < 16; ++r) p0[r] = __builtin_amdgcn_exp2f(p0[r]);
}
__device__ __forceinline__ void finishSM(f32x16& p0, f32x16& p1, float alpha, float& l_reg, bf16x8& pa0, bf16x8& pa1, bf16x8& pa2, bf16x8& pa3) {
#pragma unroll
    for (int r = 0; r < 16; ++r) p1[r] = __builtin_amdgcn_exp2f(p1[r]);
    float ps = 0;
#pragma unroll
    for (int r = 0; r < 16; ++r) ps += p0[r];
#pragma unroll
    for (int r = 0; r < 16; ++r) ps += p1[r];
    { auto rr = __builtin_amdgcn_permlane32_swap(__float_as_uint(ps), __float_as_uint(ps), false, false);
      ps = __uint_as_float(rr[0]) + __uint_as_float(rr[1]); }
    l_reg = l_reg * alpha + ps;
#define PK4(P, BASE, OUT) do { unsigned a0 = cvt_pk_bf16(P[BASE + 0], P[BASE + 1]), a1 = cvt_pk_bf16(P[BASE + 2], P[BASE + 3]);   \
    unsigned b0 = cvt_pk_bf16(P[BASE + 4], P[BASE + 5]), b1 = cvt_pk_bf16(P[BASE + 6], P[BASE + 7]);                              \
    auto r0 = __builtin_amdgcn_permlane32_swap(a0, b0, false, false); auto r1 = __builtin_amdgcn_permlane32_swap(a1, b1, false, false); \
    u32x4 w = {r0[0], r1[0], r0[1], r1[1]}; OUT = *reinterpret_cast<bf16x8*>(&w); } while (0)
    PK4(p0, 0, pa0); PK4(p0, 8, pa1); PK4(p1, 0, pa2); PK4(p1, 8, pa3);
#undef PK4
}
__device__ __forceinline__ int v_st(int k, int c) { const int kk = (k & ~0xC) | ((k & 4) << 1) | ((k & 8) >> 1); return ((kk >> 3) * 4 + (c >> 5)) * 512 + ((kk & 7) * 32 + (c & 31)) * 2; }
__device__ __forceinline__ int v_rd_base(int lane) { return ((lane & 3) << 3) | (((lane >> 2) & 3) << 6) | (((lane >> 4) & 1) << 5) | (((lane >> 5) & 1) << 8); }
constexpr int v_rd_off(int d0, int ks, int half) { return d0 * 512 + ks * 4096 + half * 2048; }
template <int OFF> __device__ __forceinline__ s16x4 tr_read(int vb) {
    s16x4 r; asm volatile("ds_read_b64_tr_b16 %0, %1 offset:%2" : "=&v"(r) : "v"(vb), "i"(OFF) : "memory"); return r;
}
struct VFrag { s16x4 l0, h0, l1, h1, l2, h2, l3, h3; };
template <int D0> __device__ __forceinline__ void v_load(VFrag& f, int vb) {
    f.l0 = tr_read<v_rd_off(D0, 0, 0)>(vb); f.h0 = tr_read<v_rd_off(D0, 0, 1)>(vb); f.l1 = tr_read<v_rd_off(D0, 1, 0)>(vb); f.h1 = tr_read<v_rd_off(D0, 1, 1)>(vb);
    f.l2 = tr_read<v_rd_off(D0, 2, 0)>(vb); f.h2 = tr_read<v_rd_off(D0, 2, 1)>(vb); f.l3 = tr_read<v_rd_off(D0, 3, 0)>(vb); f.h3 = tr_read<v_rd_off(D0, 3, 1)>(vb);
}
__device__ __forceinline__ void pv_mma(f32x16& od, const VFrag& f, bf16x8 pa0, bf16x8 pa1, bf16x8 pa2, bf16x8 pa3) {
#define PK(L, H) (bf16x8){L[0], L[1], L[2], L[3], H[0], H[1], H[2], H[3]}
    od = __builtin_amdgcn_mfma_f32_32x32x16_bf16(pa0, PK(f.l0, f.h0), od, 0, 0, 0);
    od = __builtin_amdgcn_mfma_f32_32x32x16_bf16(pa1, PK(f.l1, f.h1), od, 0, 0, 0);
    od = __builtin_amdgcn_mfma_f32_32x32x16_bf16(pa2, PK(f.l2, f.h2), od, 0, 0, 0);
    od = __builtin_amdgcn_mfma_f32_32x32x16_bf16(pa3, PK(f.l3, f.h3), od, 0, 0, 0);
#undef PK
}
__device__ __forceinline__ void pv_all(f32x16 (&o)[4], int vb, bf16x8 pa0, bf16x8 pa1, bf16x8 pa2, bf16x8 pa3) {
    VFrag fa, fb;
    v_load<0>(fa, vb); v_load<1>(fb, vb);
    asm volatile("s_waitcnt lgkmcnt(8)" ::: "memory"); SBAR(); pv_mma(o[0], fa, pa0, pa1, pa2, pa3); SBAR();
    v_load<2>(fa, vb);
    asm volatile("s_waitcnt lgkmcnt(8)" ::: "memory"); SBAR(); pv_mma(o[1], fb, pa0, pa1, pa2, pa3); SBAR();
    v_load<3>(fb, vb);
    asm volatile("s_waitcnt lgkmcnt(8)" ::: "memory"); SBAR(); pv_mma(o[2], fa, pa0, pa1, pa2, pa3); SBAR();
    asm volatile("s_waitcnt lgkmcnt(0)" ::: "memory"); SBAR(); pv_mma(o[3], fb, pa0, pa1, pa2, pa3);
}

struct AttnP {
    unsigned char* ws; const int* positions; const float* subln_g; float lam, out_scale;
    __device__ __forceinline__ const bf16_t* proj() const { return (const bf16_t*)(ws + WS_PROJ); }
    __device__ __forceinline__ const bf16_t* qm() const { return (const bf16_t*)(ws + WS_QM); }
    __device__ __forceinline__ const bf16_t* knv() const { return (const bf16_t*)(ws + WS_KNV); }
    __device__ __forceinline__ const bf16_t* krot() const { return (const bf16_t*)(ws + WS_KROT); }
    __device__ __forceinline__ const float* ckS() const { return (const float*)(ws + MS_CKS); }
    __device__ __forceinline__ bf16_t* obuf() const { return (bf16_t*)(ws + WS_OBUF); }
};

template <int MODE>
__device__ __forceinline__ void attn_unit(const AttnP& P, int b, int h, int x, LAS char* lds) {
    constexpr int DK = Cfg<MODE>::DK, NQ = Cfg<MODE>::NQ, RS = DK * 2, SHM_K = 64 * RS;
    constexpr bool HAS_N = (MODE != 0);
    constexpr int RCOL = (MODE == 2) ? 128 : 0;
    constexpr bool HAS_R = (MODE != 1);
    constexpr bool HAS_AUX = (MODE != 2);
    int tid = threadIdx.x; asm volatile("" : "+v"(tid));
    const int wid = __builtin_amdgcn_readfirstlane(tid >> 6), lane = tid & 63, r32 = lane & 31, hi = lane >> 5;
    const size_t tok0 = (size_t)b * SEQ;
    const int q0w = x * 256 + wid * 32;
    const int NT = 4 * x + 4, jmax = 4 * x + (wid >> 1);
    LAS float* ws = (LAS float*)(lds + OFF_WS) + wid * 64; LAS float* li_l = ws; LAS float* al_l = ws + 32;
    const int sr = tid >> 4, sc = (tid & 15) * 8, vst0 = v_st(sr, sc), vst1 = v_st(32 + sr, sc);
    const int vb0 = (int)(uintptr_t)(lds + OFF_V) + v_rd_base(lane);
    const int rrow = tid >> 3, rcol = (tid & 7) * 8;
#define KSWZ(row, colB) ((row) * RS + ((colB) ^ (((row) & 7) << 4)))
    const int kstN0 = KSWZ(sr, sc * 2), kstN1 = KSWZ(32 + sr, sc * 2), kstR = KSWZ(rrow, (RCOL + rcol) * 2);
    int kb[4];
#pragma unroll
    for (int c = 0; c < 4; ++c) kb[c] = KSWZ(r32, c * 32 + hi * 16);
    constexpr int ldN = (MODE == 2) ? 2048 : LDP, ldR = (MODE == 2) ? 64 : LDP, ldV = (MODE == 2) ? 2048 : LDP, ldQ = (MODE == 2) ? 1536 : LDP;
    const bf16_t *srcN = nullptr, *srcR = nullptr, *srcV = nullptr, *srcQ = nullptr;
    if (MODE == 0) { srcR = P.proj() + tok0 * LDP + PC_AK + h * 128; srcV = P.proj() + tok0 * LDP + PC_AV + h * 128; srcQ = P.proj() + tok0 * LDP + PC_AQ + h * 128; }
    if (MODE == 1) { srcN = P.proj() + tok0 * LDP + PC_BK + h * 128; srcV = P.proj() + tok0 * LDP + PC_BV + h * 128; srcQ = P.proj() + tok0 * LDP + PC_BQ + h * 128; }
    if (MODE == 2) { srcN = P.knv() + tok0 * 2048 + h * 128; srcR = P.krot() + tok0 * 64; srcV = P.knv() + tok0 * 2048 + 1024 + h * 128; srcQ = P.qm() + tok0 * 1536 + h * 192; }
    float qaux = 0.f, slope2 = 0.f, xref = 0.f;
    if (MODE == 0) { qaux = (float)P.positions[tok0 + q0w + r32]; slope2 = exp2f(-(float)(h + 1)) * L2E; xref = (float)P.positions[tok0 + x * 256]; }
    if (MODE == 1) xref = P.ckS()[((size_t)b * 8 + h) * SEQ + x * 256];
    bf16x8 qx = bf16x8{}; if (hi == 0) { qx[0] = (short)0x3F80; qx[1] = (short)0x3F80; }
    f32x16 o[4]; float m_reg, l_reg; bf16x8 qr[NQ];
    constexpr int NMAP = (MODE == 0) ? 2 : 1;
    for (int mp = 0; mp < NMAP; ++mp) {
#pragma unroll
        for (int d = 0; d < 4; ++d) o[d] = f32x16{};
        m_reg = 0.f; l_reg = 0.f;
        { const bf16_t* Qw = srcQ + (size_t)(q0w + r32) * ldQ + mp * 64 + hi * 8;
#pragma unroll
          for (int d0 = 0; d0 < NQ; ++d0) qr[d0] = *(const bf16x8*)(Qw + d0 * 16); }
        const char* gN = (const char*)srcN; const char* gR = (const char*)(srcR + mp * 64); const char* gV = (const char*)srcV;
        const unsigned oN = (unsigned)(sr * ldN + sc) * 2u, oR = (unsigned)(rrow * ldR + rcol) * 2u, oV = (unsigned)(sr * ldV + sc) * 2u;
        bf16x8 sN0, sN1, sR, sV0, sV1; float sAux = 0.f; int tload = 0;
#define SLOAD() do { if (HAS_N) { sN0 = *(const bf16x8*)(gN + oN); sN1 = *(const bf16x8*)(gN + (size_t)32 * ldN * 2 + oN); gN += (size_t)64 * ldN * 2; } \
        if (HAS_R) { sR = *(const bf16x8*)(gR + oR); gR += (size_t)64 * ldR * 2; } \
        sV0 = *(const bf16x8*)(gV + oV); sV1 = *(const bf16x8*)(gV + (size_t)32 * ldV * 2 + oV); gV += (size_t)64 * ldV * 2; \
        if (HAS_AUX && tid < 64) { if (MODE == 0) sAux = (float)P.positions[tok0 + tload * 64 + tid]; else sAux = P.ckS()[((size_t)b * 8 + h) * SEQ + tload * 64 + tid]; } \
        ++tload; } while (0)
#define SWRITE(bf) do { LAS char* Kb = lds + OFF_K + (bf) * SHM_K; LAS char* Vb = lds + OFF_V + (bf) * SHM_V; \
        if (HAS_N) { *(LAS bf16x8*)(Kb + kstN0) = sN0; *(LAS bf16x8*)(Kb + kstN1) = sN1; } if (HAS_R) *(LAS bf16x8*)(Kb + kstR) = sR; \
        *(LAS bf16x8*)(Vb + vst0) = sV0; *(LAS bf16x8*)(Vb + vst1) = sV1; \
        if (HAS_AUX && tid < 64) { const float val = (MODE == 0) ? slope2 * (sAux - xref) : (xref - sAux) * L2E; const unsigned vh = cvt_pk_bf16(val, 0.f) & 0xffffu; \
            const unsigned vl = cvt_pk_bf16(val - __uint_as_float(vh << 16), 0.f) & 0xffffu; LAS u32x4* kx = (LAS u32x4*)(lds + OFF_KX + (bf) * SHM_KX + tid * 32); \
            kx[0] = (u32x4){vh | (vl << 16), 0u, 0u, 0u}; kx[1] = (u32x4){0u, 0u, 0u, 0u}; \
            if (MODE == 0) ((LAS float*)(lds + OFF_KAUX))[(bf) * 64 + tid] = sAux; } } while (0)
        __syncthreads();
        SLOAD(); SWRITE(0); SLOAD();
        for (int j = 0; j < NT; ++j) {
            __syncthreads();
            const int bf = j & 1;
            if (j <= jmax) {
                const bool first = (j == 0);
                f32x16 p0, p1; { const float ini = first ? 0.f : -m_reg;
#pragma unroll
                  for (int r = 0; r < 16; ++r) { p0[r] = ini; p1[r] = ini; } }
                {
                  const LAS char* Kb = lds + OFF_K + bf * SHM_K;
                  const LAS char* kx = lds + OFF_KX + bf * SHM_KX + r32 * 32 + hi * 16;
                  constexpr int NS = NQ + (HAS_AUX ? 1 : 0);
                  bf16x8 ra[3], rb[3];
#define QLOAD(s_) do { if ((s_) < NQ) { const LAS char* kp = Kb + kb[(s_) & 3] + ((s_) >> 2) * 128; ra[(s_) % 3] = *(const LAS bf16x8*)kp; rb[(s_) % 3] = *(const LAS bf16x8*)(kp + 32 * RS); } \
                      else { ra[(s_) % 3] = *(const LAS bf16x8*)kx; rb[(s_) % 3] = *(const LAS bf16x8*)(kx + 1024); } } while (0)
                  QLOAD(0); QLOAD(1);
#pragma unroll
                  for (int st = 0; st < NS; ++st) {
                      if (st + 2 < NS) QLOAD(st + 2);
                      SBAR();
                      const bf16x8 qb = (st < NQ) ? qr[st < NQ ? st : 0] : qx;
                      p0 = __builtin_amdgcn_mfma_f32_32x32x16_bf16(ra[st % 3], qb, p0, 0, 0, 0);
                      p1 = __builtin_amdgcn_mfma_f32_32x32x16_bf16(rb[st % 3], qb, p1, 0, 0, 0);
                      SBAR(); }
#undef QLOAD
                }
                if (MODE == 0 && j == jmax) {
                    const LAS float* ka = (const LAS float*)(lds + OFF_KAUX) + bf * 64 + 4 * hi; const float s2 = 2.f * slope2;
#pragma unroll
                    for (int g = 0; g < 4; ++g) { const f32x4 a0 = *(const LAS f32x4*)(ka + 8 * g), a1 = *(const LAS f32x4*)(ka + 32 + 8 * g);
#pragma unroll
                        for (int i = 0; i < 4; ++i) { p0[4 * g + i] = fmaf(s2, fminf(qaux - a0[i], 0.f), p0[4 * g + i]); p1[4 * g + i] = fmaf(s2, fminf(qaux - a1[i], 0.f), p1[4 * g + i]); } }
                }
                if (MODE == 1 && j == jmax) {
                    const int rowt = q0w - 64 * j + r32;
#pragma unroll
                    for (int r = 0; r < 16; ++r) { const int kk = crow(r, hi); if (kk > rowt) p0[r] = -__builtin_inff(); if (kk + 32 > rowt) p1[r] = -__builtin_inff(); }
                }
                float alpha; partialSM2(p0, p1, first, m_reg, alpha);
                if (__any(alpha < 1.f)) { if (hi == 0) al_l[r32] = alpha; LDS_WAIT();
#pragma unroll
                    for (int d = 0; d < 4; ++d)
#pragma unroll
                        for (int r = 0; r < 16; ++r) o[d][r] *= al_l[crow(r, hi)]; }
                bf16x8 pa0, pa1, pa2, pa3; finishSM(p0, p1, alpha, l_reg, pa0, pa1, pa2, pa3); SBAR();
                const int vb = vb0 + bf * SHM_V;
                pv_all(o, vb, pa0, pa1, pa2, pa3);
            }
            if (j + 1 < NT) { SWRITE(bf ^ 1); if (j + 2 < NT) SLOAD(); }
        }
#undef SLOAD
#undef SWRITE
        if (hi == 0) li_l[r32] = l_reg; LDS_WAIT();
        float rli[16];
#pragma unroll
        for (int r = 0; r < 16; ++r) rli[r] = __builtin_amdgcn_rcpf(li_l[crow(r, hi)]);
        LDS_WAIT();
        bf16_t* Ob = P.obuf() + (tok0 + q0w) * 3072 + MODE * 1024 + h * 128;
        constexpr int LDO = 3072;
        int hi4 = hi * 4; asm volatile("" : "+v"(hi4));
        if (MODE == 0 && mp == 1) {
            asm volatile("s_waitcnt vmcnt(0)" ::: "memory");
            const bf16_t* O1 = Ob; bf16_t* Oc = Ob;
            float gq[4];
#pragma unroll
            for (int d = 0; d < 4; ++d) gq[d] = P.subln_g[r32 + 32 * d] * P.out_scale;
            bf16_t a1[16][4];
#pragma unroll
            for (int r = 0; r < 16; ++r) { const unsigned vo1 = (unsigned)(((r & 3) + 8 * (r >> 2) + hi4) * 3072 + r32) * 2u;
#pragma unroll
                for (int d = 0; d < 4; ++d) a1[r][d] = *(const bf16_t*)((const char*)O1 + vo1 + d * 64); }
            asm volatile("" ::: "memory");
#pragma unroll
            for (int r = 0; r < 16; ++r) { const int rowi = (r & 3) + 8 * (r >> 2) + hi4; const unsigned vo2 = (unsigned)(rowi * 3072 + r32) * 2u;
                float v[4]; float ss = 0.f;
#pragma unroll
                for (int d = 0; d < 4; ++d) { const float a = bf2f(a1[r][d]); const float bq = __uint_as_float(cvt_pk_bf16(o[d][r] * rli[r], 0.f) << 16);
                    v[d] = a - P.lam * bq; ss += v[d] * v[d]; }
                ss = row_sum16(ss); ss += __int_as_float(__builtin_amdgcn_ds_swizzle(__float_as_int(ss), 0x401F));
                const float rs = __builtin_amdgcn_rsqf(ss * (1.0f / 128.0f) + NORM_EPS);
#pragma unroll
                for (int d = 0; d < 4; ++d) *(bf16_t*)((char*)Oc + vo2 + d * 64) = (bf16_t)(cvt_pk_bf16(v[d] * rs * gq[d], 0.f) & 0xffffu); }
        } else {
#pragma unroll
        for (int r = 0; r < 16; ++r) { const unsigned voff = (unsigned)(((r & 3) + 8 * (r >> 2) + hi4) * LDO + r32) * 2u;
#pragma unroll
            for (int d = 0; d < 4; ++d) *(bf16_t*)((char*)Ob + voff + d * 64) = (bf16_t)(cvt_pk_bf16(o[d][r] * rli[r], 0.f) & 0xffffu); }
        }
    }
#undef KSWZ
}
#undef SBAR
}

__device__ __forceinline__ int wsrc_in(int n) {
    if (n < 6144) return n;
    if (n < 7168) return 6152 + (n - 6144);
    if (n < 13312) return 7240 + (n - 7168);
    if (n < 13376) { const int j = n - 13312; return 7176 + (j & 1) * 32 + (j >> 1); }
    if (n < 13384) return 6144 + (n - 13376);
    return -1;
}
__device__ __forceinline__ int wsrc_uq(int n) { const int h = n / 192, d = n % 192; if (d < 128) return n; const int j = d - 128; return h * 192 + 128 + (j & 1) * 32 + (j >> 1); }
template <int KIND>
__device__ __forceinline__ void wconv_job(const float* W, const float* W2, int ldw, int K, int ndst, int nz, size_t wzs, size_t bzs, bf16_t* Bt, const float* ks, int kzs, LAS float* scr, int vcu, int G, int tid, int r0 = 0, int r1 = 0x7fffff) {
    const int lane = tid & 63, wave = __builtin_amdgcn_readfirstlane(tid >> 6);
    const int nkb = K / 64, nnb = ndst / 64, per = nkb * nnb, stride = G * 8, ntile_all = per * nz, ntile = (r1 < 0x7fffff && (long)r1 * stride < ntile_all) ? r1 * stride : ntile_all;
    LAS char* img = (LAS char*)scr + wave * 9216;
    float v[64]; int src = 0; float cs = 1.0f;
#define WC_LOAD(t_) do { const int z_ = (t_) / per, r_ = (t_) % per, kb_ = r_ / nnb, nb_ = r_ % nnb, nd_ = nb_ * 64 + lane; \
        const float* Wp_ = W + (size_t)z_ * wzs; src = nd_; \
        if (KIND == 1) { src = wsrc_in(nd_); cs = (nd_ < 1024) ? att::Cfg<0>::SCALE * att::L2E : ((nd_ >= PC_BQ && nd_ < PC_BK) ? att::Cfg<1>::SCALE * att::L2E : 1.0f); }     \
        if (KIND == 2) src = wsrc_uq(nd_); \
        if (KIND == 3) { Wp_ = (((nb_ >> 1) & 1) ? W2 : W) + (size_t)z_ * wzs; src = (nb_ >> 2) * 128 + (nb_ & 1) * 64 + lane; } \
        const float* col_ = Wp_ + (size_t)(kb_ * 64) * ldw + (src >= 0 ? src : 0); \
        _Pragma("unroll") for (int i = 0; i < 64; ++i) v[i] = __builtin_nontemporal_load(col_ + (size_t)i * ldw); } while (0)
    int t = vcu * 8 + wave + r0 * stride;
    if (t < ntile) WC_LOAD(t);
    while (t < ntile) {
        const int z = t / per, r = t % per, kb = r / nnb, nb = r % nnb, k0 = kb * 64, n0 = nb * 64;
        if (src < 0) {
#pragma unroll
            for (int i = 0; i < 64; ++i) v[i] = 0.f;
        }
        if (KIND == 1) {
#pragma unroll
            for (int i = 0; i < 64; ++i) v[i] *= cs; }
        if (ks) { const float* ksp = ks + (size_t)z * kzs + k0;
#pragma unroll
            for (int i = 0; i < 64; ++i) v[i] *= ksp[i]; }
#pragma unroll
        for (int c = 0; c < 8; ++c) { u32x4 o; o.x = cvt_pk_bf16(v[8 * c], v[8 * c + 1]); o.y = cvt_pk_bf16(v[8 * c + 2], v[8 * c + 3]); o.z = cvt_pk_bf16(v[8 * c + 4], v[8 * c + 5]); o.w = cvt_pk_bf16(v[8 * c + 6], v[8 * c + 7]);
            *(LAS u32x4*)(img + lane * 144 + c * 16) = o; }
        const int tn = t + stride;
        if (tn < ntile) WC_LOAD(tn);
        asm volatile("s_waitcnt lgkmcnt(0)" ::: "memory");
        bf16_t* dst = Bt + (size_t)z * bzs + (size_t)(n0 + (lane >> 3)) * K + k0 + (lane & 7) * 8;
#pragma unroll
        for (int i = 0; i < 8; ++i) { const u32x4 o = *(const LAS u32x4*)(img + ((lane >> 3) + 8 * i) * 144 + (lane & 7) * 16); __builtin_nontemporal_store(o, (u32x4*)(dst + (size_t)(8 * i) * K)); }
        asm volatile("s_waitcnt lgkmcnt(0)" ::: "memory");
        t = tn;
    }
#undef WC_LOAD
}
__device__ __forceinline__ void rmsnorm_rows(const float* x, const float* g, bf16_t* out, int vcu, int G, int wave, int lane) {
    f32x4 gv[8];
#pragma unroll
    for (int j = 0; j < 8; ++j) gv[j] = *((const f32x4*)g + lane + 64 * j);
    for (int m = vcu * 8 + wave; m < T; m += G * 16) {
        const int m2 = (m + G * 8 < T) ? m + G * 8 : m;
        const f32x4* xr = (const f32x4*)(x + (size_t)m * DM) + lane; const f32x4* xq = (const f32x4*)(x + (size_t)m2 * DM) + lane; f32x4 v[8], u[8]; float s = 0.f, s2 = 0.f;
#pragma unroll
        for (int j = 0; j < 8; ++j) v[j] = xr[64 * j];
#pragma unroll
        for (int j = 0; j < 8; ++j) u[j] = xq[64 * j];
#pragma unroll
        for (int j = 0; j < 8; ++j) s += (v[j][0] * v[j][0] + v[j][1] * v[j][1]) + (v[j][2] * v[j][2] + v[j][3] * v[j][3]);
#pragma unroll
        for (int j = 0; j < 8; ++j) s2 += (u[j][0] * u[j][0] + u[j][1] * u[j][1]) + (u[j][2] * u[j][2] + u[j][3] * u[j][3]);
        const float rstd = __builtin_amdgcn_rsqf(wave_sum(s) * (1.0f / DM) + NORM_EPS), rstd2 = __builtin_amdgcn_rsqf(wave_sum(s2) * (1.0f / DM) + NORM_EPS);
        u32x2* o8 = (u32x2*)(out + (size_t)m * DM) + lane; u32x2* o9 = (u32x2*)(out + (size_t)m2 * DM) + lane;
#pragma unroll
        for (int j = 0; j < 8; ++j) { const f32x4 y = v[j] * rstd * gv[j]; u32x2 w; w.x = cvt_pk_bf16(y[0], y[1]); w.y = cvt_pk_bf16(y[2], y[3]); o8[64 * j] = w; }
#pragma unroll
        for (int j = 0; j < 8; ++j) { const f32x4 y = u[j] * rstd2 * gv[j]; u32x2 w; w.x = cvt_pk_bf16(y[0], y[1]); w.y = cvt_pk_bf16(y[2], y[3]); o9[64 * j] = w; }
    }
}
__device__ __forceinline__ void prep_phase(const bf16_t* proj, const float* tail, const float* tail1, const int* positions, const float* fbias,
                                           float* rstdq, float* rstdkv, bf16_t* krot, float* ckS, LAS float* scr, int vcu, int G, int tid, int wave, int lane) {
    const float rfreq = __builtin_amdgcn_exp2f(-(float)(lane & 31) * 0.41524101186092f) * 0.15915494309189535f;
    for (int m = vcu * 8 + wave; m < T; m += G * 32) {
        int mk[4]; u32x4 a[4], b[4]; f32x2 xv[4]; float pos[4];
#pragma unroll
        for (int k = 0; k < 4; ++k) { mk[k] = (m + k * G * 8 < T) ? m + k * G * 8 : m; }
#pragma unroll
        for (int k = 0; k < 4; ++k) { a[k] = *(const u32x4*)(proj + (size_t)mk[k] * LDP + PC_CQ + 8 * lane); b[k] = *(const u32x4*)(proj + (size_t)mk[k] * LDP + PC_CKV + 8 * lane);
            xv[k] = *((const f32x2*)(tail + (size_t)mk[k] * TAILW) + (lane & 31)) + *((const f32x2*)(tail1 + (size_t)mk[k] * TAILW) + (lane & 31)); pos[k] = (float)positions[mk[k]]; }
#pragma unroll
        for (int k = 0; k < 4; ++k) {
            float sa = 0.f, sb = 0.f;
#pragma unroll
            for (int i = 0; i < 4; ++i) { const float a0 = bflo(a[k][i]), a1 = bfhi(a[k][i]), b0 = bflo(b[k][i]), b1 = bfhi(b[k][i]); sa += a0 * a0 + a1 * a1; sb += b0 * b0 + b1 * b1; }
            sa = wave_sum(sa); sb = wave_sum(sb);
            if (lane == 0) { rstdq[mk[k]] = __builtin_amdgcn_rsqf(sa * (1.0f / 512.0f) + NORM_EPS); rstdkv[mk[k]] = __builtin_amdgcn_rsqf(sb * (1.0f / 512.0f) + NORM_EPS); }
            if (lane < 32) { const float rev = pos[k] * rfreq, frc = rev - floorf(rev);
                const float cs = __builtin_amdgcn_cosf(frc), sn = __builtin_amdgcn_sinf(frc);
                ((unsigned*)(krot + (size_t)mk[k] * 64))[lane] = cvt_pk_bf16(xv[k].x * cs - xv[k].y * sn, xv[k].y * cs + xv[k].x * sn); }
        }
    }
    for (int u = vcu; u < NB * 8; u += G) {
        const int b = u >> 3, h = u & 7; const float fb = fbias[h]; float v[8]; float run = 0.f;
#pragma unroll
        for (int i = 0; i < 8; ++i) { const size_t ti = ((size_t)b * SEQ + tid * 8 + i) * TAILW + 64 + h; const float f = tail[ti] + tail1[ti] + fb;
            const float ls = -(fmaxf(-f, 0.f) + log1pf(__expf(-fabsf(f)))); run += ls; v[i] = run; }
        __syncthreads();
        scr[tid] = run; __syncthreads();
        for (int o = 1; o < 512; o <<= 1) { float t = (tid >= o) ? scr[tid - o] : 0.f; __syncthreads(); scr[tid] += t; __syncthreads(); }
        const float excl = scr[tid] - run;
#pragma unroll
        for (int i = 0; i < 8; ++i) ckS[((size_t)b * 8 + h) * SEQ + tid * 8 + i] = excl + v[i];
        __syncthreads();
    }
}

__device__ __forceinline__ void diff_combine(const bf16_t* oscr, const float* g, float lam, float out_scale, bf16_t* obuf, int vcu, int G, int wave, int lane) {
    f32x4 g0 = *(const f32x4*)(g + (lane & 15) * 8), g1 = *(const f32x4*)(g + (lane & 15) * 8 + 4);
    for (int m = vcu * 8 + wave; m < T; m += G * 8) {
#pragma unroll
        for (int c = 0; c < 2; ++c) {
            const u32x4 a = *(const u32x4*)(oscr + (size_t)m * 2048 + c * 512 + lane * 8), b = *(const u32x4*)(oscr + (size_t)m * 2048 + 1024 + c * 512 + lane * 8);
            float v[8]; float ss = 0.f;
#pragma unroll
            for (int i = 0; i < 4; ++i) { v[2 * i] = bflo(a[i]) - lam * bflo(b[i]); v[2 * i + 1] = bfhi(a[i]) - lam * bfhi(b[i]); ss += v[2 * i] * v[2 * i] + v[2 * i + 1] * v[2 * i + 1]; }
            ss = row_sum16(ss);
            const float rs = __builtin_amdgcn_rsqf(ss * (1.0f / 128.0f) + NORM_EPS) * out_scale;
            u32x4 w; w.x = cvt_pk_bf16(v[0] * rs * g0[0], v[1] * rs * g0[1]); w.y = cvt_pk_bf16(v[2] * rs * g0[2], v[3] * rs * g0[3]);
            w.z = cvt_pk_bf16(v[4] * rs * g1[0], v[5] * rs * g1[1]); w.w = cvt_pk_bf16(v[6] * rs * g1[2], v[7] * rs * g1[3]);
            *(u32x4*)(obuf + (size_t)m * 3072 + c * 512 + lane * 8) = w;
        }
    }
}

#define LADD(p, v) (void)__hip_atomic_fetch_add((p), (v), __ATOMIC_RELAXED, __HIP_MEMORY_SCOPE_WORKGROUP)
__device__ __forceinline__ void moe_route(const float* x, const float* g, const float* router_w, int* route, float* rstd2, unsigned* cnt, LAS unsigned char* lds, int vcu, int G, int tid, int wave, int lane) {
    LAS float* Wt = (LAS float*)lds; LAS unsigned* elist = (LAS unsigned*)(lds + 65536);
    for (int idx = tid; idx < DM * 8; idx += 512) Wt[(idx & 7) * DM + (idx >> 3)] = router_w[idx];
    __syncthreads();
    int Gd = G; asm volatile("" : "+s"(Gd));
    const int TPW = (T + Gd - 1) / Gd, t0 = vcu * TPW, t1 = (t0 + TPW < T) ? t0 + TPW : T;
    f32x4 gv[8];
#pragma unroll
    for (int j = 0; j < 8; ++j) gv[j] = *((const f32x4*)g + lane + 64 * j);
    for (int m = t0 + wave; m < t1; m += 16) {
        const int mq = (m + 8 < t1) ? m + 8 : m;
        const f32x4* xr = (const f32x4*)(x + (size_t)m * DM) + lane; const f32x4* xq = (const f32x4*)(x + (size_t)mq * DM) + lane; f32x4 v[8], u[8]; float s = 0.f, sq = 0.f;
#pragma unroll
        for (int j = 0; j < 8; ++j) v[j] = xr[64 * j];
#pragma unroll
        for (int j = 0; j < 8; ++j) u[j] = xq[64 * j];
#pragma unroll
        for (int j = 0; j < 8; ++j) s += (v[j][0] * v[j][0] + v[j][1] * v[j][1]) + (v[j][2] * v[j][2] + v[j][3] * v[j][3]);
#pragma unroll
        for (int j = 0; j < 8; ++j) sq += (u[j][0] * u[j][0] + u[j][1] * u[j][1]) + (u[j][2] * u[j][2] + u[j][3] * u[j][3]);
        const float rstd = __builtin_amdgcn_rsqf(wave_sum(s) * (1.0f / DM) + NORM_EPS), rstdq = __builtin_amdgcn_rsqf(wave_sum(sq) * (1.0f / DM) + NORM_EPS);
#pragma unroll
        for (int j = 0; j < 8; ++j) { v[j] = v[j] * rstd * gv[j]; u[j] = u[j] * rstdq * gv[j]; }
        float lg[8], lq[8];
#pragma unroll
        for (int e = 0; e < 8; ++e) { float a = 0.f, b = 0.f;
#pragma unroll
            for (int j = 0; j < 8; ++j) { const f32x4 w = *((const LAS f32x4*)(Wt + e * DM) + lane + 64 * j); a += (v[j][0] * w[0] + v[j][1] * w[1]) + (v[j][2] * w[2] + v[j][3] * w[3]);
                b += (u[j][0] * w[0] + u[j][1] * w[1]) + (u[j][2] * w[2] + u[j][3] * w[3]); }
            lg[e] = wave_sum(a); lq[e] = wave_sum(b); }
#define ROUTE_PICK(lg_, m_, rstd_) do { int e0 = 0; float v0 = lg_[0]; \
        _Pragma("unroll") for (int e = 1; e < 8; ++e) if (lg_[e] > v0) { v0 = lg_[e]; e0 = e; } \
        int e1 = -1; float v1 = -__builtin_inff(); \
        _Pragma("unroll") for (int e = 0; e < 8; ++e) if (e != e0 && lg_[e] > v1) { v1 = lg_[e]; e1 = e; } \
        const float ex = __expf(v1 - v0), w0 = 1.0f / (1.0f + ex), w1 = ex * w0; \
        if (lane == 0) { i32x4 r; r.x = e0; r.y = e1; r.z = __float_as_int(w0); r.w = __float_as_int(w1); *((i32x4*)route + (m_)) = r; rstd2[m_] = rstd_; elist[(m_) - t0] = (unsigned)e0 | ((unsigned)e1 << 8); } } while (0)
        ROUTE_PICK(lg, m, rstd); ROUTE_PICK(lq, mq, rstdq);
#undef ROUTE_PICK
    }
    __syncthreads();
    if (tid < 8) { unsigned c = 0; for (int i = 0; i < t1 - t0; ++i) { const unsigned w = elist[i]; c += ((w & 255u) == (unsigned)tid) + ((w >> 8) == (unsigned)tid); } cnt[vcu * 8 + tid] = c; }
    __syncthreads();
}
__device__ __forceinline__ void moe_gather(const float* x, const float* g, const int* route, const float* rstd2, const unsigned* cnt, int* slots, int* moe_off, bf16_t* hs,
                                           LAS unsigned char* lds, int vcu, int G, int tid, int wave, int lane) {
    LAS unsigned* tot = (LAS unsigned*)lds; LAS unsigned* base = tot + 8; LAS int* offp = (LAS int*)(tot + 16); LAS unsigned* elist = tot + 32; LAS int* slotl = (LAS int*)(tot + 32 + 1024);
    if (tid < 16) tot[tid] = 0u;
    __syncthreads();
    for (int w = tid; w < G; w += 512) { const u32x4 c0 = *((const u32x4*)cnt + 2 * w), c1 = *((const u32x4*)cnt + 2 * w + 1);
#pragma unroll
        for (int e = 0; e < 4; ++e) { LADD(&tot[e], c0[e]); LADD(&tot[4 + e], c1[e]); if (w < vcu) { LADD(&base[e], c0[e]); LADD(&base[4 + e], c1[e]); } } }
    __syncthreads();
    if (tid == 0) { int o = 0; for (int e = 0; e < 8; ++e) { offp[e] = o; o += (int)((tot[e] + 255u) & ~255u); } offp[8] = o; }
    __syncthreads();
    if (vcu == 0 && tid < 9) moe_off[tid] = offp[tid];
    int Gd = G; asm volatile("" : "+s"(Gd));
    const int TPW = (T + Gd - 1) / Gd, t0 = vcu * TPW, t1 = (t0 + TPW < T) ? t0 + TPW : T, nt = t1 - t0;
    for (int i = tid; i < nt; i += 512) { const i32x4 r = *((const i32x4*)route + t0 + i); elist[i] = (unsigned)r.x | ((unsigned)r.y << 8); }
    __syncthreads();
    for (int i = tid; i < nt; i += 512) { const unsigned w = elist[i], e0 = w & 255u, e1 = w >> 8; int r0 = 0, r1 = 0;
        for (int k = 0; k < i; ++k) { const unsigned q = elist[k], a = q & 255u, b = q >> 8; r0 += (a == e0) + (b == e0); r1 += (a == e1) + (b == e1); }
        const int s0 = offp[e0] + (int)base[e0] + r0, s1 = offp[e1] + (int)base[e1] + r1;
        slotl[2 * i] = s0; slotl[2 * i + 1] = s1; slots[2 * (t0 + i)] = s0; slots[2 * (t0 + i) + 1] = s1; }
    __syncthreads();
    f32x4 gv[8];
#pragma unroll
    for (int j = 0; j < 8; ++j) gv[j] = *((const f32x4*)g + lane + 64 * j);
    for (int m = t0 + wave; m < t1; m += 16) {
        const int mq = (m + 8 < t1) ? m + 8 : m;
        const f32x4* xr = (const f32x4*)(x + (size_t)m * DM) + lane; const f32x4* xq = (const f32x4*)(x + (size_t)mq * DM) + lane; f32x4 v[8], u[8];
#pragma unroll
        for (int j = 0; j < 8; ++j) v[j] = xr[64 * j];
#pragma unroll
        for (int j = 0; j < 8; ++j) u[j] = xq[64 * j];
        const float rstd = rstd2[m], rstdq = rstd2[mq]; const int s0 = slotl[2 * (m - t0)], s1 = slotl[2 * (m - t0) + 1], q0 = slotl[2 * (mq - t0)], q1 = slotl[2 * (mq - t0) + 1];
        u32x2* o0 = (u32x2*)(hs + (size_t)s0 * DM) + lane; u32x2* o1 = (u32x2*)(hs + (size_t)s1 * DM) + lane; u32x2* p0 = (u32x2*)(hs + (size_t)q0 * DM) + lane; u32x2* p1 = (u32x2*)(hs + (size_t)q1 * DM) + lane;
#pragma unroll
        for (int j = 0; j < 8; ++j) { const f32x4 y = v[j] * rstd * gv[j]; u32x2 w; w.x = cvt_pk_bf16(y[0], y[1]); w.y = cvt_pk_bf16(y[2], y[3]); o0[64 * j] = w; o1[64 * j] = w; }
#pragma unroll
        for (int j = 0; j < 8; ++j) { const f32x4 y = u[j] * rstdq * gv[j]; u32x2 w; w.x = cvt_pk_bf16(y[0], y[1]); w.y = cvt_pk_bf16(y[2], y[3]); p0[64 * j] = w; p1[64 * j] = w; }
    }
    __syncthreads();
}
__device__ __forceinline__ void final_phase(const float* x, const bf16_t* ys, const int* route, const int* slots, const float* g, float* out, const LAS int* late, bool want_late, int vcu, int G, int wave, int lane) {
    f32x4 gv[8];
#pragma unroll
    for (int j = 0; j < 8; ++j) gv[j] = *((const f32x4*)g + lane + 64 * j);
    for (int m = vcu * 8 + wave; m < T; m += G * 8) {
        const int s0 = __builtin_amdgcn_readfirstlane(slots[2 * m]), s1 = __builtin_amdgcn_readfirstlane(slots[2 * m + 1]);
        if (((late[s0 >> 8] | late[s1 >> 8]) != 0) != want_late) continue;
        const i32x4 r = *((const i32x4*)route + m); const float w0 = __int_as_float(r.z), w1 = __int_as_float(r.w);
        const f32x4* xr = (const f32x4*)(x + (size_t)m * DM) + lane; const u32x2* y0 = (const u32x2*)(ys + (size_t)s0 * DM) + lane; const u32x2* y1 = (const u32x2*)(ys + (size_t)s1 * DM) + lane;
        f32x4 v[8]; float s = 0.f;
#pragma unroll
        for (int j = 0; j < 8; ++j) { const u32x2 a = y0[64 * j], b = y1[64 * j]; f32x4 t = xr[64 * j];
            t[0] += w0 * bflo(a.x) + w1 * bflo(b.x); t[1] += w0 * bfhi(a.x) + w1 * bfhi(b.x); t[2] += w0 * bflo(a.y) + w1 * bflo(b.y); t[3] += w0 * bfhi(a.y) + w1 * bfhi(b.y);
            v[j] = t; s += (t[0] * t[0] + t[1] * t[1]) + (t[2] * t[2] + t[3] * t[3]); }
        const float rstd = __builtin_amdgcn_rsqf(wave_sum(s) * (1.0f / DM) + NORM_EPS);
        f32x4* o = (f32x4*)(out + (size_t)m * DM) + lane;
#pragma unroll
        for (int j = 0; j < 8; ++j) o[64 * j] = v[j] * rstd * gv[j];
    }
}

constexpr int NWAVES = 8, PH_PER_LAYER = 13, NPH = 1 + 2 * PH_PER_LAYER;
struct Args {
    const float* x; const int* positions; const float* attn_norm_g; const float* w_in; const float* diff_lambda; const float* diff_subln_g; const float* fox_bias;
    const float* q_norm_g; const float* kv_norm_g; const float* w_uq; const float* w_uk; const float* w_uv; const float* w_branch; const float* w_out; const float* ffn_norm_g;
    const float* dense_w1; const float* dense_w3; const float* dense_w2; const float* router_w; const float* expert_w1; const float* expert_w3; const float* expert_w2; const float* final_norm_g;
    float* out; unsigned char* ws; int ph_lo, ph_hi, li, pad;
};
__host__ __device__ constexpr bool phase_exists(int k) {
    if (k == 0) return true;
    const int l = (k - 1) / PH_PER_LAYER, p = (k - 1) % PH_PER_LAYER;
    if (l == 0) return p >= 1 && p <= 10;
    return true;
}

typedef const __attribute__((address_space(4))) Args* KArgs;
__device__ __forceinline__ KArgs kargs() { KArgs p = (KArgs)__builtin_amdgcn_kernarg_segment_ptr(); asm volatile("" : "+s"(p)); return p; }

__global__ void __launch_bounds__(NWAVES * 64, 2) mega_fwd(Args a) {
    extern __shared__ __attribute__((aligned(16))) unsigned char lds_raw[];
    LAS unsigned char* lds = (LAS unsigned char*)lds_raw;
    const int G = gridDim.x, bx = blockIdx.x, vcu = (G % 8 == 0) ? (bx % 8) * (G / 8) + bx / 8 : bx;
    volatile LAS unsigned* MISC = (volatile LAS unsigned*)(lds + MISC_OFF);
    for (int u = threadIdx.x; u < (LDS_BYTES - LDSCTL_OFF) / 4; u += NWAVES * 64) ((LAS unsigned*)(lds + LDSCTL_OFF))[u] = 0u;
    __syncthreads();
    XcdBarrier bar = xcd_barrier_post((unsigned*)(a.ws + WS_CTL) + CW_BAR + a.li * XCD_BAR_WORDS, MISC + 8);
    const int lo = a.ph_lo, hi = a.ph_hi;
#ifndef ATT_MODES
#define ATT_MODES 7
#endif
#ifndef PH_ENABLE
#define PH_ENABLE 0xFFFFFFFFu
#endif
#define IN(k) (lo <= (k) && (k) < hi)
#define EN(kind) (((PH_ENABLE) >> (kind)) & 1u)
#ifndef PROBE_REP_MASK
#define PROBE_REP_MASK 0u
#endif
#define REPS(kind) for (int rep_ = 0; rep_ < ((((PROBE_REP_MASK) >> (kind)) & 1u) ? PROBE_REP_N : 1); ++rep_)
#ifndef PROBE_REP_N
#define PROBE_REP_N 2
#endif
#ifndef PROBE_BAR2
#define PROBE_BAR2 0
#endif
#define SEAM(k) do { if (IN(k) && (k) + 1 < hi) { xcd_barrier(bar); if (PROBE_BAR2) xcd_barrier(bar); } } while (0)
#define PHASE_LOCALS KArgs A = kargs(); unsigned char* ws = A->ws; int tid = threadIdx.x; asm volatile("" : "+v"(tid)); const int lane = tid & 63, wave = __builtin_amdgcn_readfirstlane(tid >> 6); (void)lane; (void)wave; (void)ws
#define WSP(T_, off) ((T_*)(ws + (off)))

    if (EN(0) && IN(0)) REPS(0) {
        PHASE_LOCALS; LAS float* scr = (LAS float*)lds;
        wconv_job<1>(A->w_in, nullptr, N_IN_SRC, DM, NIN, 1, (size_t)DM * N_IN_SRC, (size_t)NIN * DM, WSP(bf16_t, WS_WIN), nullptr, 0, scr, vcu, G, tid);
        wconv_job<2>(A->w_uq, nullptr, 1536, 512, 1536, 2, (size_t)512 * 1536, (size_t)1536 * 512, WSP(bf16_t, WS_WUQ), A->q_norm_g, 512, scr, vcu, G, tid);
        wconv_job<0>(A->w_uk, nullptr, 1024, 512, 1024, 2, (size_t)512 * 1024, (size_t)2048 * 512, WSP(bf16_t, WS_WUKV), A->kv_norm_g, 512, scr, vcu, G, tid);
        wconv_job<0>(A->w_uv, nullptr, 1024, 512, 1024, 2, (size_t)512 * 1024, (size_t)2048 * 512, WSP(bf16_t, WS_WUKV) + (size_t)1024 * 512, A->kv_norm_g, 512, scr, vcu, G, tid);
        rmsnorm_rows(A->x, A->attn_norm_g, WSP(bf16_t, WS_H), vcu, G, wave, lane);
    }
    SEAM(0);

    for (int l = 0; l < DEPTH; ++l) {
        const int pb = 1 + l * PH_PER_LAYER;
        if (hi <= pb || lo >= pb + PH_PER_LAYER) continue;

        if (l > 0) { if (EN(1) && IN(pb + 0)) REPS(1) { PHASE_LOCALS; rmsnorm_rows(A->out, A->attn_norm_g + l * DM, WSP(bf16_t, WS_H), vcu, G, wave, lane); } SEAM(pb + 0); }

        if (EN(2) && IN(pb + 1)) REPS(2) {
            PHASE_LOCALS;
            pg8::Gemm g{WSP(bf16_t, WS_H), DM, 0, WSP(bf16_t, WS_WIN + (size_t)l * SZ_WIN), DM, 0}; pg8::StaticOrder S; S.init(T / 256, LDP / 256, G, bx);
            pg8::EpiProj E{WSP(bf16_t, WS_PROJ), WSP(float, WS_TAIL)};
            pg8::gemm_phase(lds, g, S, E);
            { pg8::Gemm gt{WSP(bf16_t, WS_H), DM, (size_t)(DM / 2), WSP(bf16_t, WS_WIN + (size_t)l * SZ_WIN) + (size_t)LDP * DM, DM / 2, (size_t)(DM / 2), DM};
              pg8::TailSplit St; St.G = G; St.c = bx;
              pg8::EpiTail Et{WSP(float, WS_TAIL), WSP(float, WS_TAIL1)};
              pg8::gemm_phase(lds, gt, St, Et); }
        }
        SEAM(pb + 1);

        if (EN(3) && IN(pb + 2)) REPS(3) { PHASE_LOCALS;
            prep_phase(WSP(bf16_t, WS_PROJ), WSP(float, WS_TAIL), WSP(float, WS_TAIL1), A->positions, A->fox_bias + l * 8, WSP(float, MS_RSTDQ), WSP(float, MS_RSTDKV), WSP(bf16_t, WS_KROT), WSP(float, MS_CKS),
                       (LAS float*)lds, vcu, G, tid, wave, lane); }
        SEAM(pb + 2);

        if (EN(4) && IN(pb + 3)) REPS(4) {
            { PHASE_LOCALS;
              pg8::Gemm g{WSP(bf16_t, WS_PROJ) + PC_CQ, LDP, 0, WSP(bf16_t, WS_WUQ + (size_t)l * SZ_WUQ), 512, 0}; pg8::StaticOrder S; S.init(T / 256, 1536 / 256, G, bx);
              pg8::EpiQ E{WSP(bf16_t, WS_QM), WSP(float, MS_RSTDQ), A->positions, att::Cfg<2>::SCALE * att::L2E};
              pg8::gemm_phase(lds, g, S, E); }
            { PHASE_LOCALS;
              pg8::Gemm g{WSP(bf16_t, WS_PROJ) + PC_CKV, LDP, 0, WSP(bf16_t, WS_WUKV + (size_t)l * SZ_WUKV), 512, 0}; pg8::StaticOrder S; S.init(T / 256, 2048 / 256, G, bx);
              pg8::EpiBf16 E{WSP(bf16_t, WS_KNV), 2048, WSP(float, MS_RSTDKV)};
              pg8::gemm_phase(lds, g, S, E); }
        }
        SEAM(pb + 3);

        const float lam_init = (l == 0) ? 0.2f : 0.35550906759f;
        if (EN(5) && IN(pb + 4)) REPS(5) {
            PHASE_LOCALS;
            const float* dl = A->diff_lambda + l * 256; const float p = dl[lane] * dl[64 + lane], q = dl[128 + lane] * dl[192 + lane];
            const float lam = __expf(wave_sum(p)) - __expf(wave_sum(q)) + lam_init;
            att::AttnP P{ws, A->positions, A->diff_subln_g + l * 128, lam, 1.0f - lam_init};
            int cslot = 0;
#define CJ(KIND_, W_, W2_, ldw_, K_, nd_, nz_, wzs_, bzs_, Bt_, pre_, rp_) do { const int a_ = g0_ - (pre_), b_ = a_ + rs0; \
                wconv_job<KIND_>(W_, W2_, ldw_, K_, nd_, nz_, wzs_, bzs_, Bt_, nullptr, 0, (LAS float*)lds, vcu, G, tid, a_ < 0 ? 0 : a_, b_ < (rp_) ? b_ : (rp_)); } while (0)
#define CONV_CONSTS int Gq_ = G; asm volatile("" : "+s"(Gq_)); const int nslots = 6 * ((512 - vcu + Gq_ - 1) / Gq_); const int rp2 = ((DFFE / 64) * (DM / 64) * NEXP + Gq_ * 8 - 1) / (Gq_ * 8), rp13 = ((DM / 64) * (2 * DFFE / 64) * EARLY_EXP + Gq_ * 8 - 1) / (Gq_ * 8); const int rs2 = (rp2 + nslots - 1) / nslots, rs13 = (rp13 + nslots - 1) / nslots; const int W8 = Gq_ * 8, rpA = ((DM / 64) * (NIN / 64) + W8 - 1) / W8, rpB = ((DM / 64) * (2 * DFF / 64) + W8 - 1) / W8, rpC = (6 * (1024 / 64) * (DM / 64) + W8 - 1) / W8, rpD = ((DFF / 64) * (DM / 64) + W8 - 1) / W8, rpE = (2 * (DM / 64) * (DM / 64) + W8 - 1) / W8;
#define CONV_SLOT() do { CONV_CONSTS if (l == 1) { __syncthreads(); const int q0_ = cslot * rs2, q1_ = q0_ + rs2, e0_ = cslot * rs13, e1_ = e0_ + rs13; ++cslot; \
                wconv_job<0>(A->expert_w2, nullptr, DM, DFFE, DM, NEXP, (size_t)DFFE * DM, (size_t)DM * DFFE, WSP(bf16_t, WS_EW2), nullptr, 0, (LAS float*)lds, vcu, G, tid, q0_, q1_); \
                wconv_job<3>(A->expert_w1, A->expert_w3, DFFE, DM, 2 * DFFE, EARLY_EXP, (size_t)DM * DFFE, (size_t)2 * DFFE * DM, WSP(bf16_t, WS_EW13), nullptr, 0, (LAS float*)lds, vcu, G, tid, e0_, e1_); } } while (0)
#define CONV_SLOT0() do { CONV_CONSTS if (l == 0) { __syncthreads(); const int rs0 = (rpA + rpB + rpC + rpD + rpE + nslots / 3 - 1) / (nslots / 3), g0_ = cslot * rs0; \
                CJ(1, A->w_in + (size_t)DM * N_IN_SRC, nullptr, N_IN_SRC, DM, NIN, 1, 0, 0, WSP(bf16_t, WS_WIN) + (size_t)NIN * DM, 0, rpA); \
                CJ(3, A->dense_w1, A->dense_w3, DFF, DM, 2 * DFF, 1, 0, 0, WSP(bf16_t, WS_WD13), rpA, rpB); \
                CJ(0, A->w_branch, nullptr, DM, 1024, DM, 6, (size_t)1024 * DM, (size_t)DM * 1024, WSP(bf16_t, WS_WBR), rpA + rpB, rpC); \
                CJ(0, A->dense_w2, nullptr, DM, DFF, DM, 1, 0, 0, WSP(bf16_t, WS_WD2), rpA + rpB + rpC, rpD); \
                CJ(0, A->w_out, nullptr, DM, DM, DM, 2, (size_t)DM * DM, (size_t)DM * DM, WSP(bf16_t, WS_WOUT), rpA + rpB + rpC + rpD, rpE); ++cslot; } } while (0)
            if (ATT_MODES & 1) for (int u = vcu; u < 512; u += G) for (int hf = 0; hf < 2; ++hf) { att::attn_unit<0>(P, u >> 6, (u >> 3) & 7, hf ? 15 - (u & 7) : (u & 7), (LAS char*)lds); CONV_SLOT0(); CONV_SLOT(); }
            if (ATT_MODES & 2) for (int u = vcu; u < 512; u += G) for (int hf = 0; hf < 2; ++hf) { att::attn_unit<1>(P, u >> 6, (u >> 3) & 7, hf ? 15 - (u & 7) : (u & 7), (LAS char*)lds); CONV_SLOT(); }
            if (ATT_MODES & 4) for (int u = vcu; u < 512; u += G) for (int hf = 0; hf < 2; ++hf) { att::attn_unit<2>(P, u >> 6, (u >> 3) & 7, hf ? 15 - (u & 7) : (u & 7), (LAS char*)lds); CONV_SLOT(); }
#undef CONV_SLOT
#undef CONV_SLOT0
#undef CJ
#undef CONV_CONSTS
            __syncthreads();
        }
        SEAM(pb + 4);


        if (EN(6) && IN(pb + 6)) REPS(6) {
            PHASE_LOCALS;
            pg8::Gemm g{WSP(bf16_t, WS_OBUF), 3072, 1024, WSP(bf16_t, WS_WBR + (size_t)l * SZ_WBR), 1024, (size_t)DM * 1024}; pg8::Z3Order S; S.init(T / 256, DM / 256, G, bx);
            pg8::EpiBranch E{WSP(bf16_t, WS_MERGED), WSP(bf16_t, WS_PROJ)};
            pg8::gemm_phase(lds, g, S, E);
        }
        SEAM(pb + 6);

        if (EN(7) && IN(pb + 7)) REPS(7) {
            PHASE_LOCALS;
            pg8::Gemm g{WSP(bf16_t, WS_MERGED), DM, 0, WSP(bf16_t, WS_WOUT + (size_t)l * SZ_WOUT), DM, 0}; pg8::StaticOrder S; S.init(T / 256, DM / 256, G, bx);
            pg8::EpiResid E{(l == 0) ? A->x : (const float*)A->out, (((PROBE_REP_MASK >> 7) & 1u) && rep_ == 0) ? WSP(float, WS_QM) : A->out};
            pg8::gemm_phase(lds, g, S, E);
        }
        SEAM(pb + 7);

        if (l == 0) {
            if (EN(8) && IN(pb + 8)) REPS(8) { PHASE_LOCALS; rmsnorm_rows(A->out, A->ffn_norm_g, WSP(bf16_t, WS_H), vcu, G, wave, lane); }
            SEAM(pb + 8);
            if (EN(9) && IN(pb + 9)) REPS(9) {
                PHASE_LOCALS;
                pg8::Gemm g{WSP(bf16_t, WS_H), DM, 0, WSP(bf16_t, WS_WD13), DM, 0}; pg8::StaticOrder S; S.init(T / 256, 2 * DFF / 256, G, bx);
                pg8::EpiSwiglu E{WSP(bf16_t, WS_UD), DFF};
                pg8::gemm_phase(lds, g, S, E);
            }
            SEAM(pb + 9);
            if (EN(10) && IN(pb + 10)) REPS(10) {
                PHASE_LOCALS;
                pg8::Gemm g{WSP(bf16_t, WS_UD), DFF, 0, WSP(bf16_t, WS_WD2), DFF, 0}; pg8::StaticOrder S; S.init(T / 256, DM / 256, G, bx);
                pg8::EpiResid E{A->out, (((PROBE_REP_MASK >> 10) & 1u) && rep_ == 0) ? WSP(float, WS_QM) : A->out};
                pg8::gemm_phase(lds, g, S, E);
            }
            SEAM(pb + 10);
        } else {
            if (EN(11) && IN(pb + 8)) REPS(11) {
                PHASE_LOCALS; LAS float* scr = (LAS float*)lds;
                wconv_job<3>(A->expert_w1 + (size_t)EARLY_EXP * DM * DFFE, A->expert_w3 + (size_t)EARLY_EXP * DM * DFFE, DFFE, DM, 2 * DFFE, NEXP - EARLY_EXP, (size_t)DM * DFFE, (size_t)2 * DFFE * DM,
                             WSP(bf16_t, WS_EW13) + (size_t)EARLY_EXP * 2 * DFFE * DM, nullptr, 0, scr, vcu, G, tid);
                __syncthreads();
                moe_route(A->out, A->ffn_norm_g + DM, A->router_w, WSP(int, MS_ROUTE), WSP(float, MS_RSTD2), WSP(unsigned, MS_CNT), lds, vcu, G, tid, wave, lane);
            }
            SEAM(pb + 8);
            if (EN(12) && IN(pb + 9)) REPS(12) { PHASE_LOCALS;
                moe_gather(A->out, A->ffn_norm_g + DM, WSP(int, MS_ROUTE), WSP(float, MS_RSTD2), WSP(unsigned, MS_CNT), WSP(int, MS_SLOTS), WSP(int, MS_MOEOFF), WSP(bf16_t, WS_HS), lds, vcu, G, tid, wave, lane); }
            SEAM(pb + 9);
            if (EN(13) && IN(pb + 10)) REPS(13) {
                PHASE_LOCALS;
                pg8::MoeOrder S; const int* moe_off = WSP(int, MS_MOEOFF);
#pragma unroll
                for (int e = 0; e < 9; ++e) S.off[e] = __builtin_amdgcn_readfirstlane(moe_off[e]);
                S.init(S.off[8] / 256, 2 * DFFE / 256, G, bx);
                pg8::Gemm g{WSP(bf16_t, WS_HS), DM, 0, WSP(bf16_t, WS_EW13), DM, (size_t)2 * DFFE * DM};
                pg8::EpiSwiglu E{WSP(bf16_t, WS_UM), DFFE};
                pg8::gemm_phase(lds, g, S, E);
            }
            SEAM(pb + 10);
            if (EN(14) && IN(pb + 11)) REPS(14) {
                PHASE_LOCALS;
                pg8::MoeRange S; const int* moe_off = WSP(int, MS_MOEOFF);
#pragma unroll
                for (int e = 0; e < 9; ++e) S.off[e] = __builtin_amdgcn_readfirstlane(moe_off[e]);
                S.init(S.off[8] / 256, DM / 256, G, bx); int Gd = G; asm volatile("" : "+s"(Gd)); S.i0 = 0; S.i1 = S.nwg / Gd;
                if ((S.i1 * G) % (pg8::WGM * (DM / 256)) == 0) S.nwg = S.i1 * G; else S.i1 += 1;
                pg8::Gemm g{WSP(bf16_t, WS_UM), DFFE, 0, WSP(bf16_t, WS_EW2), DFFE, (size_t)DM * DFFE};
                pg8::EpiBf16 E{WSP(bf16_t, WS_HS), DM, nullptr};
                pg8::gemm_phase(lds, g, S, E);
            }
            SEAM(pb + 11);
            if (EN(15) && IN(pb + 12)) REPS(15) { PHASE_LOCALS;
                pg8::MoeOne S; const int* moe_off = WSP(int, MS_MOEOFF);
#pragma unroll
                for (int e = 0; e < 9; ++e) S.off[e] = __builtin_amdgcn_readfirstlane(moe_off[e]);
                S.init(S.off[8] / 256, DM / 256, G, bx);
                int Gd = G; asm volatile("" : "+s"(Gd)); constexpr int NIG = pg8::WGM * (DM / 256);
                const int R = S.nwg / Gd; const bool clean = ((R * G) % NIG) == 0; const int Lc = clean ? S.nwg - R * G : 0;
                LAS int* late = (LAS int*)(lds + LDSCTL_OFF + 8192);
                for (int u = tid; u < 512; u += NWAVES * 64) late[u] = (clean && Lc > 0 && u >= (R * G) / (DM / 256) && u < S.nM) ? 1 : 0;
                __syncthreads();
                if (bx < Lc) {
                    { const int id = R * G + bx, gid = id / NIG, fm = gid * pg8::WGM, gsz = (S.nM - fm) < pg8::WGM ? (S.nM - fm) : pg8::WGM; S.pm1 = fm + (id % NIG) % gsz; S.pn1 = (id % NIG) / gsz; }
                    pg8::Gemm g{WSP(bf16_t, WS_UM), DFFE, 0, WSP(bf16_t, WS_EW2), DFFE, (size_t)DM * DFFE};
                    pg8::EpiBf16 E{WSP(bf16_t, WS_HS), DM, nullptr};
                    pg8::gemm_phase(lds, g, S, E);
                } else final_phase(A->out, WSP(bf16_t, WS_HS), WSP(int, MS_ROUTE), WSP(int, MS_SLOTS), A->final_norm_g, A->out, late, false, bx - Lc, G - Lc, wave, lane);
                xcd_barrier(bar);
                final_phase(A->out, WSP(bf16_t, WS_HS), WSP(int, MS_ROUTE), WSP(int, MS_SLOTS), A->final_norm_g, A->out, late, true, vcu, G, wave, lane);
            }
        }
    }
#undef IN
#undef EN
#undef SEAM
#undef PHASE_LOCALS
#undef WSP
}

extern "C" void kernel_launch(void* const* d_in, const int* in_sizes, int n_in, void* d_out, int out_size, void* d_ws, size_t ws_size, hipStream_t stream) {
    static int grid = 0;
    if (grid == 0) {
        if (n_in != 23 || in_sizes[0] != T * DM || out_size != T * DM || ws_size < WS_NEED) {
            fprintf(stderr, "kernel_launch: shape mismatch: n_in %d in0 %d out %d ws %zu (need %zu)\n", n_in, n_in > 0 ? in_sizes[0] : -1, out_size, ws_size, (size_t)WS_NEED); grid = -1; return; }
        int dev = 0, cus = 0, per_cu = 0;
        if (hipGetDevice(&dev) != hipSuccess || hipDeviceGetAttribute(&cus, hipDeviceAttributeMultiprocessorCount, dev) != hipSuccess) { fprintf(stderr, "kernel_launch: device query failed\n"); grid = -1; return; }
        if (hipFuncSetAttribute((const void*)mega_fwd, hipFuncAttributeMaxDynamicSharedMemorySize, LDS_BYTES) != hipSuccess) { fprintf(stderr, "kernel_launch: hipFuncSetAttribute failed\n"); grid = -1; return; }
        if (hipOccupancyMaxActiveBlocksPerMultiprocessor(&per_cu, (const void*)mega_fwd, NWAVES * 64, LDS_BYTES) != hipSuccess || per_cu < 1)
            fprintf(stderr, "kernel_launch: note: occupancy query reports %d workgroups per CU\n", per_cu);
        (void)hipGetLastError();
        grid = cus;
    }
    if (grid < 0) return;
    if (hipMemsetAsync((char*)d_ws + WS_CTL, 0, CTL_ZERO_BYTES, stream) != hipSuccess) { fprintf(stderr, "kernel_launch: memset failed\n"); return; }
    Args a{};
    a.x = (const float*)d_in[0]; a.positions = (const int*)d_in[1]; a.attn_norm_g = (const float*)d_in[2]; a.w_in = (const float*)d_in[3]; a.diff_lambda = (const float*)d_in[4];
    a.diff_subln_g = (const float*)d_in[5]; a.fox_bias = (const float*)d_in[6]; a.q_norm_g = (const float*)d_in[7]; a.kv_norm_g = (const float*)d_in[8]; a.w_uq = (const float*)d_in[9];
    a.w_uk = (const float*)d_in[10]; a.w_uv = (const float*)d_in[11]; a.w_branch = (const float*)d_in[12]; a.w_out = (const float*)d_in[13]; a.ffn_norm_g = (const float*)d_in[14];
    a.dense_w1 = (const float*)d_in[15]; a.dense_w3 = (const float*)d_in[16]; a.dense_w2 = (const float*)d_in[17]; a.router_w = (const float*)d_in[18]; a.expert_w1 = (const float*)d_in[19];
    a.expert_w3 = (const float*)d_in[20]; a.expert_w2 = (const float*)d_in[21]; a.final_norm_g = (const float*)d_in[22];
    a.out = (float*)d_out; a.ws = (unsigned char*)d_ws;
#if MK_ONE_LAUNCH
    a.ph_lo = 0; a.ph_hi = NPH; a.li = 0;
    hipLaunchKernelGGL(mega_fwd, dim3(grid), dim3(NWAVES * 64), LDS_BYTES, stream, a);
#else
    int li = 0;
    for (int k = 0; k < NPH; ++k) { if (!phase_exists(k)) continue;
        a.ph_lo = k; a.ph_hi = k + 1; a.li = li++;
        hipLaunchKernelGGL(mega_fwd, dim3(grid), dim3(NWAVES * 64), LDS_BYTES, stream, a); }
#endif
    const hipError_t le = hipPeekAtLastError();
    if (le != hipSuccess) fprintf(stderr, "kernel_launch: launch failed: %s\n", hipGetErrorName(le));
}
```

```cpp
#include <hip/hip_runtime.h>
#include <cstdio>
#include <cstdint>

#ifndef MK_ONE_LAUNCH
#define MK_ONE_LAUNCH 1
#endif

#define GAS __attribute__((address_space(1)))
#define LAS __attribute__((address_space(3)))
typedef unsigned short bf16_t;
typedef short bf16x8 __attribute__((ext_vector_type(8)));
typedef short s16x4 __attribute__((ext_vector_type(4)));
typedef float f32x4 __attribute__((ext_vector_type(4)));
typedef float f32x2 __attribute__((ext_vector_type(2)));
typedef float f32x16 __attribute__((ext_vector_type(16)));
typedef unsigned u32x4 __attribute__((ext_vector_type(4)));
typedef unsigned u32x2 __attribute__((ext_vector_type(2)));
typedef int i32x4 __attribute__((ext_vector_type(4)));

constexpr int NB = 8, SEQ = 4096, T = NB * SEQ, DM = 2048, DEPTH = 2;
constexpr int N_IN_SRC = 13384, NIN = 13568, LDP = 13312, TAILW = 256;
constexpr int DFF = 5632, NEXP = 8, DFFE = 7168;
constexpr float NORM_EPS = 1e-6f;
constexpr int PC_AQ = 0, PC_AK = 1024, PC_AV = 2048, PC_BQ = 3072, PC_BK = 4096, PC_BV = 5120, PC_CQ = 6144, PC_CKV = 6656, PC_GATE = 7168;
constexpr int MOE_ROWS = 2 * T + 2048;

constexpr size_t MiB = 1u << 20;
constexpr size_t WS_CTL = 0, CTL_ZERO_BYTES = 1 * MiB;
constexpr size_t WS_MISC = 3 * MiB;
constexpr size_t MS_RSTDQ = WS_MISC, MS_RSTDKV = MS_RSTDQ + (size_t)T * 4, MS_CKS = MS_RSTDKV + (size_t)T * 4, MS_ROUTE = MS_CKS + (size_t)NB * 8 * SEQ * 4,
                 MS_RSTD2 = MS_ROUTE + (size_t)T * 16, MS_SLOTS = MS_RSTD2 + (size_t)T * 4, MS_CNT = MS_SLOTS + (size_t)T * 8, MS_MOEOFF = MS_CNT + 1024 * 8 * 4,
                 MS_LAM = MS_MOEOFF + 256, MS_END = MS_LAM + 256;
static_assert(MS_END <= 8 * MiB, "misc region");
constexpr size_t WS_BASE = 8 * MiB;
constexpr size_t SZ_WIN = (size_t)NIN * DM * 2, SZ_WUQ = (size_t)1536 * 512 * 2, SZ_WUKV = (size_t)2048 * 512 * 2, SZ_WBR = (size_t)3 * 2048 * 1024 * 2, SZ_WOUT = (size_t)DM * DM * 2;
constexpr size_t WS_WIN = WS_BASE, WS_WD13 = WS_WIN + 2 * SZ_WIN, WS_WD2 = WS_WD13 + (size_t)2 * DFF * DM * 2, WS_H = WS_WD2 + (size_t)DM * DFF * 2,
                 WS_WUQ = WS_H + (size_t)T * DM * 2, WS_WUKV = WS_WUQ + 2 * SZ_WUQ, WS_TAIL = WS_WUKV + 2 * SZ_WUKV, WS_EARLY_END = WS_TAIL + (size_t)T * TAILW * 4 + (size_t)T * DM * 2  ,
                 WS_WBR = WS_EARLY_END, WS_WOUT = WS_WBR + 2 * SZ_WBR,
                 WS_PROJ = WS_WOUT + 2 * SZ_WOUT, WS_QM = WS_PROJ + (size_t)T * LDP * 2, WS_KNV = WS_QM + (size_t)T * 1536 * 2,
                 WS_KROT = WS_KNV + (size_t)T * 2048 * 2, WS_OBUF = WS_KROT + (size_t)T * 64 * 2, WS_MIX_END = WS_OBUF + (size_t)T * 3072 * 2;
constexpr size_t WS_MERGED = WS_QM;
static_assert((size_t)T * DM * 2 <= (size_t)T * (1536 + 2048) * 2, "merged fits in qm | knv");
constexpr size_t WS_UD = WS_PROJ;
static_assert((size_t)T * DFF * 2 <= (size_t)T * LDP * 2, "dense hidden fits in proj");
constexpr size_t WS_EW13 = WS_BASE, WS_HS = WS_EW13 + (size_t)NEXP * 2 * DFFE * DM * 2,
                 WS_UM = WS_HS + (size_t)MOE_ROWS * DM * 2, WS_MOE_END = WS_UM + (size_t)MOE_ROWS * DFFE * 2;
constexpr size_t WS_EW2 = WS_MIX_END > WS_MOE_END ? WS_MIX_END : WS_MOE_END;
constexpr size_t WS_NEED = WS_EW2 + (size_t)NEXP * DM * DFFE * 2;
constexpr int EARLY_EXP = 8;
static_assert(WS_EW13 + (size_t)EARLY_EXP * 2 * DFFE * DM * 2 <= WS_EARLY_END, "the early experts' copies must stay inside [WIN, WD13, WD2, H, WUQ, WUKV, TAIL, spare]");
static_assert(WS_NEED <= 2134232128ull, "workspace map exceeds the guaranteed minimum");
constexpr int CW_TMO = 0, CW_BAR = 4096;

constexpr int RING_BYTES = 131072, LDSCTL_OFF = RING_BYTES, MISC_OFF = LDSCTL_OFF + 320, LDS_BYTES = 147456;

#define RLX_AGENT __ATOMIC_RELAXED, __HIP_MEMORY_SCOPE_AGENT
#define LDS_WAIT() asm volatile("s_waitcnt lgkmcnt(0)" ::: "memory")
#define VM_WAIT() asm volatile("s_waitcnt vmcnt(0)" ::: "memory")
__device__ __forceinline__ unsigned cvt_pk_bf16(float lo, float hi) { unsigned r; asm volatile("v_cvt_pk_bf16_f32 %0, %1, %2" : "=v"(r) : "v"(lo), "v"(hi)); return r; }
__device__ __forceinline__ float bf2f(unsigned short h) { return __uint_as_float((unsigned)h << 16); }
__device__ __forceinline__ float bflo(unsigned w) { return __uint_as_float(w << 16); }
__device__ __forceinline__ float bfhi(unsigned w) { return __uint_as_float(w & 0xffff0000u); }
template <int CTRL> __device__ __forceinline__ float dpp_f(float v) { return __int_as_float(__builtin_amdgcn_update_dpp(0, __float_as_int(v), CTRL, 0xf, 0xf, true)); }
__device__ __forceinline__ float row_sum16(float v) {
    v += dpp_f<0xB1>(v);
    v += dpp_f<0x4E>(v);
    v += dpp_f<0x141>(v);
    v += dpp_f<0x140>(v);
    return v;
}
__device__ __forceinline__ float wave_sum(float v) {
    v = row_sum16(v);
    const int i = __float_as_int(v);
    return (__int_as_float(__builtin_amdgcn_readlane(i, 0)) + __int_as_float(__builtin_amdgcn_readlane(i, 16))) + (__int_as_float(__builtin_amdgcn_readlane(i, 32)) + __int_as_float(__builtin_amdgcn_readlane(i, 48)));
}
__device__ __forceinline__ float sigmoidf_(float x) { return __builtin_amdgcn_rcpf(1.0f + __expf(-x)); }

#define XB_TMO      128
#define XB_XCNT(j)  (256  + 64 * (j))
#define XB_XSUB(j)  (1280 + 64 * (j))
#define XB_XGEN(j)  (2304 + 64 * (j))
#define XB_TOP      3328
#define XB_TOPGEN   3392
#define XCD_BAR_WORDS 3456
#define XB_SPIN_CAP (1u << 22)
__device__ __forceinline__ unsigned xb_ld(unsigned* p)              { return __hip_atomic_load(p, __ATOMIC_RELAXED, __HIP_MEMORY_SCOPE_AGENT); }
__device__ __forceinline__ unsigned xb_add(unsigned* p, unsigned v) { return __hip_atomic_fetch_add(p, v, __ATOMIC_RELAXED, __HIP_MEMORY_SCOPE_AGENT); }
__device__ __forceinline__ unsigned xb_xcc_id() { return (unsigned)__builtin_amdgcn_s_getreg((3 << 11) | 20) & 0xFu; }
#define XB_SPIN(cond, bar) do { unsigned _sp = 0; while (cond) { __builtin_amdgcn_s_sleep(1); \
    if ((++_sp & 255u) == 0u) { if (xb_ld(&(bar)[XB_TMO])) break; if (_sp > XB_SPIN_CAP) { atomicAdd(&(bar)[XB_TMO], 1u); break; } } } } while (0)
struct XcdBarrier { unsigned* bar; unsigned x; volatile LAS unsigned* st; };
__device__ __forceinline__ XcdBarrier xcd_barrier_post(unsigned* bar, volatile LAS unsigned* st) {
    XcdBarrier b; b.bar = bar; b.x = xb_xcc_id(); b.st = st;
    if (threadIdx.x == 0) (void)xb_add(&bar[XB_XCNT(b.x)], 1u);
    return b;
}
__device__ __forceinline__ void xcd_barrier_complete(unsigned* bar, unsigned x, unsigned& nloc, unsigned& nx) {
    const unsigned G = gridDim.x * gridDim.y * gridDim.z;
    unsigned sum, cnt, mine, sp = 0u;
    for (;;) {
        sum = 0u; cnt = 0u; mine = 0u;
#pragma unroll
        for (unsigned j = 0; j < 16; ++j) { const unsigned c = xb_ld(&bar[XB_XCNT(j)]); sum += c; cnt += (c > 0u) ? 1u : 0u; mine = (j == x) ? c : mine; }
        if (sum == G) break;
        __builtin_amdgcn_s_sleep(1);
        if ((++sp & 255u) == 0u) { if (xb_ld(&bar[XB_TMO])) break; if (sp > XB_SPIN_CAP) { atomicAdd(&bar[XB_TMO], 1u); break; } }
    }
    nloc = mine > 0u ? mine : 1u; nx = cnt > 0u ? cnt : 1u;
}
__device__ __forceinline__ void xcd_barrier(const XcdBarrier& b) {
    asm volatile("s_waitcnt vmcnt(0)" ::: "memory");
    __syncthreads();
    if (threadIdx.x == 0) {
        unsigned* bar = b.bar;
        __builtin_amdgcn_s_waitcnt(0);
        unsigned nloc = b.st[0], nx = b.st[1];
        if (nloc == 0u) { xcd_barrier_complete(bar, b.x, nloc, nx); b.st[0] = nloc; b.st[1] = nx; }
        const unsigned old = xb_add(&bar[XB_XSUB(b.x)], 1u);
        const unsigned gen = old / nloc;
        if (old + 1u == (gen + 1u) * nloc) {
            __builtin_amdgcn_fence(__ATOMIC_RELEASE, "agent");
            asm volatile("s_waitcnt vmcnt(0)" ::: "memory");
            const unsigned og = xb_add(&bar[XB_TOP], 1u);
            const unsigned tg = og / nx;
            if (og + 1u == (tg + 1u) * nx) xb_add(&bar[XB_TOPGEN], 1u);
            else XB_SPIN(xb_ld(&bar[XB_TOPGEN]) == tg, bar);
            __builtin_amdgcn_fence(__ATOMIC_ACQUIRE, "agent");
            xb_add(&bar[XB_XGEN(b.x)], 1u);
            asm volatile("s_waitcnt vmcnt(0)" ::: "memory");
        } else {
            XB_SPIN(xb_ld(&bar[XB_XGEN(b.x)]) == gen, bar);
            __builtin_amdgcn_fence(__ATOMIC_ACQUIRE, "agent");
            asm volatile("s_waitcnt vmcnt(0)" ::: "memory");
        }
    }
    __syncthreads();
}

#ifndef PG8_SP2
#define PG8_SP2 1
#endif
namespace pg8 {
constexpr int BM = 256, BK = 64, HALF = 128, HTB = HALF * BK * 2, STAGE_BYTES = 8 * HTB, NXCD = 8, WGM = 4;
__host__ __device__ __forceinline__ int lds_byte(int r, int c) { const int st = (r >> 4) * 2 + (c >> 5), rr = r & 15, cc = c & 31, ob = rr * 64 + cc * 2; return st * 1024 + (ob ^ (((ob >> 9) & 1) << 5)); }
__host__ __device__ __forceinline__ void stage_rc(int b, int& R, int& C) { const int st = b / 1024, sb = b % 1024, swz = sb ^ (((sb >> 9) & 1) << 5); R = (st >> 1) * 16 + swz / 64; C = (st & 1) * 32 + (swz % 64) / 2; }
__host__ __device__ __forceinline__ int perm32(int rho) { const int n = rho >> 4, i = rho & 15; return 8 * (i >> 2) + 4 * n + (i & 3); }

struct Unit { int pm, pn, z; };
struct Gemm { const bf16_t* A; int lda; size_t azs; const bf16_t* Bt; int K; size_t bzs; };

struct StaticOrder {
    int nM, nN, nwg, G, c;
    __device__ void init(int nM_, int nN_, int G_, int c_) { nM = nM_; nN = nN_; nwg = nM * nN; G = G_; c = c_; }
    __device__ __forceinline__ bool tile(int i, int& pm, int& pn) const {
        const long L = (long)i * G + c; if (L >= nwg) return false;
        int wgid = (int)L; { const int q = nwg / NXCD, r = nwg % NXCD, xcd = wgid % NXCD, off = wgid / NXCD; wgid = (xcd < r ? xcd * (q + 1) : r * (q + 1) + (xcd - r) * q) + off; }
        const int nig = WGM * nN, gid = wgid / nig, fm = gid * WGM, gsz = (nM - fm) < WGM ? (nM - fm) : WGM;
        pm = fm + ((wgid % nig) % gsz); pn = (wgid % nig) / gsz; return true;
    }
    __device__ bool next(int i, Unit& u) const { u.z = 0; return tile(i, u.pm, u.pn); }
};
struct Z3Order : StaticOrder {
    __device__ bool next(int i, Unit& u) const { u.z = i % 3; return tile(i / 3, u.pm, u.pn); }
};
struct MoeOrder : StaticOrder {
    int off[9];
    __device__ bool next(int i, Unit& u) const {
        if (!tile(i, u.pm, u.pn)) return false;
        const int r = u.pm * 256; int z = 0;
#pragma unroll
        for (int e = 1; e < 8; ++e) z += (r >= off[e]) ? 1 : 0;
        u.z = z; return true;
    }
};
struct MoeRange : MoeOrder {
    int i0, i1;
    __device__ bool next(int i, Unit& u) const { return (i + i0 < i1) && MoeOrder::next(i + i0, u); }
};
struct MoeOne : MoeOrder {
    int pm1, pn1;
    __device__ bool next(int i, Unit& u) const {
        if (i != 0) return false;
        u.pm = pm1; u.pn = pn1; const int r = pm1 * 256; int z = 0;
#pragma unroll
        for (int e = 1; e < 8; ++e) z += (r >= off[e]) ? 1 : 0;
        u.z = z; return true;
    }
};

template <class Epi, class Sched>
__device__ __forceinline__ void gemm_phase(LAS unsigned char* lds, const Gemm g, const Sched& S, const Epi& E) {
    int tid = threadIdx.x; asm volatile("" : "+v"(tid));
    const int wid = __builtin_amdgcn_readfirstlane(tid >> 6), lane = tid & 63, wr = wid >> 2, wc = wid & 3, fr = lane & 15, fq = lane >> 4;
    const int K = g.K, nt = K / BK, lda = g.lda;
    unsigned voffA[2], voffB[2];
#pragma unroll
    for (int i = 0; i < 2; ++i) { int R, C; stage_rc(tid * 16 + i * 8192, R, C); const int Rb = Epi::PERM ? ((R & ~31) + perm32(R & 31)) : R;
        voffA[i] = (unsigned)(R * lda + C) * 2u; voffB[i] = (unsigned)(Rb * K + C) * 2u; }
    const size_t kstep = (size_t)(BK * 2);
    const size_t hstepA = (size_t)HALF * lda * 2, hstepB = (size_t)HALF * K * 2;
    const unsigned ldsw = (unsigned)wid * 1024u;
    const int aoff = lds_byte(wr * 64 + fr, fq * 8), boff = lds_byte(wc * 32 + fr, fq * 8);
#define PG8_SA(b, h) (((b) * 2 + (h)) * HTB)
#define PG8_SB(b, h) ((4 + (b) * 2 + (h)) * HTB)
#define PG8_STAGE(bufoff, gbase, voff) do { _Pragma("unroll") for (int _i = 0; _i < 2; ++_i) \
        __builtin_amdgcn_global_load_lds((const unsigned*)((const char*)(gbase) + (voff)[_i]), (LAS unsigned*)(lds + (bufoff) + ldsw + _i * 8192), 16, 0, 0); } while (0)
#define PG8_LDA(dst, b, h) do { _Pragma("unroll") for (int m = 0; m < 4; ++m) _Pragma("unroll") for (int k = 0; k < 2; ++k) dst[m][k] = *(const LAS bf16x8*)(lds + PG8_SA(b, h) + aoff + m * 2048 + k * 1024); } while (0)
#define PG8_LDB(dst, b, h) do { _Pragma("unroll") for (int n = 0; n < 2; ++n) _Pragma("unroll") for (int k = 0; k < 2; ++k) dst[n][k] = *(const LAS bf16x8*)(lds + PG8_SB(b, h) + boff + n * 2048 + k * 1024); } while (0)
#define PG8_MMA(ai, bj, At, Bt) do { __builtin_amdgcn_s_setprio(1); _Pragma("unroll") for (int m = 0; m < 4; ++m) _Pragma("unroll") for (int n = 0; n < 2; ++n) _Pragma("unroll") for (int k = 0; k < 2; ++k) \
        acc[ai][bj][m][n] = __builtin_amdgcn_mfma_f32_16x16x32_bf16(Bt[n][k], At[m][k], acc[ai][bj][m][n], 0, 0, 0); __builtin_amdgcn_s_setprio(0); } while (0)
#define PG8_WAIT_V(n) asm volatile("s_waitcnt vmcnt(" #n ")" ::: "memory")
#define PG8_WAIT_L(n) asm volatile("s_waitcnt lgkmcnt(" #n ")" ::: "memory")
#define PG8_WAIT_VR(t_, ui_) asm volatile("s_waitcnt vmcnt(16)\n\ts_cmp_lg_u32 %0, 0\n\ts_cbranch_scc1 .Lpg8s%=\n\ts_cmp_lg_u32 %1, 0\n\ts_cbranch_scc1 .Lpg8r%=\n.Lpg8s%=:\n\ts_waitcnt vmcnt(8)\n.Lpg8r%=:" :: "s"(t_), "s"(ui_) : "memory", "scc")
#define PG8_BAR __builtin_amdgcn_s_barrier()
#define PG8_SCHED __builtin_amdgcn_sched_barrier(0)
    Unit cur, nxt; int ui = 0;
    if (!S.next(0, cur)) return;
    f32x4 acc[2][2][4][2];
#pragma unroll
    for (int a = 0; a < 2; ++a)
#pragma unroll
        for (int b = 0; b < 2; ++b)
#pragma unroll
            for (int m = 0; m < 4; ++m)
#pragma unroll
                for (int n = 0; n < 2; ++n) acc[a][b][m][n] = (f32x4){0.f, 0.f, 0.f, 0.f};
    bf16x8 At[4][2], B0[2][2], B1[2][2];
    const char* cA = (const char*)(g.A + (size_t)cur.z * g.azs) + (size_t)cur.pm * 2 * hstepA;
    const char* cB = (const char*)(g.Bt + (size_t)cur.z * g.bzs) + (size_t)cur.pn * 2 * hstepB;
#if PG8_SP2
    PG8_STAGE(PG8_SB(0, 0), cB, voffB); PG8_STAGE(PG8_SB(0, 1), cB + hstepB, voffB); PG8_STAGE(PG8_SA(0, 0), cA, voffA); PG8_STAGE(PG8_SA(0, 1), cA + hstepA, voffA);
    if (wr == 1) PG8_BAR;
    PG8_WAIT_V(2); PG8_BAR;
    PG8_STAGE(PG8_SB(1, 0), cB + kstep, voffB); PG8_STAGE(PG8_SA(1, 0), cA + kstep, voffA); PG8_STAGE(PG8_SB(1, 1), cB + hstepB + kstep, voffB);
    PG8_WAIT_V(6); PG8_BAR;
#else
    PG8_STAGE(PG8_SB(0, 0), cB, voffB); PG8_STAGE(PG8_SA(0, 0), cA, voffA); PG8_STAGE(PG8_SB(0, 1), cB + hstepB, voffB); PG8_STAGE(PG8_SA(0, 1), cA + hstepA, voffA);
    if (wr == 1) PG8_BAR;
    PG8_WAIT_V(4); PG8_BAR;
    PG8_STAGE(PG8_SB(1, 0), cB + kstep, voffB); PG8_STAGE(PG8_SA(1, 0), cA + kstep, voffA); PG8_STAGE(PG8_SB(1, 1), cB + hstepB + kstep, voffB);
    PG8_WAIT_V(6); PG8_BAR;
#endif
    for (;;) {
        const bool has_next = S.next(ui + 1, nxt);
        const char* nA = has_next ? (const char*)(g.A + (size_t)nxt.z * g.azs) + (size_t)nxt.pm * 2 * hstepA : cA;
        const char* nB = has_next ? (const char*)(g.Bt + (size_t)nxt.z * g.bzs) + (size_t)nxt.pn * 2 * hstepB : cB;
        for (int t = 0; t < nt; t += 2) {
            const bool last = (t == nt - 2);
            const char* a1 = cA + (size_t)(t + 1) * kstep;
            const char* a2 = last ? nA : cA + (size_t)(t + 2) * kstep; const char* b2 = last ? nB : cB + (size_t)(t + 2) * kstep;
            const char* a3 = a2 + kstep; const char* b3 = b2 + kstep;
#if PG8_SP2
            PG8_LDB(B0, 0, 0); PG8_LDB(B1, 0, 1); PG8_SCHED; PG8_LDA(At, 0, 0); PG8_STAGE(PG8_SA(1, 1), a1 + hstepA, voffA);
            PG8_WAIT_VR(t, ui);
            PG8_WAIT_L(0); PG8_BAR; PG8_MMA(0, 0, At, B0); PG8_MMA(0, 1, At, B1); PG8_BAR; PG8_SCHED;
            PG8_LDA(At, 0, 1); PG8_STAGE(PG8_SB(0, 0), b2, voffB); PG8_STAGE(PG8_SB(0, 1), b2 + hstepB, voffB); PG8_STAGE(PG8_SA(0, 0), a2, voffA);
            PG8_WAIT_VR(t, ui);
            PG8_WAIT_L(0); PG8_BAR; PG8_MMA(1, 0, At, B0); PG8_MMA(1, 1, At, B1); PG8_BAR; PG8_SCHED;
            PG8_LDB(B0, 1, 0); PG8_LDB(B1, 1, 1); PG8_SCHED; PG8_LDA(At, 1, 0); PG8_STAGE(PG8_SA(0, 1), a2 + hstepA, voffA);
            PG8_WAIT_V(8); PG8_WAIT_L(0); PG8_BAR; PG8_MMA(0, 0, At, B0); PG8_MMA(0, 1, At, B1); PG8_BAR; PG8_SCHED;
            PG8_LDA(At, 1, 1); PG8_STAGE(PG8_SB(1, 0), b3, voffB); PG8_STAGE(PG8_SB(1, 1), b3 + hstepB, voffB); PG8_STAGE(PG8_SA(1, 0), a3, voffA);
            PG8_WAIT_V(8); PG8_WAIT_L(0); PG8_BAR; PG8_MMA(1, 0, At, B0); PG8_MMA(1, 1, At, B1); PG8_BAR; PG8_SCHED;
#else
            PG8_LDB(B0, 0, 0); PG8_SCHED; PG8_LDA(At, 0, 0); PG8_STAGE(PG8_SA(1, 1), a1 + hstepA, voffA);
            PG8_WAIT_L(8); PG8_BAR; PG8_WAIT_L(0); PG8_MMA(0, 0, At, B0); PG8_BAR; PG8_SCHED;
            PG8_LDB(B1, 0, 1); PG8_STAGE(PG8_SB(0, 0), b2, voffB);
            PG8_BAR; PG8_WAIT_L(0); PG8_MMA(0, 1, At, B1); PG8_BAR;
            PG8_LDA(At, 0, 1); PG8_STAGE(PG8_SA(0, 0), a2, voffA);
            PG8_BAR; PG8_WAIT_L(0); PG8_MMA(1, 0, At, B0); PG8_BAR; PG8_SCHED;
            PG8_STAGE(PG8_SB(0, 1), b2 + hstepB, voffB);
            PG8_WAIT_V(6); PG8_BAR; PG8_MMA(1, 1, At, B1); PG8_BAR;
            PG8_LDB(B0, 1, 0); PG8_SCHED; PG8_LDA(At, 1, 0); PG8_STAGE(PG8_SA(0, 1), a2 + hstepA, voffA);
            PG8_WAIT_L(8); PG8_BAR; PG8_WAIT_L(0); PG8_MMA(0, 0, At, B0); PG8_BAR; PG8_SCHED;
            PG8_LDB(B1, 1, 1); PG8_STAGE(PG8_SB(1, 0), b3, voffB);
            PG8_BAR; PG8_WAIT_L(0); PG8_MMA(0, 1, At, B1); PG8_BAR;
            PG8_LDA(At, 1, 1); PG8_STAGE(PG8_SA(1, 0), a3, voffA);
            PG8_BAR; PG8_WAIT_L(0); PG8_MMA(1, 0, At, B0); PG8_BAR; PG8_SCHED;
            PG8_STAGE(PG8_SB(1, 1), b3 + hstepB, voffB);
            PG8_WAIT_V(6); PG8_BAR; PG8_MMA(1, 1, At, B1); PG8_BAR;
#endif
        }
        if (wr == 0) PG8_BAR;
        E(acc, cur, wr, wc, fr, fq);
        if (!has_next) break;
#pragma unroll
        for (int a = 0; a < 2; ++a)
#pragma unroll
            for (int b = 0; b < 2; ++b)
#pragma unroll
                for (int m = 0; m < 4; ++m)
#pragma unroll
                    for (int n = 0; n < 2; ++n) acc[a][b][m][n] = (f32x4){0.f, 0.f, 0.f, 0.f};
        cur = nxt; cA = nA; cB = nB; ++ui;
        if (wr == 1) PG8_BAR;
    }
    PG8_WAIT_V(0);
    PG8_BAR;
#undef PG8_SA
#undef PG8_SB
#undef PG8_STAGE
#undef PG8_LDA
#undef PG8_LDB
#undef PG8_MMA
#undef PG8_WAIT_V
#undef PG8_WAIT_L
#undef PG8_WAIT_VR
#undef PG8_BAR
#undef PG8_SCHED
}

#define EPI_ROWS(ai, m) (u.pm * BM + (ai) * HALF + wr * 64 + (m) * 16 + fr)

struct EpiProj {
    static constexpr bool PERM = true;
    bf16_t* O; float* tail;
    __device__ __forceinline__ void operator()(f32x4 (&acc)[2][2][4][2], const Unit& u, int wr, int wc, int fr, int fq) const {
        const int colt = wc * 32 + 8 * fq;
        if (u.pn < LDP / 256) {
#pragma unroll
            for (int ai = 0; ai < 2; ++ai)
#pragma unroll
                for (int m = 0; m < 4; ++m) { bf16_t* rowp = O + (size_t)EPI_ROWS(ai, m) * LDP + u.pn * BM + colt;
#pragma unroll
                    for (int bj = 0; bj < 2; ++bj) { const f32x4 v0 = acc[ai][bj][m][0], v1 = acc[ai][bj][m][1];
                        u32x4 w; w.x = cvt_pk_bf16(v0[0], v0[1]); w.y = cvt_pk_bf16(v0[2], v0[3]); w.z = cvt_pk_bf16(v1[0], v1[1]); w.w = cvt_pk_bf16(v1[2], v1[3]);
                        *(u32x4*)(rowp + bj * HALF) = w; } }
        } else {
#pragma unroll
            for (int ai = 0; ai < 2; ++ai)
#pragma unroll
                for (int m = 0; m < 4; ++m) { float* rowp = tail + (size_t)EPI_ROWS(ai, m) * TAILW + colt;
#pragma unroll
                    for (int bj = 0; bj < 2; ++bj) { *(f32x4*)(rowp + bj * HALF) = acc[ai][bj][m][0]; *(f32x4*)(rowp + bj * HALF + 4) = acc[ai][bj][m][1]; } }
        }
    }
};
struct EpiBf16 {
    static constexpr bool PERM = true;
    bf16_t* O; int ldc; const float* rowscale;
    __device__ __forceinline__ void operator()(f32x4 (&acc)[2][2][4][2], const Unit& u, int wr, int wc, int fr, int fq) const {
        const int colt = u.pn * BM + wc * 32 + 8 * fq;
#pragma unroll
        for (int ai = 0; ai < 2; ++ai)
#pragma unroll
            for (int m = 0; m < 4; ++m) { const int row = EPI_ROWS(ai, m); const float s = rowscale ? rowscale[row] : 1.0f; bf16_t* rowp = O + (size_t)row * ldc + colt;
#pragma unroll
                for (int bj = 0; bj < 2; ++bj) { const f32x4 v0 = acc[ai][bj][m][0] * s, v1 = acc[ai][bj][m][1] * s;
                    u32x4 w; w.x = cvt_pk_bf16(v0[0], v0[1]); w.y = cvt_pk_bf16(v0[2], v0[3]); w.z = cvt_pk_bf16(v1[0], v1[1]); w.w = cvt_pk_bf16(v1[2], v1[3]);
                    *(u32x4*)(rowp + bj * HALF) = w; } }
    }
};
struct EpiQ {
    static constexpr bool PERM = true;
    bf16_t* O; const float* rowscale; const int* positions; float qscale;
    __device__ __forceinline__ void operator()(f32x4 (&acc)[2][2][4][2], const Unit& u, int wr, int wc, int fr, int fq) const {
        const int colt = u.pn * BM + wc * 32 + 8 * fq;
        float sc[2][4], pf[2][4];
#pragma unroll
        for (int ai = 0; ai < 2; ++ai)
#pragma unroll
            for (int m = 0; m < 4; ++m) { const int row = EPI_ROWS(ai, m); sc[ai][m] = rowscale[row] * qscale; pf[ai][m] = (float)positions[row]; }
        float rf[2][4]; bool rope[2];
#pragma unroll
        for (int bj = 0; bj < 2; ++bj) { const int d = (colt + bj * HALF) % 192; rope[bj] = d >= 128;
#pragma unroll
            for (int k = 0; k < 4; ++k) rf[bj][k] = __builtin_amdgcn_exp2f(-(float)((d - 128) / 2 + k) * 0.41524101186092f) * 0.15915494309189535f; }
#pragma unroll
        for (int ai = 0; ai < 2; ++ai)
#pragma unroll
            for (int m = 0; m < 4; ++m) { const int row = EPI_ROWS(ai, m); const float s = sc[ai][m], p = pf[ai][m]; bf16_t* rowp = O + (size_t)row * 1536 + colt;
#pragma unroll
                for (int bj = 0; bj < 2; ++bj) { f32x4 v[2] = {acc[ai][bj][m][0] * s, acc[ai][bj][m][1] * s};
                    if (rope[bj]) {
#pragma unroll
                        for (int k = 0; k < 4; ++k) { const float rev = p * rf[bj][k], frc = rev - floorf(rev); const float c = __builtin_amdgcn_cosf(frc), sn = __builtin_amdgcn_sinf(frc);
                            const float a0 = v[k >> 1][2 * (k & 1)], b0 = v[k >> 1][2 * (k & 1) + 1];
                            v[k >> 1][2 * (k & 1)] = a0 * c - b0 * sn; v[k >> 1][2 * (k & 1) + 1] = b0 * c + a0 * sn; }
                    }
                    u32x4 w; w.x = cvt_pk_bf16(v[0][0], v[0][1]); w.y = cvt_pk_bf16(v[0][2], v[0][3]); w.z = cvt_pk_bf16(v[1][0], v[1][1]); w.w = cvt_pk_bf16(v[1][2], v[1][3]);
                    *(u32x4*)(rowp + bj * HALF) = w; } }
    }
};
struct EpiSwiglu {
    static constexpr bool PERM = true;
    bf16_t* O; int ldc;
    __device__ __forceinline__ void operator()(f32x4 (&acc)[2][2][4][2], const Unit& u, int wr, int wc, int fr, int fq) const {
        const int colt = u.pn * HALF + wc * 32 + 8 * fq;
#pragma unroll
        for (int ai = 0; ai < 2; ++ai)
#pragma unroll
            for (int m = 0; m < 4; ++m) { bf16_t* rowp = O + (size_t)EPI_ROWS(ai, m) * ldc + colt; float r[8];
#pragma unroll
                for (int n = 0; n < 2; ++n)
#pragma unroll
                    for (int i = 0; i < 4; ++i) { const float a = acc[ai][0][m][n][i], b = acc[ai][1][m][n][i]; r[n * 4 + i] = a * sigmoidf_(a) * b; }
                u32x4 w; w.x = cvt_pk_bf16(r[0], r[1]); w.y = cvt_pk_bf16(r[2], r[3]); w.z = cvt_pk_bf16(r[4], r[5]); w.w = cvt_pk_bf16(r[6], r[7]);
                *(u32x4*)rowp = w; }
    }
};
struct EpiBranch {
    static constexpr bool PERM = true;
    bf16_t* O; const bf16_t* proj;
    __device__ __forceinline__ void operator()(f32x4 (&acc)[2][2][4][2], const Unit& u, int wr, int wc, int fr, int fq) const {
        const int colt = u.pn * BM + wc * 32 + 8 * fq;
#pragma unroll
        for (int ai = 0; ai < 2; ++ai) {
            u32x4 gw[4][2];
#pragma unroll
            for (int m = 0; m < 4; ++m) { const bf16_t* gp = proj + (size_t)EPI_ROWS(ai, m) * LDP + PC_GATE + u.z * DM + colt;
#pragma unroll
                for (int bj = 0; bj < 2; ++bj) gw[m][bj] = *(const u32x4*)(gp + bj * HALF); }
            asm volatile("" ::: "memory");
#pragma unroll
            for (int m = 0; m < 4; ++m)
#pragma unroll
                for (int bj = 0; bj < 2; ++bj) { const u32x4 g = gw[m][bj]; const f32x4 v0 = acc[ai][bj][m][0], v1 = acc[ai][bj][m][1];
                    acc[ai][bj][m][0] = (f32x4){v0[0] * sigmoidf_(bflo(g.x)), v0[1] * sigmoidf_(bfhi(g.x)), v0[2] * sigmoidf_(bflo(g.y)), v0[3] * sigmoidf_(bfhi(g.y))};
                    acc[ai][bj][m][1] = (f32x4){v1[0] * sigmoidf_(bflo(g.z)), v1[1] * sigmoidf_(bfhi(g.z)), v1[2] * sigmoidf_(bflo(g.w)), v1[3] * sigmoidf_(bfhi(g.w))}; }
            if (u.z != 0) {
#pragma unroll
                for (int m = 0; m < 4; ++m) { const bf16_t* rowp = O + (size_t)EPI_ROWS(ai, m) * DM + colt;
#pragma unroll
                    for (int bj = 0; bj < 2; ++bj) gw[m][bj] = *(const u32x4*)(rowp + bj * HALF); }
                asm volatile("" ::: "memory");
#pragma unroll
                for (int m = 0; m < 4; ++m)
#pragma unroll
                    for (int bj = 0; bj < 2; ++bj) { const u32x4 o = gw[m][bj];
                        acc[ai][bj][m][0] += (f32x4){bflo(o.x), bfhi(o.x), bflo(o.y), bfhi(o.y)}; acc[ai][bj][m][1] += (f32x4){bflo(o.z), bfhi(o.z), bflo(o.w), bfhi(o.w)}; }
            }
#pragma unroll
            for (int m = 0; m < 4; ++m) { bf16_t* rowp = O + (size_t)EPI_ROWS(ai, m) * DM + colt;
#pragma unroll
                for (int bj = 0; bj < 2; ++bj) { const f32x4 v0 = acc[ai][bj][m][0], v1 = acc[ai][bj][m][1];
                    u32x4 w; w.x = cvt_pk_bf16(v0[0], v0[1]); w.y = cvt_pk_bf16(v0[2], v0[3]); w.z = cvt_pk_bf16(v1[0], v1[1]); w.w = cvt_pk_bf16(v1[2], v1[3]);
                    *(u32x4*)(rowp + bj * HALF) = w; } }
            asm volatile("" ::: "memory");
        }
    }
};
struct EpiResid {
    static constexpr bool PERM = false;
    const float* base; float* out;
    __device__ __forceinline__ void operator()(f32x4 (&acc)[2][2][4][2], const Unit& u, int wr, int wc, int fr, int fq) const {
        const int colt = u.pn * BM + wc * 32 + 4 * fq;
#pragma unroll
        for (int ai = 0; ai < 2; ++ai) {
            f32x4 bv[4][2][2];
#pragma unroll
            for (int m = 0; m < 4; ++m) { const size_t off = (size_t)EPI_ROWS(ai, m) * DM + colt;
#pragma unroll
                for (int bj = 0; bj < 2; ++bj)
#pragma unroll
                    for (int n = 0; n < 2; ++n) bv[m][bj][n] = *(const f32x4*)(base + off + bj * HALF + n * 16); }
            asm volatile("" ::: "memory");
#pragma unroll
            for (int m = 0; m < 4; ++m) { const size_t off = (size_t)EPI_ROWS(ai, m) * DM + colt;
#pragma unroll
                for (int bj = 0; bj < 2; ++bj)
#pragma unroll
                    for (int n = 0; n < 2; ++n) *(f32x4*)(out + off + bj * HALF + n * 16) = bv[m][bj][n] + acc[ai][bj][m][n]; }
            asm volatile("" ::: "memory");
        }
    }
};
#undef EPI_ROWS
}

namespace att {
constexpr int OFF_V = 0, SHM_V = 16384, OFF_KAUX = 32768, OFF_WS = 33280, OFF_KX = 35328, SHM_KX = 2048, OFF_K = 40960;
constexpr float L2E = 1.4426950408889634f, THR2 = 8.f * L2E;
template <int MODE> struct Cfg;
template <> struct Cfg<0> { static constexpr int DK = 64, NQ = 4; static constexpr float SCALE = 0.125f; };
template <> struct Cfg<1> { static constexpr int DK = 128, NQ = 8; static constexpr float SCALE = 0.08838834764831845f; };
template <> struct Cfg<2> { static constexpr int DK = 192, NQ = 12; static constexpr float SCALE = 0.07216878364870322f; };
static_assert(OFF_K + 2 * 64 * 192 * 2 <= RING_BYTES, "attention LDS map");

__device__ __forceinline__ int crow(int r, int hi) { return (r & 3) + 8 * (r >> 2) + 4 * hi; }
#define SBAR() __builtin_amdgcn_sched_barrier(0)
__device__ __forceinline__ void partialSM2(f32x16& p0, f32x16& p1, bool first, float& m_reg, float& alpha) {
    float pmax = p0[0];
#pragma unroll
    for (int r = 1; r < 16; ++r) pmax = fmaxf(pmax, p0[r]);
#pragma unroll
    for (int r = 0; r < 16; ++r) pmax = fmaxf(pmax, p1[r]);
    { auto rr = __builtin_amdgcn_permlane32_swap(__float_as_uint(pmax), __float_as_uint(pmax), false, false);
      pmax = fmaxf(__uint_as_float(rr[0]), __uint_as_float(rr[1])); }
    if (first) {
        m_reg = pmax; alpha = 0.f;
#pragma unroll
        for (int r = 0; r < 16; ++r) { p0[r] -= pmax; p1[r] -= pmax; }
    } else if (__builtin_expect(__all(pmax <= THR2), 1)) { alpha = 1.f; }
    else { const float delta = fmaxf(pmax, 0.f); alpha = __builtin_amdgcn_exp2f(-delta); m_reg += delta;
#pragma unroll
        for (int r = 0; r < 16; ++r) { p0[r] -= delta; p1[r] -= delta; } }
#pragma unroll
    for (int r = 0; r < 16; ++r) p0[r] = __builtin_amdgcn_exp2f(p0[r]);
}
__device__ __forceinline__ void finishSM(f32x16& p0, f32x16& p1, float alpha, float& l_reg, bf16x8& pa0, bf16x8& pa1, bf16x8& pa2, bf16x8& pa3) {
#pragma unroll
    for (int r = 0; r < 16; ++r) p1[r] = __builtin_amdgcn_exp2f(p1[r]);
    float ps = 0;
#pragma unroll
    for (int r = 0; r < 16; ++r) ps += p0[r];
#pragma unroll
    for (int r = 0; r < 16; ++r) ps += p1[r];
    { auto rr = __builtin_amdgcn_permlane32_swap(__float_as_uint(ps), __float_as_uint(ps), false, false);
      ps = __uint_as_float(rr[0]) + __uint_as_float(rr[1]); }
    l_reg = l_reg * alpha + ps;
#define PK4(P, BASE, OUT) do { unsigned a0 = cvt_pk_bf16(P[BASE + 0], P[BASE + 1]), a1 = cvt_pk_bf16(P[BASE + 2], P[BASE + 3]);   \
    unsigned b0 = cvt_pk_bf16(P[BASE + 4], P[BASE + 5]), b1 = cvt_pk_bf16(P[BASE + 6], P[BASE + 7]);                              \
    auto r0 = __builtin_amdgcn_permlane32_swap(a0, b0, false, false); auto r1 = __builtin_amdgcn_permlane32_swap(a1, b1, false, false); \
    u32x4 w = {r0[0], r1[0], r0[1], r1[1]}; OUT = *reinterpret_cast<bf16x8*>(&w); } while (0)
    PK4(p0, 0, pa0); PK4(p0, 8, pa1); PK4(p1, 0, pa2); PK4(p1, 8, pa3);
#undef PK4
}
__device__ __forceinline__ int v_st(int k, int c) { const int kk = (k & ~0xC) | ((k & 4) << 1) | ((k & 8) >> 1); return ((kk >> 3) * 4 + (c >> 5)) * 512 + ((kk & 7) * 32 + (c & 31)) * 2; }
__device__ __forceinline__ int v_rd_base(int lane) { return ((lane & 3) << 3) | (((lane >> 2) & 3) << 6) | (((lane >> 4) & 1) << 5) | (((lane >> 5) & 1) << 8); }
constexpr int v_rd_off(int d0, int ks, int half) { return d0 * 512 + ks * 4096 + half * 2048; }
template <int OFF> __device__ __forceinline__ s16x4 tr_read(int vb) {
    s16x4 r; asm volatile("ds_read_b64_tr_b16 %0, %1 offset:%2" : "=&v"(r) : "v"(vb), "i"(OFF) : "memory"); return r;
}
struct VFrag { s16x4 l0, h0, l1, h1, l2, h2, l3, h3; };
template <int D0> __device__ __forceinline__ void v_load(VFrag& f, int vb) {
    f.l0 = tr_read<v_rd_off(D0, 0, 0)>(vb); f.h0 = tr_read<v_rd_off(D0, 0, 1)>(vb); f.l1 = tr_read<v_rd_off(D0, 1, 0)>(vb); f.h1 = tr_read<v_rd_off(D0, 1, 1)>(vb);
    f.l2 = tr_read<v_rd_off(D0, 2, 0)>(vb); f.h2 = tr_read<v_rd_off(D0, 2, 1)>(vb); f.l3 = tr_read<v_rd_off(D0, 3, 0)>(vb); f.h3 = tr_read<v_rd_off(D0, 3, 1)>(vb);
}
__device__ __forceinline__ void pv_mma(f32x16& od, const VFrag& f, bf16x8 pa0, bf16x8 pa1, bf16x8 pa2, bf16x8 pa3) {
#define PK(L, H) (bf16x8){L[0], L[1], L[2], L[3], H[0], H[1], H[2], H[3]}
    od = __builtin_amdgcn_mfma_f32_32x32x16_bf16(pa0, PK(f.l0, f.h0), od, 0, 0, 0);
    od = __builtin_amdgcn_mfma_f32_32x32x16_bf16(pa1, PK(f.l1, f.h1), od, 0, 0, 0);
    od = __builtin_amdgcn_mfma_f32_32x32x16_bf16(pa2, PK(f.l2, f.h2), od, 0, 0, 0);
    od = __builtin_amdgcn_mfma_f32_32x32x16_bf16(pa3, PK(f.l3, f.h3), od, 0, 0, 0);
#undef PK
}
__device__ __forceinline__ void pv_all(f32x16 (&o)[4], int vb, bf16x8 pa0, bf16x8 pa1, bf16x8 pa2, bf16x8 pa3) {
    VFrag fa, fb;
    v_load<0>(fa, vb); v_load<1>(fb, vb);
    asm volatile("s_waitcnt lgkmcnt(8)" ::: "memory"); SBAR(); pv_mma(o[0], fa, pa0, pa1, pa2, pa3); SBAR();
    v_load<2>(fa, vb);
    asm volatile("s_waitcnt lgkmcnt(8)" ::: "memory"); SBAR(); pv_mma(o[1], fb, pa0, pa1, pa2, pa3); SBAR();
    v_load<3>(fb, vb);
    asm volatile("s_waitcnt lgkmcnt(8)" ::: "memory"); SBAR(); pv_mma(o[2], fa, pa0, pa1, pa2, pa3); SBAR();
    asm volatile("s_waitcnt lgkmcnt(0)" ::: "memory"); SBAR(); pv_mma(o[3], fb, pa0, pa1, pa2, pa3);
}

struct AttnP {
    unsigned char* ws; const int* positions; const float* subln_g; float lam, out_scale;
    __device__ __forceinline__ const bf16_t* proj() const { return (const bf16_t*)(ws + WS_PROJ); }
    __device__ __forceinline__ const bf16_t* qm() const { return (const bf16_t*)(ws + WS_QM); }
    __device__ __forceinline__ const bf16_t* knv() const { return (const bf16_t*)(ws + WS_KNV); }
    __device__ __forceinline__ const bf16_t* krot() const { return (const bf16_t*)(ws + WS_KROT); }
    __device__ __forceinline__ const float* ckS() const { return (const float*)(ws + MS_CKS); }
    __device__ __forceinline__ bf16_t* obuf() const { return (bf16_t*)(ws + WS_OBUF); }
};

template <int MODE>
__device__ __forceinline__ void attn_unit(const AttnP& P, int b, int h, int x, LAS char* lds) {
    constexpr int DK = Cfg<MODE>::DK, NQ = Cfg<MODE>::NQ, RS = DK * 2, SHM_K = 64 * RS;
    constexpr bool HAS_N = (MODE != 0);
    constexpr int RCOL = (MODE == 2) ? 128 : 0;
    constexpr bool HAS_R = (MODE != 1);
    constexpr bool HAS_AUX = (MODE != 2);
    int tid = threadIdx.x; asm volatile("" : "+v"(tid));
    const int wid = __builtin_amdgcn_readfirstlane(tid >> 6), lane = tid & 63, r32 = lane & 31, hi = lane >> 5;
    const size_t tok0 = (size_t)b * SEQ;
    const int q0w = x * 256 + wid * 32;
    const int NT = 4 * x + 4, jmax = 4 * x + (wid >> 1);
    LAS float* ws = (LAS float*)(lds + OFF_WS) + wid * 64; LAS float* li_l = ws; LAS float* al_l = ws + 32;
    const int sr = tid >> 4, sc = (tid & 15) * 8, vst0 = v_st(sr, sc), vst1 = v_st(32 + sr, sc);
    const int vb0 = (int)(uintptr_t)(lds + OFF_V) + v_rd_base(lane);
    const int rrow = tid >> 3, rcol = (tid & 7) * 8;
#define KSWZ(row, colB) ((row) * RS + ((colB) ^ (((row) & 7) << 4)))
    const int kstN0 = KSWZ(sr, sc * 2), kstN1 = KSWZ(32 + sr, sc * 2), kstR = KSWZ(rrow, (RCOL + rcol) * 2);
    int kb[4];
#pragma unroll
    for (int c = 0; c < 4; ++c) kb[c] = KSWZ(r32, c * 32 + hi * 16);
    constexpr int ldN = (MODE == 2) ? 2048 : LDP, ldR = (MODE == 2) ? 64 : LDP, ldV = (MODE == 2) ? 2048 : LDP, ldQ = (MODE == 2) ? 1536 : LDP;
    const bf16_t *srcN = nullptr, *srcR = nullptr, *srcV = nullptr, *srcQ = nullptr;
    if (MODE == 0) { srcR = P.proj() + tok0 * LDP + PC_AK + h * 128; srcV = P.proj() + tok0 * LDP + PC_AV + h * 128; srcQ = P.proj() + tok0 * LDP + PC_AQ + h * 128; }
    if (MODE == 1) { srcN = P.proj() + tok0 * LDP + PC_BK + h * 128; srcV = P.proj() + tok0 * LDP + PC_BV + h * 128; srcQ = P.proj() + tok0 * LDP + PC_BQ + h * 128; }
    if (MODE == 2) { srcN = P.knv() + tok0 * 2048 + h * 128; srcR = P.krot() + tok0 * 64; srcV = P.knv() + tok0 * 2048 + 1024 + h * 128; srcQ = P.qm() + tok0 * 1536 + h * 192; }
    float qaux = 0.f, slope2 = 0.f, xref = 0.f;
    if (MODE == 0) { qaux = (float)P.positions[tok0 + q0w + r32]; slope2 = exp2f(-(float)(h + 1)) * L2E; xref = (float)P.positions[tok0 + x * 256]; }
    if (MODE == 1) xref = P.ckS()[((size_t)b * 8 + h) * SEQ + x * 256];
    bf16x8 qx = bf16x8{}; if (hi == 0) { qx[0] = (short)0x3F80; qx[1] = (short)0x3F80; }
    f32x16 o[4]; float m_reg, l_reg; bf16x8 qr[NQ];
    constexpr int NMAP = (MODE == 0) ? 2 : 1;
    for (int mp = 0; mp < NMAP; ++mp) {
#pragma unroll
        for (int d = 0; d < 4; ++d) o[d] = f32x16{};
        m_reg = 0.f; l_reg = 0.f;
        { const bf16_t* Qw = srcQ + (size_t)(q0w + r32) * ldQ + mp * 64 + hi * 8;
#pragma unroll
          for (int d0 = 0; d0 < NQ; ++d0) qr[d0] = *(const bf16x8*)(Qw + d0 * 16); }
        const char* gN = (const char*)srcN; const char* gR = (const char*)(srcR + mp * 64); const char* gV = (const char*)srcV;
        const unsigned oN = (unsigned)(sr * ldN + sc) * 2u, oR = (unsigned)(rrow * ldR + rcol) * 2u, oV = (unsigned)(sr * ldV + sc) * 2u;
        bf16x8 sN0, sN1, sR, sV0, sV1; float sAux = 0.f; int tload = 0;
#define SLOAD() do { if (HAS_N) { sN0 = *(const bf16x8*)(gN + oN); sN1 = *(const bf16x8*)(gN + (size_t)32 * ldN * 2 + oN); gN += (size_t)64 * ldN * 2; } \
        if (HAS_R) { sR = *(const bf16x8*)(gR + oR); gR += (size_t)64 * ldR * 2; } \
        sV0 = *(const bf16x8*)(gV + oV); sV1 = *(const bf16x8*)(gV + (size_t)32 * ldV * 2 + oV); gV += (size_t)64 * ldV * 2; \
        if (HAS_AUX && tid < 64) { if (MODE == 0) sAux = (float)P.positions[tok0 + tload * 64 + tid]; else sAux = P.ckS()[((size_t)b * 8 + h) * SEQ + tload * 64 + tid]; } \
        ++tload; } while (0)
#define SWRITE(bf) do { LAS char* Kb = lds + OFF_K + (bf) * SHM_K; LAS char* Vb = lds + OFF_V + (bf) * SHM_V; \
        if (HAS_N) { *(LAS bf16x8*)(Kb + kstN0) = sN0; *(LAS bf16x8*)(Kb + kstN1) = sN1; } if (HAS_R) *(LAS bf16x8*)(Kb + kstR) = sR; \
        *(LAS bf16x8*)(Vb + vst0) = sV0; *(LAS bf16x8*)(Vb + vst1) = sV1; \
        if (HAS_AUX && tid < 64) { const float val = (MODE == 0) ? slope2 * (sAux - xref) : (xref - sAux) * L2E; const unsigned vh = cvt_pk_bf16(val, 0.f) & 0xffffu; \
            const unsigned vl = cvt_pk_bf16(val - __uint_as_float(vh << 16), 0.f) & 0xffffu; LAS u32x4* kx = (LAS u32x4*)(lds + OFF_KX + (bf) * SHM_KX + tid * 32); \
            kx[0] = (u32x4){vh | (vl << 16), 0u, 0u, 0u}; kx[1] = (u32x4){0u, 0u, 0u, 0u}; \
            if (MODE == 0) ((LAS float*)(lds + OFF_KAUX))[(bf) * 64 + tid] = sAux; } } while (0)
        __syncthreads();
        SLOAD(); SWRITE(0); SLOAD();
        for (int j = 0; j < NT; ++j) {
            __syncthreads();
            const int bf = j & 1;
            if (j <= jmax) {
                const bool first = (j == 0);
                f32x16 p0, p1; { const float ini = first ? 0.f : -m_reg;
#pragma unroll
                  for (int r = 0; r < 16; ++r) { p0[r] = ini; p1[r] = ini; } }
                {
                  const LAS char* Kb = lds + OFF_K + bf * SHM_K;
                  const LAS char* kx = lds + OFF_KX + bf * SHM_KX + r32 * 32 + hi * 16;
                  constexpr int NS = NQ + (HAS_AUX ? 1 : 0);
                  bf16x8 ra[3], rb[3];
#define QLOAD(s_) do { if ((s_) < NQ) { const LAS char* kp = Kb + kb[(s_) & 3] + ((s_) >> 2) * 128; ra[(s_) % 3] = *(const LAS bf16x8*)kp; rb[(s_) % 3] = *(const LAS bf16x8*)(kp + 32 * RS); } \
                      else { ra[(s_) % 3] = *(const LAS bf16x8*)kx; rb[(s_) % 3] = *(const LAS bf16x8*)(kx + 1024); } } while (0)
                  QLOAD(0); QLOAD(1);
#pragma unroll
                  for (int st = 0; st < NS; ++st) {
                      if (st + 2 < NS) QLOAD(st + 2);
                      SBAR();
                      const bf16x8 qb = (st < NQ) ? qr[st < NQ ? st : 0] : qx;
                      p0 = __builtin_amdgcn_mfma_f32_32x32x16_bf16(ra[st % 3], qb, p0, 0, 0, 0);
                      p1 = __builtin_amdgcn_mfma_f32_32x32x16_bf16(rb[st % 3], qb, p1, 0, 0, 0);
                      SBAR(); }
#undef QLOAD
                }
                if (MODE == 0 && j == jmax) {
                    const LAS float* ka = (const LAS float*)(lds + OFF_KAUX) + bf * 64 + 4 * hi; const float s2 = 2.f * slope2;
#pragma unroll
                    for (int g = 0; g < 4; ++g) { const f32x4 a0 = *(const LAS f32x4*)(ka + 8 * g), a1 = *(const LAS f32x4*)(ka + 32 + 8 * g);
#pragma unroll
                        for (int i = 0; i < 4; ++i) { p0[4 * g + i] = fmaf(s2, fminf(qaux - a0[i], 0.f), p0[4 * g + i]); p1[4 * g + i] = fmaf(s2, fminf(qaux - a1[i], 0.f), p1[4 * g + i]); } }
                }
                if (MODE == 1 && j == jmax) {
                    const int rowt = q0w - 64 * j + r32;
#pragma unroll
                    for (int r = 0; r < 16; ++r) { const int kk = crow(r, hi); if (kk > rowt) p0[r] = -__builtin_inff(); if (kk + 32 > rowt) p1[r] = -__builtin_inff(); }
                }
                float alpha; partialSM2(p0, p1, first, m_reg, alpha);
                if (__any(alpha < 1.f)) { if (hi == 0) al_l[r32] = alpha; LDS_WAIT();
#pragma unroll
                    for (int d = 0; d < 4; ++d)
#pragma unroll
                        for (int r = 0; r < 16; ++r) o[d][r] *= al_l[crow(r, hi)]; }
                bf16x8 pa0, pa1, pa2, pa3; finishSM(p0, p1, alpha, l_reg, pa0, pa1, pa2, pa3); SBAR();
                const int vb = vb0 + bf * SHM_V;
                pv_all(o, vb, pa0, pa1, pa2, pa3);
            }
            if (j + 1 < NT) { SWRITE(bf ^ 1); if (j + 2 < NT) SLOAD(); }
        }
#undef SLOAD
#undef SWRITE
        if (hi == 0) li_l[r32] = l_reg; LDS_WAIT();
        float rli[16];
#pragma unroll
        for (int r = 0; r < 16; ++r) rli[r] = __builtin_amdgcn_rcpf(li_l[crow(r, hi)]);
        LDS_WAIT();
        bf16_t* Ob = P.obuf() + (tok0 + q0w) * 3072 + MODE * 1024 + h * 128;
        constexpr int LDO = 3072;
        int hi4 = hi * 4; asm volatile("" : "+v"(hi4));
        if (MODE == 0 && mp == 1) {
            asm volatile("s_waitcnt vmcnt(0)" ::: "memory");
            const bf16_t* O1 = Ob; bf16_t* Oc = Ob;
            float gq[4];
#pragma unroll
            for (int d = 0; d < 4; ++d) gq[d] = P.subln_g[r32 + 32 * d] * P.out_scale;
            bf16_t a1[16][4];
#pragma unroll
            for (int r = 0; r < 16; ++r) { const unsigned vo1 = (unsigned)(((r & 3) + 8 * (r >> 2) + hi4) * 3072 + r32) * 2u;
#pragma unroll
                for (int d = 0; d < 4; ++d) a1[r][d] = *(const bf16_t*)((const char*)O1 + vo1 + d * 64); }
            asm volatile("" ::: "memory");
#pragma unroll
            for (int r = 0; r < 16; ++r) { const int rowi = (r & 3) + 8 * (r >> 2) + hi4; const unsigned vo2 = (unsigned)(rowi * 3072 + r32) * 2u;
                float v[4]; float ss = 0.f;
#pragma unroll
                for (int d = 0; d < 4; ++d) { const float a = bf2f(a1[r][d]); const float bq = __uint_as_float(cvt_pk_bf16(o[d][r] * rli[r], 0.f) << 16);
                    v[d] = a - P.lam * bq; ss += v[d] * v[d]; }
                ss = row_sum16(ss); ss += __int_as_float(__builtin_amdgcn_ds_swizzle(__float_as_int(ss), 0x401F));
                const float rs = __builtin_amdgcn_rsqf(ss * (1.0f / 128.0f) + NORM_EPS);
#pragma unroll
                for (int d = 0; d < 4; ++d) *(bf16_t*)((char*)Oc + vo2 + d * 64) = (bf16_t)(cvt_pk_bf16(v[d] * rs * gq[d], 0.f) & 0xffffu); }
        } else {
#pragma unroll
        for (int r = 0; r < 16; ++r) { const unsigned voff = (unsigned)(((r & 3) + 8 * (r >> 2) + hi4) * LDO + r32) * 2u;
#pragma unroll
            for (int d = 0; d < 4; ++d) *(bf16_t*)((char*)Ob + voff + d * 64) = (bf16_t)(cvt_pk_bf16(o[d][r] * rli[r], 0.f) & 0xffffu); }
        }
    }
#undef KSWZ
}
#undef SBAR
}

__device__ __forceinline__ int wsrc_in(int n) {
    if (n < 6144) return n;
    if (n < 7168) return 6152 + (n - 6144);
    if (n < 13312) return 7240 + (n - 7168);
    if (n < 13376) { const int j = n - 13312; return 7176 + (j & 1) * 32 + (j >> 1); }
    if (n < 13384) return 6144 + (n - 13376);
    return -1;
}
__device__ __forceinline__ int wsrc_uq(int n) { const int h = n / 192, d = n % 192; if (d < 128) return n; const int j = d - 128; return h * 192 + 128 + (j & 1) * 32 + (j >> 1); }
template <int KIND>
__device__ __forceinline__ void wconv_job(const float* W, const float* W2, int ldw, int K, int ndst, int nz, size_t wzs, size_t bzs, bf16_t* Bt, const float* ks, int kzs, LAS float* scr, int vcu, int G, int tid, int r0 = 0, int r1 = 0x7fffff) {
    const int lane = tid & 63, wave = __builtin_amdgcn_readfirstlane(tid >> 6);
    const int nkb = K / 64, nnb = ndst / 64, per = nkb * nnb, stride = G * 8, ntile_all = per * nz, ntile = (r1 < 0x7fffff && (long)r1 * stride < ntile_all) ? r1 * stride : ntile_all;
    LAS char* img = (LAS char*)scr + wave * 9216;
    float v[64]; int src = 0; float cs = 1.0f;
#define WC_LOAD(t_) do { const int z_ = (t_) / per, r_ = (t_) % per, kb_ = r_ / nnb, nb_ = r_ % nnb, nd_ = nb_ * 64 + lane; \
        const float* Wp_ = W + (size_t)z_ * wzs; src = nd_; \
        if (KIND == 1) { src = wsrc_in(nd_); cs = (nd_ < 1024) ? att::Cfg<0>::SCALE * att::L2E : ((nd_ >= PC_BQ && nd_ < PC_BK) ? att::Cfg<1>::SCALE * att::L2E : 1.0f); }     \
        if (KIND == 2) src = wsrc_uq(nd_); \
        if (KIND == 3) { Wp_ = (((nb_ >> 1) & 1) ? W2 : W) + (size_t)z_ * wzs; src = (nb_ >> 2) * 128 + (nb_ & 1) * 64 + lane; } \
        const float* col_ = Wp_ + (size_t)(kb_ * 64) * ldw + (src >= 0 ? src : 0); \
        _Pragma("unroll") for (int i = 0; i < 64; ++i) v[i] = __builtin_nontemporal_load(col_ + (size_t)i * ldw); } while (0)
    int t = vcu * 8 + wave + r0 * stride;
    if (t < ntile) WC_LOAD(t);
    while (t < ntile) {
        const int z = t / per, r = t % per, kb = r / nnb, nb = r % nnb, k0 = kb * 64, n0 = nb * 64;
        if (src < 0) {
#pragma unroll
            for (int i = 0; i < 64; ++i) v[i] = 0.f;
        }
        if (KIND == 1) {
#pragma unroll
            for (int i = 0; i < 64; ++i) v[i] *= cs; }
        if (ks) { const float* ksp = ks + (size_t)z * kzs + k0;
#pragma unroll
            for (int i = 0; i < 64; ++i) v[i] *= ksp[i]; }
#pragma unroll
        for (int c = 0; c < 8; ++c) { u32x4 o; o.x = cvt_pk_bf16(v[8 * c], v[8 * c + 1]); o.y = cvt_pk_bf16(v[8 * c + 2], v[8 * c + 3]); o.z = cvt_pk_bf16(v[8 * c + 4], v[8 * c + 5]); o.w = cvt_pk_bf16(v[8 * c + 6], v[8 * c + 7]);
            *(LAS u32x4*)(img + lane * 144 + c * 16) = o; }
        const int tn = t + stride;
        if (tn < ntile) WC_LOAD(tn);
        asm volatile("s_waitcnt lgkmcnt(0)" ::: "memory");
        bf16_t* dst = Bt + (size_t)z * bzs + (size_t)(n0 + (lane >> 3)) * K + k0 + (lane & 7) * 8;
#pragma unroll
        for (int i = 0; i < 8; ++i) { const u32x4 o = *(const LAS u32x4*)(img + ((lane >> 3) + 8 * i) * 144 + (lane & 7) * 16); __builtin_nontemporal_store(o, (u32x4*)(dst + (size_t)(8 * i) * K)); }
        asm volatile("s_waitcnt lgkmcnt(0)" ::: "memory");
        t = tn;
    }
#undef WC_LOAD
}
__device__ __forceinline__ void rmsnorm_rows(const float* x, const float* g, bf16_t* out, int vcu, int G, int wave, int lane) {
    f32x4 gv[8];
#pragma unroll
    for (int j = 0; j < 8; ++j) gv[j] = *((const f32x4*)g + lane + 64 * j);
    for (int m = vcu * 8 + wave; m < T; m += G * 16) {
        const int m2 = (m + G * 8 < T) ? m + G * 8 : m;
        const f32x4* xr = (const f32x4*)(x + (size_t)m * DM) + lane; const f32x4* xq = (const f32x4*)(x + (size_t)m2 * DM) + lane; f32x4 v[8], u[8]; float s = 0.f, s2 = 0.f;
#pragma unroll
        for (int j = 0; j < 8; ++j) v[j] = xr[64 * j];
#pragma unroll
        for (int j = 0; j < 8; ++j) u[j] = xq[64 * j];
#pragma unroll
        for (int j = 0; j < 8; ++j) s += (v[j][0] * v[j][0] + v[j][1] * v[j][1]) + (v[j][2] * v[j][2] + v[j][3] * v[j][3]);
#pragma unroll
        for (int j = 0; j < 8; ++j) s2 += (u[j][0] * u[j][0] + u[j][1] * u[j][1]) + (u[j][2] * u[j][2] + u[j][3] * u[j][3]);
        const float rstd = __builtin_amdgcn_rsqf(wave_sum(s) * (1.0f / DM) + NORM_EPS), rstd2 = __builtin_amdgcn_rsqf(wave_sum(s2) * (1.0f / DM) + NORM_EPS);
        u32x2* o8 = (u32x2*)(out + (size_t)m * DM) + lane; u32x2* o9 = (u32x2*)(out + (size_t)m2 * DM) + lane;
#pragma unroll
        for (int j = 0; j < 8; ++j) { const f32x4 y = v[j] * rstd * gv[j]; u32x2 w; w.x = cvt_pk_bf16(y[0], y[1]); w.y = cvt_pk_bf16(y[2], y[3]); o8[64 * j] = w; }
#pragma unroll
        for (int j = 0; j < 8; ++j) { const f32x4 y = u[j] * rstd2 * gv[j]; u32x2 w; w.x = cvt_pk_bf16(y[0], y[1]); w.y = cvt_pk_bf16(y[2], y[3]); o9[64 * j] = w; }
    }
}
__device__ __forceinline__ void prep_phase(const bf16_t* proj, const float* tail, const int* positions, const float* fbias,
                                           float* rstdq, float* rstdkv, bf16_t* krot, float* ckS, LAS float* scr, int vcu, int G, int tid, int wave, int lane) {
    const float rfreq = __builtin_amdgcn_exp2f(-(float)(lane & 31) * 0.41524101186092f) * 0.15915494309189535f;
    for (int m = vcu * 8 + wave; m < T; m += G * 32) {
        int mk[4]; u32x4 a[4], b[4]; f32x2 xv[4]; float pos[4];
#pragma unroll
        for (int k = 0; k < 4; ++k) { mk[k] = (m + k * G * 8 < T) ? m + k * G * 8 : m; }
#pragma unroll
        for (int k = 0; k < 4; ++k) { a[k] = *(const u32x4*)(proj + (size_t)mk[k] * LDP + PC_CQ + 8 * lane); b[k] = *(const u32x4*)(proj + (size_t)mk[k] * LDP + PC_CKV + 8 * lane);
            xv[k] = *((const f32x2*)(tail + (size_t)mk[k] * TAILW) + (lane & 31)); pos[k] = (float)positions[mk[k]]; }
#pragma unroll
        for (int k = 0; k < 4; ++k) {
            float sa = 0.f, sb = 0.f;
#pragma unroll
            for (int i = 0; i < 4; ++i) { const float a0 = bflo(a[k][i]), a1 = bfhi(a[k][i]), b0 = bflo(b[k][i]), b1 = bfhi(b[k][i]); sa += a0 * a0 + a1 * a1; sb += b0 * b0 + b1 * b1; }
            sa = wave_sum(sa); sb = wave_sum(sb);
            if (lane == 0) { rstdq[mk[k]] = __builtin_amdgcn_rsqf(sa * (1.0f / 512.0f) + NORM_EPS); rstdkv[mk[k]] = __builtin_amdgcn_rsqf(sb * (1.0f / 512.0f) + NORM_EPS); }
            if (lane < 32) { const float rev = pos[k] * rfreq, frc = rev - floorf(rev);
                const float cs = __builtin_amdgcn_cosf(frc), sn = __builtin_amdgcn_sinf(frc);
                ((unsigned*)(krot + (size_t)mk[k] * 64))[lane] = cvt_pk_bf16(xv[k].x * cs - xv[k].y * sn, xv[k].y * cs + xv[k].x * sn); }
        }
    }
    for (int u = vcu; u < NB * 8; u += G) {
        const int b = u >> 3, h = u & 7; const float fb = fbias[h]; float v[8]; float run = 0.f;
#pragma unroll
        for (int i = 0; i < 8; ++i) { const float f = tail[((size_t)b * SEQ + tid * 8 + i) * TAILW + 64 + h] + fb;
            const float ls = -(fmaxf(-f, 0.f) + log1pf(__expf(-fabsf(f)))); run += ls; v[i] = run; }
        __syncthreads();
        scr[tid] = run; __syncthreads();
        for (int o = 1; o < 512; o <<= 1) { float t = (tid >= o) ? scr[tid - o] : 0.f; __syncthreads(); scr[tid] += t; __syncthreads(); }
        const float excl = scr[tid] - run;
#pragma unroll
        for (int i = 0; i < 8; ++i) ckS[((size_t)b * 8 + h) * SEQ + tid * 8 + i] = excl + v[i];
        __syncthreads();
    }
}

__device__ __forceinline__ void diff_combine(const bf16_t* oscr, const float* g, float lam, float out_scale, bf16_t* obuf, int vcu, int G, int wave, int lane) {
    f32x4 g0 = *(const f32x4*)(g + (lane & 15) * 8), g1 = *(const f32x4*)(g + (lane & 15) * 8 + 4);
    for (int m = vcu * 8 + wave; m < T; m += G * 8) {
#pragma unroll
        for (int c = 0; c < 2; ++c) {
            const u32x4 a = *(const u32x4*)(oscr + (size_t)m * 2048 + c * 512 + lane * 8), b = *(const u32x4*)(oscr + (size_t)m * 2048 + 1024 + c * 512 + lane * 8);
            float v[8]; float ss = 0.f;
#pragma unroll
            for (int i = 0; i < 4; ++i) { v[2 * i] = bflo(a[i]) - lam * bflo(b[i]); v[2 * i + 1] = bfhi(a[i]) - lam * bfhi(b[i]); ss += v[2 * i] * v[2 * i] + v[2 * i + 1] * v[2 * i + 1]; }
            ss = row_sum16(ss);
            const float rs = __builtin_amdgcn_rsqf(ss * (1.0f / 128.0f) + NORM_EPS) * out_scale;
            u32x4 w; w.x = cvt_pk_bf16(v[0] * rs * g0[0], v[1] * rs * g0[1]); w.y = cvt_pk_bf16(v[2] * rs * g0[2], v[3] * rs * g0[3]);
            w.z = cvt_pk_bf16(v[4] * rs * g1[0], v[5] * rs * g1[1]); w.w = cvt_pk_bf16(v[6] * rs * g1[2], v[7] * rs * g1[3]);
            *(u32x4*)(obuf + (size_t)m * 3072 + c * 512 + lane * 8) = w;
        }
    }
}

#define LADD(p, v) (void)__hip_atomic_fetch_add((p), (v), __ATOMIC_RELAXED, __HIP_MEMORY_SCOPE_WORKGROUP)
__device__ __forceinline__ void moe_route(const float* x, const float* g, const float* router_w, int* route, float* rstd2, unsigned* cnt, LAS unsigned char* lds, int vcu, int G, int tid, int wave, int lane) {
    LAS float* Wt = (LAS float*)lds; LAS unsigned* elist = (LAS unsigned*)(lds + 65536);
    for (int idx = tid; idx < DM * 8; idx += 512) Wt[(idx & 7) * DM + (idx >> 3)] = router_w[idx];
    __syncthreads();
    int Gd = G; asm volatile("" : "+s"(Gd));
    const int TPW = (T + Gd - 1) / Gd, t0 = vcu * TPW, t1 = (t0 + TPW < T) ? t0 + TPW : T;
    f32x4 gv[8];
#pragma unroll
    for (int j = 0; j < 8; ++j) gv[j] = *((const f32x4*)g + lane + 64 * j);
    for (int m = t0 + wave; m < t1; m += 16) {
        const int mq = (m + 8 < t1) ? m + 8 : m;
        const f32x4* xr = (const f32x4*)(x + (size_t)m * DM) + lane; const f32x4* xq = (const f32x4*)(x + (size_t)mq * DM) + lane; f32x4 v[8], u[8]; float s = 0.f, sq = 0.f;
#pragma unroll
        for (int j = 0; j < 8; ++j) v[j] = xr[64 * j];
#pragma unroll
        for (int j = 0; j < 8; ++j) u[j] = xq[64 * j];
#pragma unroll
        for (int j = 0; j < 8; ++j) s += (v[j][0] * v[j][0] + v[j][1] * v[j][1]) + (v[j][2] * v[j][2] + v[j][3] * v[j][3]);
#pragma unroll
        for (int j = 0; j < 8; ++j) sq += (u[j][0] * u[j][0] + u[j][1] * u[j][1]) + (u[j][2] * u[j][2] + u[j][3] * u[j][3]);
        const float rstd = __builtin_amdgcn_rsqf(wave_sum(s) * (1.0f / DM) + NORM_EPS), rstdq = __builtin_amdgcn_rsqf(wave_sum(sq) * (1.0f / DM) + NORM_EPS);
#pragma unroll
        for (int j = 0; j < 8; ++j) { v[j] = v[j] * rstd * gv[j]; u[j] = u[j] * rstdq * gv[j]; }
        float lg[8], lq[8];
#pragma unroll
        for (int e = 0; e < 8; ++e) { float a = 0.f, b = 0.f;
#pragma unroll
            for (int j = 0; j < 8; ++j) { const f32x4 w = *((const LAS f32x4*)(Wt + e * DM) + lane + 64 * j); a += (v[j][0] * w[0] + v[j][1] * w[1]) + (v[j][2] * w[2] + v[j][3] * w[3]);
                b += (u[j][0] * w[0] + u[j][1] * w[1]) + (u[j][2] * w[2] + u[j][3] * w[3]); }
            lg[e] = wave_sum(a); lq[e] = wave_sum(b); }
#define ROUTE_PICK(lg_, m_, rstd_) do { int e0 = 0; float v0 = lg_[0]; \
        _Pragma("unroll") for (int e = 1; e < 8; ++e) if (lg_[e] > v0) { v0 = lg_[e]; e0 = e; } \
        int e1 = -1; float v1 = -__builtin_inff(); \
        _Pragma("unroll") for (int e = 0; e < 8; ++e) if (e != e0 && lg_[e] > v1) { v1 = lg_[e]; e1 = e; } \
        const float ex = __expf(v1 - v0), w0 = 1.0f / (1.0f + ex), w1 = ex * w0; \
        if (lane == 0) { i32x4 r; r.x = e0; r.y = e1; r.z = __float_as_int(w0); r.w = __float_as_int(w1); *((i32x4*)route + (m_)) = r; rstd2[m_] = rstd_; elist[(m_) - t0] = (unsigned)e0 | ((unsigned)e1 << 8); } } while (0)
        ROUTE_PICK(lg, m, rstd); ROUTE_PICK(lq, mq, rstdq);
#undef ROUTE_PICK
    }
    __syncthreads();
    if (tid < 8) { unsigned c = 0; for (int i = 0; i < t1 - t0; ++i) { const unsigned w = elist[i]; c += ((w & 255u) == (unsigned)tid) + ((w >> 8) == (unsigned)tid); } cnt[vcu * 8 + tid] = c; }
    __syncthreads();
}
__device__ __forceinline__ void moe_gather(const float* x, const float* g, const int* route, const float* rstd2, const unsigned* cnt, int* slots, int* moe_off, bf16_t* hs,
                                           LAS unsigned char* lds, int vcu, int G, int tid, int wave, int lane) {
    LAS unsigned* tot = (LAS unsigned*)lds; LAS unsigned* base = tot + 8; LAS int* offp = (LAS int*)(tot + 16); LAS unsigned* elist = tot + 32; LAS int* slotl = (LAS int*)(tot + 32 + 1024);
    if (tid < 16) tot[tid] = 0u;
    __syncthreads();
    for (int w = tid; w < G; w += 512) { const u32x4 c0 = *((const u32x4*)cnt + 2 * w), c1 = *((const u32x4*)cnt + 2 * w + 1);
#pragma unroll
        for (int e = 0; e < 4; ++e) { LADD(&tot[e], c0[e]); LADD(&tot[4 + e], c1[e]); if (w < vcu) { LADD(&base[e], c0[e]); LADD(&base[4 + e], c1[e]); } } }
    __syncthreads();
    if (tid == 0) { int o = 0; for (int e = 0; e < 8; ++e) { offp[e] = o; o += (int)((tot[e] + 255u) & ~255u); } offp[8] = o; }
    __syncthreads();
    if (vcu == 0 && tid < 9) moe_off[tid] = offp[tid];
    int Gd = G; asm volatile("" : "+s"(Gd));
    const int TPW = (T + Gd - 1) / Gd, t0 = vcu * TPW, t1 = (t0 + TPW < T) ? t0 + TPW : T, nt = t1 - t0;
    for (int i = tid; i < nt; i += 512) { const i32x4 r = *((const i32x4*)route + t0 + i); elist[i] = (unsigned)r.x | ((unsigned)r.y << 8); }
    __syncthreads();
    for (int i = tid; i < nt; i += 512) { const unsigned w = elist[i], e0 = w & 255u, e1 = w >> 8; int r0 = 0, r1 = 0;
        for (int k = 0; k < i; ++k) { const unsigned q = elist[k], a = q & 255u, b = q >> 8; r0 += (a == e0) + (b == e0); r1 += (a == e1) + (b == e1); }
        const int s0 = offp[e0] + (int)base[e0] + r0, s1 = offp[e1] + (int)base[e1] + r1;
        slotl[2 * i] = s0; slotl[2 * i + 1] = s1; slots[2 * (t0 + i)] = s0; slots[2 * (t0 + i) + 1] = s1; }
    __syncthreads();
    f32x4 gv[8];
#pragma unroll
    for (int j = 0; j < 8; ++j) gv[j] = *((const f32x4*)g + lane + 64 * j);
    for (int m = t0 + wave; m < t1; m += 16) {
        const int mq = (m + 8 < t1) ? m + 8 : m;
        const f32x4* xr = (const f32x4*)(x + (size_t)m * DM) + lane; const f32x4* xq = (const f32x4*)(x + (size_t)mq * DM) + lane; f32x4 v[8], u[8];
#pragma unroll
        for (int j = 0; j < 8; ++j) v[j] = xr[64 * j];
#pragma unroll
        for (int j = 0; j < 8; ++j) u[j] = xq[64 * j];
        const float rstd = rstd2[m], rstdq = rstd2[mq]; const int s0 = slotl[2 * (m - t0)], s1 = slotl[2 * (m - t0) + 1], q0 = slotl[2 * (mq - t0)], q1 = slotl[2 * (mq - t0) + 1];
        u32x2* o0 = (u32x2*)(hs + (size_t)s0 * DM) + lane; u32x2* o1 = (u32x2*)(hs + (size_t)s1 * DM) + lane; u32x2* p0 = (u32x2*)(hs + (size_t)q0 * DM) + lane; u32x2* p1 = (u32x2*)(hs + (size_t)q1 * DM) + lane;
#pragma unroll
        for (int j = 0; j < 8; ++j) { const f32x4 y = v[j] * rstd * gv[j]; u32x2 w; w.x = cvt_pk_bf16(y[0], y[1]); w.y = cvt_pk_bf16(y[2], y[3]); o0[64 * j] = w; o1[64 * j] = w; }
#pragma unroll
        for (int j = 0; j < 8; ++j) { const f32x4 y = u[j] * rstdq * gv[j]; u32x2 w; w.x = cvt_pk_bf16(y[0], y[1]); w.y = cvt_pk_bf16(y[2], y[3]); p0[64 * j] = w; p1[64 * j] = w; }
    }
    { const int gw = vcu * 8 + wave, nw = G * 8;
#pragma unroll 1
      for (int e = 0; e < 8; ++e) { const int first = offp[e] + (int)tot[e], npad = offp[e + 1] - first;
          for (int k = gw; k < npad; k += nw) { u32x4* o = (u32x4*)(hs + (size_t)(first + k) * DM) + lane;
#pragma unroll
              for (int j = 0; j < 4; ++j) o[64 * j] = (u32x4){0u, 0u, 0u, 0u}; } } }
    __syncthreads();
}
__device__ __forceinline__ void final_phase(const float* x, const bf16_t* ys, const int* route, const int* slots, const float* g, float* out, const LAS int* late, bool want_late, int vcu, int G, int wave, int lane) {
    f32x4 gv[8];
#pragma unroll
    for (int j = 0; j < 8; ++j) gv[j] = *((const f32x4*)g + lane + 64 * j);
    for (int m = vcu * 8 + wave; m < T; m += G * 8) {
        const int s0 = __builtin_amdgcn_readfirstlane(slots[2 * m]), s1 = __builtin_amdgcn_readfirstlane(slots[2 * m + 1]);
        if (((late[s0 >> 8] | late[s1 >> 8]) != 0) != want_late) continue;
        const i32x4 r = *((const i32x4*)route + m); const float w0 = __int_as_float(r.z), w1 = __int_as_float(r.w);
        const f32x4* xr = (const f32x4*)(x + (size_t)m * DM) + lane; const u32x2* y0 = (const u32x2*)(ys + (size_t)s0 * DM) + lane; const u32x2* y1 = (const u32x2*)(ys + (size_t)s1 * DM) + lane;
        f32x4 v[8]; float s = 0.f;
#pragma unroll
        for (int j = 0; j < 8; ++j) { const u32x2 a = y0[64 * j], b = y1[64 * j]; f32x4 t = xr[64 * j];
            t[0] += w0 * bflo(a.x) + w1 * bflo(b.x); t[1] += w0 * bfhi(a.x) + w1 * bfhi(b.x); t[2] += w0 * bflo(a.y) + w1 * bflo(b.y); t[3] += w0 * bfhi(a.y) + w1 * bfhi(b.y);
            v[j] = t; s += (t[0] * t[0] + t[1] * t[1]) + (t[2] * t[2] + t[3] * t[3]); }
        const float rstd = __builtin_amdgcn_rsqf(wave_sum(s) * (1.0f / DM) + NORM_EPS);
        f32x4* o = (f32x4*)(out + (size_t)m * DM) + lane;
#pragma unroll
        for (int j = 0; j < 8; ++j) o[64 * j] = v[j] * rstd * gv[j];
    }
}

constexpr int NWAVES = 8, PH_PER_LAYER = 13, NPH = 1 + 2 * PH_PER_LAYER;
struct Args {
    const float* x; const int* positions; const float* attn_norm_g; const float* w_in; const float* diff_lambda; const float* diff_subln_g; const float* fox_bias;
    const float* q_norm_g; const float* kv_norm_g; const float* w_uq; const float* w_uk; const float* w_uv; const float* w_branch; const float* w_out; const float* ffn_norm_g;
    const float* dense_w1; const float* dense_w3; const float* dense_w2; const float* router_w; const float* expert_w1; const float* expert_w3; const float* expert_w2; const float* final_norm_g;
    float* out; unsigned char* ws; int ph_lo, ph_hi, li, pad;
};
__host__ __device__ constexpr bool phase_exists(int k) {
    if (k == 0) return true;
    const int l = (k - 1) / PH_PER_LAYER, p = (k - 1) % PH_PER_LAYER;
    if (l == 0) return p >= 1 && p <= 10;
    return true;
}

typedef const __attribute__((address_space(4))) Args* KArgs;
__device__ __forceinline__ KArgs kargs() { KArgs p = (KArgs)__builtin_amdgcn_kernarg_segment_ptr(); asm volatile("" : "+s"(p)); return p; }

__global__ void __launch_bounds__(NWAVES * 64, 2) mega_fwd(Args a) {
    extern __shared__ __attribute__((aligned(16))) unsigned char lds_raw[];
    LAS unsigned char* lds = (LAS unsigned char*)lds_raw;
    const int G = gridDim.x, bx = blockIdx.x, vcu = (G % 8 == 0) ? (bx % 8) * (G / 8) + bx / 8 : bx;
    volatile LAS unsigned* MISC = (volatile LAS unsigned*)(lds + MISC_OFF);
    for (int u = threadIdx.x; u < (LDS_BYTES - LDSCTL_OFF) / 4; u += NWAVES * 64) ((LAS unsigned*)(lds + LDSCTL_OFF))[u] = 0u;
    __syncthreads();
    XcdBarrier bar = xcd_barrier_post((unsigned*)(a.ws + WS_CTL) + CW_BAR + a.li * XCD_BAR_WORDS, MISC + 8);
    const int lo = a.ph_lo, hi = a.ph_hi;
#ifndef ATT_MODES
#define ATT_MODES 7
#endif
#ifndef PH_ENABLE
#define PH_ENABLE 0xFFFFFFFFu
#endif
#define IN(k) (lo <= (k) && (k) < hi)
#define EN(kind) (((PH_ENABLE) >> (kind)) & 1u)
#ifndef PROBE_REP_MASK
#define PROBE_REP_MASK 0u
#endif
#define REPS(kind) for (int rep_ = 0; rep_ < ((((PROBE_REP_MASK) >> (kind)) & 1u) ? PROBE_REP_N : 1); ++rep_)
#ifndef PROBE_REP_N
#define PROBE_REP_N 2
#endif
#ifndef PROBE_BAR2
#define PROBE_BAR2 0
#endif
#define SEAM(k) do { if (IN(k) && (k) + 1 < hi) { xcd_barrier(bar); if (PROBE_BAR2) xcd_barrier(bar); } } while (0)
#define PHASE_LOCALS KArgs A = kargs(); unsigned char* ws = A->ws; int tid = threadIdx.x; asm volatile("" : "+v"(tid)); const int lane = tid & 63, wave = __builtin_amdgcn_readfirstlane(tid >> 6); (void)lane; (void)wave; (void)ws
#define WSP(T_, off) ((T_*)(ws + (off)))

    if (EN(0) && IN(0)) REPS(0) {
        PHASE_LOCALS; LAS float* scr = (LAS float*)lds;
        wconv_job<1>(A->w_in, nullptr, N_IN_SRC, DM, NIN, 1, (size_t)DM * N_IN_SRC, (size_t)NIN * DM, WSP(bf16_t, WS_WIN), nullptr, 0, scr, vcu, G, tid);
        wconv_job<2>(A->w_uq, nullptr, 1536, 512, 1536, 2, (size_t)512 * 1536, (size_t)1536 * 512, WSP(bf16_t, WS_WUQ), A->q_norm_g, 512, scr, vcu, G, tid);
        wconv_job<0>(A->w_uk, nullptr, 1024, 512, 1024, 2, (size_t)512 * 1024, (size_t)2048 * 512, WSP(bf16_t, WS_WUKV), A->kv_norm_g, 512, scr, vcu, G, tid);
        wconv_job<0>(A->w_uv, nullptr, 1024, 512, 1024, 2, (size_t)512 * 1024, (size_t)2048 * 512, WSP(bf16_t, WS_WUKV) + (size_t)1024 * 512, A->kv_norm_g, 512, scr, vcu, G, tid);
        rmsnorm_rows(A->x, A->attn_norm_g, WSP(bf16_t, WS_H), vcu, G, wave, lane);
    }
    SEAM(0);

    for (int l = 0; l < DEPTH; ++l) {
        const int pb = 1 + l * PH_PER_LAYER;
        if (hi <= pb || lo >= pb + PH_PER_LAYER) continue;

        if (l > 0) { if (EN(1) && IN(pb + 0)) REPS(1) { PHASE_LOCALS; rmsnorm_rows(A->out, A->attn_norm_g + l * DM, WSP(bf16_t, WS_H), vcu, G, wave, lane); } SEAM(pb + 0); }

        if (EN(2) && IN(pb + 1)) REPS(2) {
            PHASE_LOCALS;
            pg8::Gemm g{WSP(bf16_t, WS_H), DM, 0, WSP(bf16_t, WS_WIN + (size_t)l * SZ_WIN), DM, 0}; pg8::StaticOrder S; S.init(T / 256, NIN / 256, G, bx);
            pg8::EpiProj E{WSP(bf16_t, WS_PROJ), WSP(float, WS_TAIL)};
            pg8::gemm_phase(lds, g, S, E);
        }
        SEAM(pb + 1);

        if (EN(3) && IN(pb + 2)) REPS(3) { PHASE_LOCALS;
            prep_phase(WSP(bf16_t, WS_PROJ), WSP(float, WS_TAIL), A->positions, A->fox_bias + l * 8, WSP(float, MS_RSTDQ), WSP(float, MS_RSTDKV), WSP(bf16_t, WS_KROT), WSP(float, MS_CKS),
                       (LAS float*)lds, vcu, G, tid, wave, lane); }
        SEAM(pb + 2);

        if (EN(4) && IN(pb + 3)) REPS(4) {
            { PHASE_LOCALS;
              pg8::Gemm g{WSP(bf16_t, WS_PROJ) + PC_CQ, LDP, 0, WSP(bf16_t, WS_WUQ + (size_t)l * SZ_WUQ), 512, 0}; pg8::StaticOrder S; S.init(T / 256, 1536 / 256, G, bx);
              pg8::EpiQ E{WSP(bf16_t, WS_QM), WSP(float, MS_RSTDQ), A->positions, att::Cfg<2>::SCALE * att::L2E};
              pg8::gemm_phase(lds, g, S, E); }
            { PHASE_LOCALS;
              pg8::Gemm g{WSP(bf16_t, WS_PROJ) + PC_CKV, LDP, 0, WSP(bf16_t, WS_WUKV + (size_t)l * SZ_WUKV), 512, 0}; pg8::StaticOrder S; S.init(T / 256, 2048 / 256, G, bx);
              pg8::EpiBf16 E{WSP(bf16_t, WS_KNV), 2048, WSP(float, MS_RSTDKV)};
              pg8::gemm_phase(lds, g, S, E); }
        }
        SEAM(pb + 3);

        const float lam_init = (l == 0) ? 0.2f : 0.35550906759f;
        if (EN(5) && IN(pb + 4)) REPS(5) {
            PHASE_LOCALS;
            const float* dl = A->diff_lambda + l * 256; const float p = dl[lane] * dl[64 + lane], q = dl[128 + lane] * dl[192 + lane];
            const float lam = __expf(wave_sum(p)) - __expf(wave_sum(q)) + lam_init;
            att::AttnP P{ws, A->positions, A->diff_subln_g + l * 128, lam, 1.0f - lam_init};
            int cslot = 0;
#define CJ(KIND_, W_, W2_, ldw_, K_, nd_, nz_, wzs_, bzs_, Bt_, pre_, rp_) do { const int a_ = g0_ - (pre_), b_ = a_ + rs0; \
                wconv_job<KIND_>(W_, W2_, ldw_, K_, nd_, nz_, wzs_, bzs_, Bt_, nullptr, 0, (LAS float*)lds, vcu, G, tid, a_ < 0 ? 0 : a_, b_ < (rp_) ? b_ : (rp_)); } while (0)
#define CONV_CONSTS int Gq_ = G; asm volatile("" : "+s"(Gq_)); const int nslots = 6 * ((512 - vcu + Gq_ - 1) / Gq_); const int rp2 = ((DFFE / 64) * (DM / 64) * NEXP + Gq_ * 8 - 1) / (Gq_ * 8), rp13 = ((DM / 64) * (2 * DFFE / 64) * EARLY_EXP + Gq_ * 8 - 1) / (Gq_ * 8); const int rs2 = (rp2 + nslots - 1) / nslots, rs13 = (rp13 + nslots - 1) / nslots; const int W8 = Gq_ * 8, rpA = ((DM / 64) * (NIN / 64) + W8 - 1) / W8, rpB = ((DM / 64) * (2 * DFF / 64) + W8 - 1) / W8, rpC = (6 * (1024 / 64) * (DM / 64) + W8 - 1) / W8, rpD = ((DFF / 64) * (DM / 64) + W8 - 1) / W8, rpE = (2 * (DM / 64) * (DM / 64) + W8 - 1) / W8;
#define CONV_SLOT() do { CONV_CONSTS if (l == 1) { __syncthreads(); const int q0_ = cslot * rs2, q1_ = q0_ + rs2, e0_ = cslot * rs13, e1_ = e0_ + rs13; ++cslot; \
                wconv_job<0>(A->expert_w2, nullptr, DM, DFFE, DM, NEXP, (size_t)DFFE * DM, (size_t)DM * DFFE, WSP(bf16_t, WS_EW2), nullptr, 0, (LAS float*)lds, vcu, G, tid, q0_, q1_); \
                wconv_job<3>(A->expert_w1, A->expert_w3, DFFE, DM, 2 * DFFE, EARLY_EXP, (size_t)DM * DFFE, (size_t)2 * DFFE * DM, WSP(bf16_t, WS_EW13), nullptr, 0, (LAS float*)lds, vcu, G, tid, e0_, e1_); } } while (0)
#define CONV_SLOT0() do { CONV_CONSTS if (l == 0) { __syncthreads(); const int rs0 = (rpA + rpB + rpC + rpD + rpE + nslots / 3 - 1) / (nslots / 3), g0_ = cslot * rs0; \
                CJ(1, A->w_in + (size_t)DM * N_IN_SRC, nullptr, N_IN_SRC, DM, NIN, 1, 0, 0, WSP(bf16_t, WS_WIN) + (size_t)NIN * DM, 0, rpA); \
                CJ(3, A->dense_w1, A->dense_w3, DFF, DM, 2 * DFF, 1, 0, 0, WSP(bf16_t, WS_WD13), rpA, rpB); \
                CJ(0, A->w_branch, nullptr, DM, 1024, DM, 6, (size_t)1024 * DM, (size_t)DM * 1024, WSP(bf16_t, WS_WBR), rpA + rpB, rpC); \
                CJ(0, A->dense_w2, nullptr, DM, DFF, DM, 1, 0, 0, WSP(bf16_t, WS_WD2), rpA + rpB + rpC, rpD); \
                CJ(0, A->w_out, nullptr, DM, DM, DM, 2, (size_t)DM * DM, (size_t)DM * DM, WSP(bf16_t, WS_WOUT), rpA + rpB + rpC + rpD, rpE); ++cslot; } } while (0)
            if (ATT_MODES & 1) for (int u = vcu; u < 512; u += G) for (int hf = 0; hf < 2; ++hf) { att::attn_unit<0>(P, u >> 6, (u >> 3) & 7, hf ? 15 - (u & 7) : (u & 7), (LAS char*)lds); CONV_SLOT0(); CONV_SLOT(); }
            if (ATT_MODES & 2) for (int u = vcu; u < 512; u += G) for (int hf = 0; hf < 2; ++hf) { att::attn_unit<1>(P, u >> 6, (u >> 3) & 7, hf ? 15 - (u & 7) : (u & 7), (LAS char*)lds); CONV_SLOT(); }
            if (ATT_MODES & 4) for (int u = vcu; u < 512; u += G) for (int hf = 0; hf < 2; ++hf) { att::attn_unit<2>(P, u >> 6, (u >> 3) & 7, hf ? 15 - (u & 7) : (u & 7), (LAS char*)lds); CONV_SLOT(); }
#undef CONV_SLOT
#undef CONV_SLOT0
#undef CJ
#undef CONV_CONSTS
            __syncthreads();
        }
        SEAM(pb + 4);


        if (EN(6) && IN(pb + 6)) REPS(6) {
            PHASE_LOCALS;
            pg8::Gemm g{WSP(bf16_t, WS_OBUF), 3072, 1024, WSP(bf16_t, WS_WBR + (size_t)l * SZ_WBR), 1024, (size_t)DM * 1024}; pg8::Z3Order S; S.init(T / 256, DM / 256, G, bx);
            pg8::EpiBranch E{WSP(bf16_t, WS_MERGED), WSP(bf16_t, WS_PROJ)};
            pg8::gemm_phase(lds, g, S, E);
        }
        SEAM(pb + 6);

        if (EN(7) && IN(pb + 7)) REPS(7) {
            PHASE_LOCALS;
            pg8::Gemm g{WSP(bf16_t, WS_MERGED), DM, 0, WSP(bf16_t, WS_WOUT + (size_t)l * SZ_WOUT), DM, 0}; pg8::StaticOrder S; S.init(T / 256, DM / 256, G, bx);
            pg8::EpiResid E{(l == 0) ? A->x : (const float*)A->out, (((PROBE_REP_MASK >> 7) & 1u) && rep_ == 0) ? WSP(float, WS_QM) : A->out};
            pg8::gemm_phase(lds, g, S, E);
        }
        SEAM(pb + 7);

        if (l == 0) {
            if (EN(8) && IN(pb + 8)) REPS(8) { PHASE_LOCALS; rmsnorm_rows(A->out, A->ffn_norm_g, WSP(bf16_t, WS_H), vcu, G, wave, lane); }
            SEAM(pb + 8);
            if (EN(9) && IN(pb + 9)) REPS(9) {
                PHASE_LOCALS;
                pg8::Gemm g{WSP(bf16_t, WS_H), DM, 0, WSP(bf16_t, WS_WD13), DM, 0}; pg8::StaticOrder S; S.init(T / 256, 2 * DFF / 256, G, bx);
                pg8::EpiSwiglu E{WSP(bf16_t, WS_UD), DFF};
                pg8::gemm_phase(lds, g, S, E);
            }
            SEAM(pb + 9);
            if (EN(10) && IN(pb + 10)) REPS(10) {
                PHASE_LOCALS;
                pg8::Gemm g{WSP(bf16_t, WS_UD), DFF, 0, WSP(bf16_t, WS_WD2), DFF, 0}; pg8::StaticOrder S; S.init(T / 256, DM / 256, G, bx);
                pg8::EpiResid E{A->out, (((PROBE_REP_MASK >> 10) & 1u) && rep_ == 0) ? WSP(float, WS_QM) : A->out};
                pg8::gemm_phase(lds, g, S, E);
            }
            SEAM(pb + 10);
        } else {
            if (EN(11) && IN(pb + 8)) REPS(11) {
                PHASE_LOCALS; LAS float* scr = (LAS float*)lds;
                wconv_job<3>(A->expert_w1 + (size_t)EARLY_EXP * DM * DFFE, A->expert_w3 + (size_t)EARLY_EXP * DM * DFFE, DFFE, DM, 2 * DFFE, NEXP - EARLY_EXP, (size_t)DM * DFFE, (size_t)2 * DFFE * DM,
                             WSP(bf16_t, WS_EW13) + (size_t)EARLY_EXP * 2 * DFFE * DM, nullptr, 0, scr, vcu, G, tid);
                __syncthreads();
                moe_route(A->out, A->ffn_norm_g + DM, A->router_w, WSP(int, MS_ROUTE), WSP(float, MS_RSTD2), WSP(unsigned, MS_CNT), lds, vcu, G, tid, wave, lane);
            }
            SEAM(pb + 8);
            if (EN(12) && IN(pb + 9)) REPS(12) { PHASE_LOCALS;
                moe_gather(A->out, A->ffn_norm_g + DM, WSP(int, MS_ROUTE), WSP(float, MS_RSTD2), WSP(unsigned, MS_CNT), WSP(int, MS_SLOTS), WSP(int, MS_MOEOFF), WSP(bf16_t, WS_HS), lds, vcu, G, tid, wave, lane); }
            SEAM(pb + 9);
            if (EN(13) && IN(pb + 10)) REPS(13) {
                PHASE_LOCALS;
                pg8::MoeOrder S; const int* moe_off = WSP(int, MS_MOEOFF);
#pragma unroll
                for (int e = 0; e < 9; ++e) S.off[e] = __builtin_amdgcn_readfirstlane(moe_off[e]);
                S.init(S.off[8] / 256, 2 * DFFE / 256, G, bx);
                pg8::Gemm g{WSP(bf16_t, WS_HS), DM, 0, WSP(bf16_t, WS_EW13), DM, (size_t)2 * DFFE * DM};
                pg8::EpiSwiglu E{WSP(bf16_t, WS_UM), DFFE};
                pg8::gemm_phase(lds, g, S, E);
            }
            SEAM(pb + 10);
            if (EN(14) && IN(pb + 11)) REPS(14) {
                PHASE_LOCALS;
                pg8::MoeRange S; const int* moe_off = WSP(int, MS_MOEOFF);
#pragma unroll
                for (int e = 0; e < 9; ++e) S.off[e] = __builtin_amdgcn_readfirstlane(moe_off[e]);
                S.init(S.off[8] / 256, DM / 256, G, bx); int Gd = G; asm volatile("" : "+s"(Gd)); S.i0 = 0; S.i1 = S.nwg / Gd;
                if ((S.i1 * G) % (pg8::WGM * (DM / 256)) == 0) S.nwg = S.i1 * G; else S.i1 += 1;
                pg8::Gemm g{WSP(bf16_t, WS_UM), DFFE, 0, WSP(bf16_t, WS_EW2), DFFE, (size_t)DM * DFFE};
                pg8::EpiBf16 E{WSP(bf16_t, WS_HS), DM, nullptr};
                pg8::gemm_phase(lds, g, S, E);
            }
            SEAM(pb + 11);
            if (EN(15) && IN(pb + 12)) REPS(15) { PHASE_LOCALS;
                pg8::MoeOne S; const int* moe_off = WSP(int, MS_MOEOFF);
#pragma unroll
                for (int e = 0; e < 9; ++e) S.off[e] = __builtin_amdgcn_readfirstlane(moe_off[e]);
                S.init(S.off[8] / 256, DM / 256, G, bx);
                int Gd = G; asm volatile("" : "+s"(Gd)); constexpr int NIG = pg8::WGM * (DM / 256);
                const int R = S.nwg / Gd; const bool clean = ((R * G) % NIG) == 0; const int Lc = clean ? S.nwg - R * G : 0;
                LAS int* late = (LAS int*)(lds + LDSCTL_OFF + 8192);
                for (int u = tid; u < 512; u += NWAVES * 64) late[u] = (clean && Lc > 0 && u >= (R * G) / (DM / 256) && u < S.nM) ? 1 : 0;
                __syncthreads();
                if (bx < Lc) {
                    { const int id = R * G + bx, gid = id / NIG, fm = gid * pg8::WGM, gsz = (S.nM - fm) < pg8::WGM ? (S.nM - fm) : pg8::WGM; S.pm1 = fm + (id % NIG) % gsz; S.pn1 = (id % NIG) / gsz; }
                    pg8::Gemm g{WSP(bf16_t, WS_UM), DFFE, 0, WSP(bf16_t, WS_EW2), DFFE, (size_t)DM * DFFE};
                    pg8::EpiBf16 E{WSP(bf16_t, WS_HS), DM, nullptr};
                    pg8::gemm_phase(lds, g, S, E);
                } else final_phase(A->out, WSP(bf16_t, WS_HS), WSP(int, MS_ROUTE), WSP(int, MS_SLOTS), A->final_norm_g, A->out, late, false, bx - Lc, G - Lc, wave, lane);
                xcd_barrier(bar);
                final_phase(A->out, WSP(bf16_t, WS_HS), WSP(int, MS_ROUTE), WSP(int, MS_SLOTS), A->final_norm_g, A->out, late, true, vcu, G, wave, lane);
            }
        }
    }
#undef IN
#undef EN
#undef SEAM
#undef PHASE_LOCALS
#undef WSP
}

extern "C" void kernel_launch(void* const* d_in, const int* in_sizes, int n_in, void* d_out, int out_size, void* d_ws, size_t ws_size, hipStream_t stream) {
    static int grid = 0;
    if (grid == 0) {
        if (n_in != 23 || in_sizes[0] != T * DM || out_size != T * DM || ws_size < WS_NEED) {
            fprintf(stderr, "kernel_launch: shape mismatch: n_in %d in0 %d out %d ws %zu (need %zu)\n", n_in, n_in > 0 ? in_sizes[0] : -1, out_size, ws_size, (size_t)WS_NEED); grid = -1; return; }
        int dev = 0, cus = 0, per_cu = 0;
        if (hipGetDevice(&dev) != hipSuccess || hipDeviceGetAttribute(&cus, hipDeviceAttributeMultiprocessorCount, dev) != hipSuccess) { fprintf(stderr, "kernel_launch: device query failed\n"); grid = -1; return; }
        if (hipFuncSetAttribute((const void*)mega_fwd, hipFuncAttributeMaxDynamicSharedMemorySize, LDS_BYTES) != hipSuccess) { fprintf(stderr, "kernel_launch: hipFuncSetAttribute failed\n"); grid = -1; return; }
        if (hipOccupancyMaxActiveBlocksPerMultiprocessor(&per_cu, (const void*)mega_fwd, NWAVES * 64, LDS_BYTES) != hipSuccess || per_cu < 1)
            fprintf(stderr, "kernel_launch: note: occupancy query reports %d workgroups per CU\n", per_cu);
        (void)hipGetLastError();
        grid = cus;
    }
    if (grid < 0) return;
    if (hipMemsetAsync((char*)d_ws + WS_CTL, 0, CTL_ZERO_BYTES, stream) != hipSuccess) { fprintf(stderr, "kernel_launch: memset failed\n"); return; }
    Args a{};
    a.x = (const float*)d_in[0]; a.positions = (const int*)d_in[1]; a.attn_norm_g = (const float*)d_in[2]; a.w_in = (const float*)d_in[3]; a.diff_lambda = (const float*)d_in[4];
    a.diff_subln_g = (const float*)d_in[5]; a.fox_bias = (const float*)d_in[6]; a.q_norm_g = (const float*)d_in[7]; a.kv_norm_g = (const float*)d_in[8]; a.w_uq = (const float*)d_in[9];
    a.w_uk = (const float*)d_in[10]; a.w_uv = (const float*)d_in[11]; a.w_branch = (const float*)d_in[12]; a.w_out = (const float*)d_in[13]; a.ffn_norm_g = (const float*)d_in[14];
    a.dense_w1 = (const float*)d_in[15]; a.dense_w3 = (const float*)d_in[16]; a.dense_w2 = (const float*)d_in[17]; a.router_w = (const float*)d_in[18]; a.expert_w1 = (const float*)d_in[19];
    a.expert_w3 = (const float*)d_in[20]; a.expert_w2 = (const float*)d_in[21]; a.final_norm_g = (const float*)d_in[22];
    a.out = (float*)d_out; a.ws = (unsigned char*)d_ws;
#if MK_ONE_LAUNCH
    a.ph_lo = 0; a.ph_hi = NPH; a.li = 0;
    hipLaunchKernelGGL(mega_fwd, dim3(grid), dim3(NWAVES * 64), LDS_BYTES, stream, a);
#else
    int li = 0;
    for (int k = 0; k < NPH; ++k) { if (!phase_exists(k)) continue;
        a.ph_lo = k; a.ph_hi = k + 1; a.li = li++;
        hipLaunchKernelGGL(mega_fwd, dim3(grid), dim3(NWAVES * 64), LDS_BYTES, stream, a); }
#endif
    const hipError_t le = hipPeekAtLastError();
    if (le != hipSuccess) fprintf(stderr, "kernel_launch: launch failed: %s\n", hipGetErrorName(le));
}
```

```cpp
#include <hip/hip_runtime.h>
#include <cstdio>
#include <cstdint>

#ifndef MK_ONE_LAUNCH
#define MK_ONE_LAUNCH 1
#endif

#define GAS __attribute__((address_space(1)))
#define LAS __attribute__((address_space(3)))
typedef unsigned short bf16_t;
typedef short bf16x8 __attribute__((ext_vector_type(8)));
typedef short s16x4 __attribute__((ext_vector_type(4)));
typedef float f32x4 __attribute__((ext_vector_type(4)));
typedef float f32x2 __attribute__((ext_vector_type(2)));
typedef float f32x16 __attribute__((ext_vector_type(16)));
typedef unsigned u32x4 __attribute__((ext_vector_type(4)));
typedef unsigned u32x2 __attribute__((ext_vector_type(2)));
typedef int i32x4 __attribute__((ext_vector_type(4)));

constexpr int NB = 8, SEQ = 4096, T = NB * SEQ, DM = 2048, DEPTH = 2;
constexpr int N_IN_SRC = 13384, NIN = 13568, LDP = 13312, TAILW = 256;
constexpr int DFF = 5632, NEXP = 8, DFFE = 7168;
constexpr float NORM_EPS = 1e-6f;
constexpr int PC_AQ = 0, PC_AK = 1024, PC_AV = 2048, PC_BQ = 3072, PC_BK = 4096, PC_BV = 5120, PC_CQ = 6144, PC_CKV = 6656, PC_GATE = 7168;
constexpr int MOE_ROWS = 2 * T + 2048;

constexpr size_t MiB = 1u << 20;
constexpr size_t WS_CTL = 0, CTL_ZERO_BYTES = 1 * MiB;
constexpr size_t WS_MISC = 3 * MiB;
constexpr size_t MS_RSTDQ = WS_MISC, MS_RSTDKV = MS_RSTDQ + (size_t)T * 4, MS_CKS = MS_RSTDKV + (size_t)T * 4, MS_ROUTE = MS_CKS + (size_t)NB * 8 * SEQ * 4,
                 MS_RSTD2 = MS_ROUTE + (size_t)T * 16, MS_SLOTS = MS_RSTD2 + (size_t)T * 4, MS_CNT = MS_SLOTS + (size_t)T * 8, MS_MOEOFF = MS_CNT + 1024 * 8 * 4,
                 MS_LAM = MS_MOEOFF + 256, MS_END = MS_LAM + 256;
static_assert(MS_END <= 8 * MiB, "misc region");
constexpr size_t WS_BASE = 8 * MiB;
constexpr size_t SZ_WIN = (size_t)NIN * DM * 2, SZ_WUQ = (size_t)1536 * 512 * 2, SZ_WUKV = (size_t)2048 * 512 * 2, SZ_WBR = (size_t)3 * 2048 * 1024 * 2, SZ_WOUT = (size_t)DM * DM * 2;
constexpr size_t WS_WIN = WS_BASE, WS_WD13 = WS_WIN + 2 * SZ_WIN, WS_WD2 = WS_WD13 + (size_t)2 * DFF * DM * 2, WS_H = WS_WD2 + (size_t)DM * DFF * 2,
                 WS_WUQ = WS_H + (size_t)T * DM * 2, WS_WUKV = WS_WUQ + 2 * SZ_WUQ, WS_TAIL = WS_WUKV + 2 * SZ_WUKV, WS_EARLY_END = WS_TAIL + (size_t)T * TAILW * 4 + (size_t)T * DM * 2  ,
                 WS_WBR = WS_EARLY_END, WS_WOUT = WS_WBR + 2 * SZ_WBR,
                 WS_PROJ = WS_WOUT + 2 * SZ_WOUT, WS_QM = WS_PROJ + (size_t)T * LDP * 2, WS_KNV = WS_QM + (size_t)T * 1536 * 2,
                 WS_KROT = WS_KNV + (size_t)T * 2048 * 2, WS_OBUF = WS_KROT + (size_t)T * 64 * 2, WS_MIX_END = WS_OBUF + (size_t)T * 3072 * 2;
constexpr size_t WS_MERGED = WS_QM;
static_assert((size_t)T * DM * 2 <= (size_t)T * (1536 + 2048) * 2, "merged fits in qm | knv");
constexpr size_t WS_UD = WS_PROJ;
static_assert((size_t)T * DFF * 2 <= (size_t)T * LDP * 2, "dense hidden fits in proj");
constexpr size_t WS_EW13 = WS_BASE, WS_HS = WS_EW13 + (size_t)NEXP * 2 * DFFE * DM * 2,
                 WS_UM = WS_HS + (size_t)MOE_ROWS * DM * 2, WS_MOE_END = WS_UM + (size_t)MOE_ROWS * DFFE * 2;
constexpr size_t WS_EW2 = WS_MIX_END > WS_MOE_END ? WS_MIX_END : WS_MOE_END;
constexpr size_t WS_NEED = WS_EW2 + (size_t)NEXP * DM * DFFE * 2;
constexpr int EARLY_EXP = 8;
static_assert(WS_EW13 + (size_t)EARLY_EXP * 2 * DFFE * DM * 2 <= WS_EARLY_END, "the early experts' copies must stay inside [WIN, WD13, WD2, H, WUQ, WUKV, TAIL, spare]");
static_assert(WS_NEED <= 2134232128ull, "workspace map exceeds the guaranteed minimum");
constexpr int CW_TMO = 0, CW_BAR = 4096;

constexpr int RING_BYTES = 131072, LDSCTL_OFF = RING_BYTES, MISC_OFF = LDSCTL_OFF + 320, LDS_BYTES = 147456;

#define RLX_AGENT __ATOMIC_RELAXED, __HIP_MEMORY_SCOPE_AGENT
#define LDS_WAIT() asm volatile("s_waitcnt lgkmcnt(0)" ::: "memory")
#define VM_WAIT() asm volatile("s_waitcnt vmcnt(0)" ::: "memory")
__device__ __forceinline__ unsigned cvt_pk_bf16(float lo, float hi) { unsigned r; asm volatile("v_cvt_pk_bf16_f32 %0, %1, %2" : "=v"(r) : "v"(lo), "v"(hi)); return r; }
__device__ __forceinline__ float bf2f(unsigned short h) { return __uint_as_float((unsigned)h << 16); }
__device__ __forceinline__ float bflo(unsigned w) { return __uint_as_float(w << 16); }
__device__ __forceinline__ float bfhi(unsigned w) { return __uint_as_float(w & 0xffff0000u); }
template <int CTRL> __device__ __forceinline__ float dpp_f(float v) { return __int_as_float(__builtin_amdgcn_update_dpp(0, __float_as_int(v), CTRL, 0xf, 0xf, true)); }
__device__ __forceinline__ float row_sum16(float v) {
    v += dpp_f<0xB1>(v);
    v += dpp_f<0x4E>(v);
    v += dpp_f<0x141>(v);
    v += dpp_f<0x140>(v);
    return v;
}
__device__ __forceinline__ float wave_sum(float v) {
    v = row_sum16(v);
    const int i = __float_as_int(v);
    return (__int_as_float(__builtin_amdgcn_readlane(i, 0)) + __int_as_float(__builtin_amdgcn_readlane(i, 16))) + (__int_as_float(__builtin_amdgcn_readlane(i, 32)) + __int_as_float(__builtin_amdgcn_readlane(i, 48)));
}
__device__ __forceinline__ float sigmoidf_(float x) { return __builtin_amdgcn_rcpf(1.0f + __expf(-x)); }

#define XB_TMO      128
#define XB_XCNT(j)  (256  + 64 * (j))
#define XB_XSUB(j)  (1280 + 64 * (j))
#define XB_XGEN(j)  (2304 + 64 * (j))
#define XB_TOP      3328
#define XB_TOPGEN   3392
#define XCD_BAR_WORDS 3456
#define XB_SPIN_CAP (1u << 22)
__device__ __forceinline__ unsigned xb_ld(unsigned* p)              { return __hip_atomic_load(p, __ATOMIC_RELAXED, __HIP_MEMORY_SCOPE_AGENT); }
__device__ __forceinline__ unsigned xb_add(unsigned* p, unsigned v) { return __hip_atomic_fetch_add(p, v, __ATOMIC_RELAXED, __HIP_MEMORY_SCOPE_AGENT); }
__device__ __forceinline__ unsigned xb_xcc_id() { return (unsigned)__builtin_amdgcn_s_getreg((3 << 11) | 20) & 0xFu; }
#define XB_SPIN(cond, bar) do { unsigned _sp = 0; while (cond) { __builtin_amdgcn_s_sleep(1); \
    if ((++_sp & 255u) == 0u) { if (xb_ld(&(bar)[XB_TMO])) break; if (_sp > XB_SPIN_CAP) { atomicAdd(&(bar)[XB_TMO], 1u); break; } } } } while (0)
struct XcdBarrier { unsigned* bar; unsigned x; volatile LAS unsigned* st; };
__device__ __forceinline__ XcdBarrier xcd_barrier_post(unsigned* bar, volatile LAS unsigned* st) {
    XcdBarrier b; b.bar = bar; b.x = xb_xcc_id(); b.st = st;
    if (threadIdx.x == 0) (void)xb_add(&bar[XB_XCNT(b.x)], 1u);
    return b;
}
__device__ __forceinline__ void xcd_barrier_complete(unsigned* bar, unsigned x, unsigned& nloc, unsigned& nx) {
    const unsigned G = gridDim.x * gridDim.y * gridDim.z;
    unsigned sum, cnt, mine, sp = 0u;
    for (;;) {
        sum = 0u; cnt = 0u; mine = 0u;
#pragma unroll
        for (unsigned j = 0; j < 16; ++j) { const unsigned c = xb_ld(&bar[XB_XCNT(j)]); sum += c; cnt += (c > 0u) ? 1u : 0u; mine = (j == x) ? c : mine; }
        if (sum == G) break;
        __builtin_amdgcn_s_sleep(1);
        if ((++sp & 255u) == 0u) { if (xb_ld(&bar[XB_TMO])) break; if (sp > XB_SPIN_CAP) { atomicAdd(&bar[XB_TMO], 1u); break; } }
    }
    nloc = mine > 0u ? mine : 1u; nx = cnt > 0u ? cnt : 1u;
}
__device__ __forceinline__ void xcd_barrier(const XcdBarrier& b) {
    asm volatile("s_waitcnt vmcnt(0)" ::: "memory");
    __syncthreads();
    if (threadIdx.x == 0) {
        unsigned* bar = b.bar;
        __builtin_amdgcn_s_waitcnt(0);
        unsigned nloc = b.st[0], nx = b.st[1];
        if (nloc == 0u) { xcd_barrier_complete(bar, b.x, nloc, nx); b.st[0] = nloc; b.st[1] = nx; }
        const unsigned old = xb_add(&bar[XB_XSUB(b.x)], 1u);
        const unsigned gen = old / nloc;
        if (old + 1u == (gen + 1u) * nloc) {
            __builtin_amdgcn_fence(__ATOMIC_RELEASE, "agent");
            asm volatile("s_waitcnt vmcnt(0)" ::: "memory");
            const unsigned og = xb_add(&bar[XB_TOP], 1u);
            const unsigned tg = og / nx;
            if (og + 1u == (tg + 1u) * nx) xb_add(&bar[XB_TOPGEN], 1u);
            else XB_SPIN(xb_ld(&bar[XB_TOPGEN]) == tg, bar);
            __builtin_amdgcn_fence(__ATOMIC_ACQUIRE, "agent");
            xb_add(&bar[XB_XGEN(b.x)], 1u);
            asm volatile("s_waitcnt vmcnt(0)" ::: "memory");
        } else {
            XB_SPIN(xb_ld(&bar[XB_XGEN(b.x)]) == gen, bar);
            __builtin_amdgcn_fence(__ATOMIC_ACQUIRE, "agent");
            asm volatile("s_waitcnt vmcnt(0)" ::: "memory");
        }
    }
    __syncthreads();
}

#ifndef PG8_SP2
#define PG8_SP2 1
#endif
namespace pg8 {
constexpr int BM = 256, BK = 64, HALF = 128, HTB = HALF * BK * 2, STAGE_BYTES = 8 * HTB, NXCD = 8, WGM = 4;
__host__ __device__ __forceinline__ int lds_byte(int r, int c) { const int st = (r >> 4) * 2 + (c >> 5), rr = r & 15, cc = c & 31, ob = rr * 64 + cc * 2; return st * 1024 + (ob ^ (((ob >> 9) & 1) << 5)); }
__host__ __device__ __forceinline__ void stage_rc(int b, int& R, int& C) { const int st = b / 1024, sb = b % 1024, swz = sb ^ (((sb >> 9) & 1) << 5); R = (st >> 1) * 16 + swz / 64; C = (st & 1) * 32 + (swz % 64) / 2; }
__host__ __device__ __forceinline__ int perm32(int rho) { const int n = rho >> 4, i = rho & 15; return 8 * (i >> 2) + 4 * n + (i & 3); }

struct Unit { int pm, pn, z; };
struct Gemm { const bf16_t* A; int lda; size_t azs; const bf16_t* Bt; int K; size_t bzs; };

struct StaticOrder {
    int nM, nN, nwg, G, c;
    __device__ void init(int nM_, int nN_, int G_, int c_) { nM = nM_; nN = nN_; nwg = nM * nN; G = G_; c = c_; }
    __device__ __forceinline__ bool tile(int i, int& pm, int& pn) const {
        const long L = (long)i * G + c; if (L >= nwg) return false;
        int wgid = (int)L; { const int q = nwg / NXCD, r = nwg % NXCD, xcd = wgid % NXCD, off = wgid / NXCD; wgid = (xcd < r ? xcd * (q + 1) : r * (q + 1) + (xcd - r) * q) + off; }
        const int nig = WGM * nN, gid = wgid / nig, fm = gid * WGM, gsz = (nM - fm) < WGM ? (nM - fm) : WGM;
        pm = fm + ((wgid % nig) % gsz); pn = (wgid % nig) / gsz; return true;
    }
    __device__ bool next(int i, Unit& u) const { u.z = 0; return tile(i, u.pm, u.pn); }
};
struct Z3Order : StaticOrder {
    __device__ bool next(int i, Unit& u) const { u.z = i % 3; return tile(i / 3, u.pm, u.pn); }
};
struct MoeOrder : StaticOrder {
    int off[9];
    __device__ bool next(int i, Unit& u) const {
        if (!tile(i, u.pm, u.pn)) return false;
        const int r = u.pm * 256; int z = 0;
#pragma unroll
        for (int e = 1; e < 8; ++e) z += (r >= off[e]) ? 1 : 0;
        u.z = z; return true;
    }
};
struct MoeRange : MoeOrder {
    int i0, i1;
    __device__ bool next(int i, Unit& u) const { return (i + i0 < i1) && MoeOrder::next(i + i0, u); }
};
struct MoeOne : MoeOrder {
    int pm1, pn1;
    __device__ bool next(int i, Unit& u) const {
        if (i != 0) return false;
        u.pm = pm1; u.pn = pn1; const int r = pm1 * 256; int z = 0;
#pragma unroll
        for (int e = 1; e < 8; ++e) z += (r >= off[e]) ? 1 : 0;
        u.z = z; return true;
    }
};

template <class Epi, class Sched>
__device__ __forceinline__ void gemm_phase(LAS unsigned char* lds, const Gemm g, const Sched& S, const Epi& E) {
    int tid = threadIdx.x; asm volatile("" : "+v"(tid));
    const int wid = __builtin_amdgcn_readfirstlane(tid >> 6), lane = tid & 63, wr = wid >> 2, wc = wid & 3, fr = lane & 15, fq = lane >> 4;
    const int K = g.K, nt = K / BK, lda = g.lda;
    unsigned voffA[2], voffB[2];
#pragma unroll
    for (int i = 0; i < 2; ++i) { int R, C; stage_rc(tid * 16 + i * 8192, R, C); const int Rb = Epi::PERM ? ((R & ~31) + perm32(R & 31)) : R;
        voffA[i] = (unsigned)(R * lda + C) * 2u; voffB[i] = (unsigned)(Rb * K + C) * 2u; }
    const size_t kstep = (size_t)(BK * 2);
    const size_t hstepA = (size_t)HALF * lda * 2, hstepB = (size_t)HALF * K * 2;
    const unsigned ldsw = (unsigned)wid * 1024u;
    const int aoff = lds_byte(wr * 64 + fr, fq * 8), boff = lds_byte(wc * 32 + fr, fq * 8);
#define PG8_SA(b, h) (((b) * 2 + (h)) * HTB)
#define PG8_SB(b, h) ((4 + (b) * 2 + (h)) * HTB)
#define PG8_STAGE(bufoff, gbase, voff) do { _Pragma("unroll") for (int _i = 0; _i < 2; ++_i) { \
        const char* gb_ = (const char*)(gbase); const unsigned la_ = (unsigned)(uintptr_t)(lds + (bufoff) + ldsw + _i * 8192); \
        asm volatile("s_mov_b32 m0, %2\n\ts_nop 0\n\tglobal_load_lds_dwordx4 %0, %1" :: "v"((voff)[_i]), "s"(gb_), "s"(la_) : "memory"); } } while (0)
#define PG8_LDA(dst, b, h) do { _Pragma("unroll") for (int m = 0; m < 4; ++m) _Pragma("unroll") for (int k = 0; k < 2; ++k) dst[m][k] = *(const LAS bf16x8*)(lds + PG8_SA(b, h) + aoff + m * 2048 + k * 1024); } while (0)
#define PG8_LDB(dst, b, h) do { _Pragma("unroll") for (int n = 0; n < 2; ++n) _Pragma("unroll") for (int k = 0; k < 2; ++k) dst[n][k] = *(const LAS bf16x8*)(lds + PG8_SB(b, h) + boff + n * 2048 + k * 1024); } while (0)
#define PG8_MMA(ai, bj, At, Bt) do { __builtin_amdgcn_s_setprio(1); _Pragma("unroll") for (int m = 0; m < 4; ++m) _Pragma("unroll") for (int n = 0; n < 2; ++n) _Pragma("unroll") for (int k = 0; k < 2; ++k) \
        acc[ai][bj][m][n] = __builtin_amdgcn_mfma_f32_16x16x32_bf16(Bt[n][k], At[m][k], acc[ai][bj][m][n], 0, 0, 0); __builtin_amdgcn_s_setprio(0); } while (0)
#define PG8_WAIT_V(n) asm volatile("s_waitcnt vmcnt(" #n ")" ::: "memory")
#define PG8_WAIT_L(n) asm volatile("s_waitcnt lgkmcnt(" #n ")" ::: "memory")
#define PG8_WAIT_VR(t_, ui_) asm volatile("s_waitcnt vmcnt(16)\n\ts_cmp_lg_u32 %0, 0\n\ts_cbranch_scc1 .Lpg8s%=\n\ts_cmp_lg_u32 %1, 0\n\ts_cbranch_scc1 .Lpg8r%=\n.Lpg8s%=:\n\ts_waitcnt vmcnt(8)\n.Lpg8r%=:" :: "s"(t_), "s"(ui_) : "memory", "scc")
#define PG8_BAR __builtin_amdgcn_s_barrier()
#define PG8_SCHED __builtin_amdgcn_sched_barrier(0)
    Unit cur, nxt; int ui = 0;
    if (!S.next(0, cur)) return;
    cur.pm = __builtin_amdgcn_readfirstlane(cur.pm); cur.pn = __builtin_amdgcn_readfirstlane(cur.pn); cur.z = __builtin_amdgcn_readfirstlane(cur.z);
    f32x4 acc[2][2][4][2];
#pragma unroll
    for (int a = 0; a < 2; ++a)
#pragma unroll
        for (int b = 0; b < 2; ++b)
#pragma unroll
            for (int m = 0; m < 4; ++m)
#pragma unroll
                for (int n = 0; n < 2; ++n) acc[a][b][m][n] = (f32x4){0.f, 0.f, 0.f, 0.f};
    bf16x8 At[4][2], B0[2][2], B1[2][2];
    const char* cA = (const char*)(g.A + (size_t)cur.z * g.azs) + (size_t)cur.pm * 2 * hstepA;
    const char* cB = (const char*)(g.Bt + (size_t)cur.z * g.bzs) + (size_t)cur.pn * 2 * hstepB;
#if PG8_SP2
    PG8_STAGE(PG8_SB(0, 0), cB, voffB); PG8_STAGE(PG8_SB(0, 1), cB + hstepB, voffB); PG8_STAGE(PG8_SA(0, 0), cA, voffA); PG8_STAGE(PG8_SA(0, 1), cA + hstepA, voffA);
    if (wr == 1) PG8_BAR;
    PG8_WAIT_V(2); PG8_BAR;
    PG8_STAGE(PG8_SB(1, 0), cB + kstep, voffB); PG8_STAGE(PG8_SA(1, 0), cA + kstep, voffA); PG8_STAGE(PG8_SB(1, 1), cB + hstepB + kstep, voffB);
    PG8_WAIT_V(6); PG8_BAR;
#else
    PG8_STAGE(PG8_SB(0, 0), cB, voffB); PG8_STAGE(PG8_SA(0, 0), cA, voffA); PG8_STAGE(PG8_SB(0, 1), cB + hstepB, voffB); PG8_STAGE(PG8_SA(0, 1), cA + hstepA, voffA);
    if (wr == 1) PG8_BAR;
    PG8_WAIT_V(4); PG8_BAR;
    PG8_STAGE(PG8_SB(1, 0), cB + kstep, voffB); PG8_STAGE(PG8_SA(1, 0), cA + kstep, voffA); PG8_STAGE(PG8_SB(1, 1), cB + hstepB + kstep, voffB);
    PG8_WAIT_V(6); PG8_BAR;
#endif
    for (;;) {
        const bool has_next = S.next(ui + 1, nxt);
        nxt.pm = __builtin_amdgcn_readfirstlane(nxt.pm); nxt.pn = __builtin_amdgcn_readfirstlane(nxt.pn); nxt.z = __builtin_amdgcn_readfirstlane(nxt.z);
        const char* nA = has_next ? (const char*)(g.A + (size_t)nxt.z * g.azs) + (size_t)nxt.pm * 2 * hstepA : cA;
        const char* nB = has_next ? (const char*)(g.Bt + (size_t)nxt.z * g.bzs) + (size_t)nxt.pn * 2 * hstepB : cB;
        for (int t = 0; t < nt; t += 2) {
            const bool last = (t == nt - 2);
            const char* a1 = cA + (size_t)(t + 1) * kstep;
            const char* a2 = last ? nA : cA + (size_t)(t + 2) * kstep; const char* b2 = last ? nB : cB + (size_t)(t + 2) * kstep;
            const char* a3 = a2 + kstep; const char* b3 = b2 + kstep;
#if PG8_SP2
            PG8_LDB(B0, 0, 0); PG8_LDB(B1, 0, 1); PG8_SCHED; PG8_LDA(At, 0, 0); PG8_STAGE(PG8_SA(1, 1), a1 + hstepA, voffA);
            PG8_WAIT_VR(t, ui);
            PG8_WAIT_L(0); PG8_BAR; PG8_MMA(0, 0, At, B0); PG8_MMA(0, 1, At, B1); PG8_BAR; PG8_SCHED;
            PG8_LDA(At, 0, 1); PG8_STAGE(PG8_SB(0, 0), b2, voffB); PG8_STAGE(PG8_SB(0, 1), b2 + hstepB, voffB); PG8_STAGE(PG8_SA(0, 0), a2, voffA);
            PG8_WAIT_VR(t, ui);
            PG8_WAIT_L(0); PG8_BAR; PG8_MMA(1, 0, At, B0); PG8_MMA(1, 1, At, B1); PG8_BAR; PG8_SCHED;
            PG8_LDB(B0, 1, 0); PG8_LDB(B1, 1, 1); PG8_SCHED; PG8_LDA(At, 1, 0); PG8_STAGE(PG8_SA(0, 1), a2 + hstepA, voffA);
            PG8_WAIT_V(8); PG8_WAIT_L(0); PG8_BAR; PG8_MMA(0, 0, At, B0); PG8_MMA(0, 1, At, B1); PG8_BAR; PG8_SCHED;
            PG8_LDA(At, 1, 1); PG8_STAGE(PG8_SB(1, 0), b3, voffB); PG8_STAGE(PG8_SB(1, 1), b3 + hstepB, voffB); PG8_STAGE(PG8_SA(1, 0), a3, voffA);
            PG8_WAIT_V(8); PG8_WAIT_L(0); PG8_BAR; PG8_MMA(1, 0, At, B0); PG8_MMA(1, 1, At, B1); PG8_BAR; PG8_SCHED;
#else
            PG8_LDB(B0, 0, 0); PG8_SCHED; PG8_LDA(At, 0, 0); PG8_STAGE(PG8_SA(1, 1), a1 + hstepA, voffA);
            PG8_WAIT_L(8); PG8_BAR; PG8_WAIT_L(0); PG8_MMA(0, 0, At, B0); PG8_BAR; PG8_SCHED;
            PG8_LDB(B1, 0, 1); PG8_STAGE(PG8_SB(0, 0), b2, voffB);
            PG8_BAR; PG8_WAIT_L(0); PG8_MMA(0, 1, At, B1); PG8_BAR;
            PG8_LDA(At, 0, 1); PG8_STAGE(PG8_SA(0, 0), a2, voffA);
            PG8_BAR; PG8_WAIT_L(0); PG8_MMA(1, 0, At, B0); PG8_BAR; PG8_SCHED;
            PG8_STAGE(PG8_SB(0, 1), b2 + hstepB, voffB);
            PG8_WAIT_V(6); PG8_BAR; PG8_MMA(1, 1, At, B1); PG8_BAR;
            PG8_LDB(B0, 1, 0); PG8_SCHED; PG8_LDA(At, 1, 0); PG8_STAGE(PG8_SA(0, 1), a2 + hstepA, voffA);
            PG8_WAIT_L(8); PG8_BAR; PG8_WAIT_L(0); PG8_MMA(0, 0, At, B0); PG8_BAR; PG8_SCHED;
            PG8_LDB(B1, 1, 1); PG8_STAGE(PG8_SB(1, 0), b3, voffB);
            PG8_BAR; PG8_WAIT_L(0); PG8_MMA(0, 1, At, B1); PG8_BAR;
            PG8_LDA(At, 1, 1); PG8_STAGE(PG8_SA(1, 0), a3, voffA);
            PG8_BAR; PG8_WAIT_L(0); PG8_MMA(1, 0, At, B0); PG8_BAR; PG8_SCHED;
            PG8_STAGE(PG8_SB(1, 1), b3 + hstepB, voffB);
            PG8_WAIT_V(6); PG8_BAR; PG8_MMA(1, 1, At, B1); PG8_BAR;
#endif
        }
        if (wr == 0) PG8_BAR;
        E(acc, cur, wr, wc, fr, fq);
        if (!has_next) break;
#pragma unroll
        for (int a = 0; a < 2; ++a)
#pragma unroll
            for (int b = 0; b < 2; ++b)
#pragma unroll
                for (int m = 0; m < 4; ++m)
#pragma unroll
                    for (int n = 0; n < 2; ++n) acc[a][b][m][n] = (f32x4){0.f, 0.f, 0.f, 0.f};
        cur = nxt; cA = nA; cB = nB; ++ui;
        if (wr == 1) PG8_BAR;
    }
    PG8_WAIT_V(0);
    PG8_BAR;
#undef PG8_SA
#undef PG8_SB
#undef PG8_STAGE
#undef PG8_LDA
#undef PG8_LDB
#undef PG8_MMA
#undef PG8_WAIT_V
#undef PG8_WAIT_L
#undef PG8_WAIT_VR
#undef PG8_BAR
#undef PG8_SCHED
}

#define EPI_ROWS(ai, m) (u.pm * BM + (ai) * HALF + wr * 64 + (m) * 16 + fr)

struct EpiProj {
    static constexpr bool PERM = true;
    bf16_t* O; float* tail;
    __device__ __forceinline__ void operator()(f32x4 (&acc)[2][2][4][2], const Unit& u, int wr, int wc, int fr, int fq) const {
        const int colt = wc * 32 + 8 * fq;
        if (u.pn < LDP / 256) {
#pragma unroll
            for (int ai = 0; ai < 2; ++ai)
#pragma unroll
                for (int m = 0; m < 4; ++m) { bf16_t* rowp = O + (size_t)EPI_ROWS(ai, m) * LDP + u.pn * BM + colt;
#pragma unroll
                    for (int bj = 0; bj < 2; ++bj) { const f32x4 v0 = acc[ai][bj][m][0], v1 = acc[ai][bj][m][1];
                        u32x4 w; w.x = cvt_pk_bf16(v0[0], v0[1]); w.y = cvt_pk_bf16(v0[2], v0[3]); w.z = cvt_pk_bf16(v1[0], v1[1]); w.w = cvt_pk_bf16(v1[2], v1[3]);
                        *(u32x4*)(rowp + bj * HALF) = w; } }
        } else {
#pragma unroll
            for (int ai = 0; ai < 2; ++ai)
#pragma unroll
                for (int m = 0; m < 4; ++m) { float* rowp = tail + (size_t)EPI_ROWS(ai, m) * TAILW + colt;
#pragma unroll
                    for (int bj = 0; bj < 2; ++bj) { *(f32x4*)(rowp + bj * HALF) = acc[ai][bj][m][0]; *(f32x4*)(rowp + bj * HALF + 4) = acc[ai][bj][m][1]; } }
        }
    }
};
struct EpiBf16 {
    static constexpr bool PERM = true;
    bf16_t* O; int ldc; const float* rowscale;
    __device__ __forceinline__ void operator()(f32x4 (&acc)[2][2][4][2], const Unit& u, int wr, int wc, int fr, int fq) const {
        const int colt = u.pn * BM + wc * 32 + 8 * fq;
#pragma unroll
        for (int ai = 0; ai < 2; ++ai)
#pragma unroll
            for (int m = 0; m < 4; ++m) { const int row = EPI_ROWS(ai, m); const float s = rowscale ? rowscale[row] : 1.0f; bf16_t* rowp = O + (size_t)row * ldc + colt;
#pragma unroll
                for (int bj = 0; bj < 2; ++bj) { const f32x4 v0 = acc[ai][bj][m][0] * s, v1 = acc[ai][bj][m][1] * s;
                    u32x4 w; w.x = cvt_pk_bf16(v0[0], v0[1]); w.y = cvt_pk_bf16(v0[2], v0[3]); w.z = cvt_pk_bf16(v1[0], v1[1]); w.w = cvt_pk_bf16(v1[2], v1[3]);
                    *(u32x4*)(rowp + bj * HALF) = w; } }
    }
};
struct EpiQ {
    static constexpr bool PERM = true;
    bf16_t* O; const float* rowscale; const int* positions; float qscale;
    __device__ __forceinline__ void operator()(f32x4 (&acc)[2][2][4][2], const Unit& u, int wr, int wc, int fr, int fq) const {
        const int colt = u.pn * BM + wc * 32 + 8 * fq;
        float sc[2][4], pf[2][4];
#pragma unroll
        for (int ai = 0; ai < 2; ++ai)
#pragma unroll
            for (int m = 0; m < 4; ++m) { const int row = EPI_ROWS(ai, m); sc[ai][m] = rowscale[row] * qscale; pf[ai][m] = (float)positions[row]; }
        float rf[2][4]; bool rope[2];
#pragma unroll
        for (int bj = 0; bj < 2; ++bj) { const int d = (colt + bj * HALF) % 192; rope[bj] = d >= 128;
#pragma unroll
            for (int k = 0; k < 4; ++k) rf[bj][k] = __builtin_amdgcn_exp2f(-(float)((d - 128) / 2 + k) * 0.41524101186092f) * 0.15915494309189535f; }
#pragma unroll
        for (int ai = 0; ai < 2; ++ai)
#pragma unroll
            for (int m = 0; m < 4; ++m) { const int row = EPI_ROWS(ai, m); const float s = sc[ai][m], p = pf[ai][m]; bf16_t* rowp = O + (size_t)row * 1536 + colt;
#pragma unroll
                for (int bj = 0; bj < 2; ++bj) { f32x4 v[2] = {acc[ai][bj][m][0] * s, acc[ai][bj][m][1] * s};
                    if (rope[bj]) {
#pragma unroll
                        for (int k = 0; k < 4; ++k) { const float rev = p * rf[bj][k], frc = rev - floorf(rev); const float c = __builtin_amdgcn_cosf(frc), sn = __builtin_amdgcn_sinf(frc);
                            const float a0 = v[k >> 1][2 * (k & 1)], b0 = v[k >> 1][2 * (k & 1) + 1];
                            v[k >> 1][2 * (k & 1)] = a0 * c - b0 * sn; v[k >> 1][2 * (k & 1) + 1] = b0 * c + a0 * sn; }
                    }
                    u32x4 w; w.x = cvt_pk_bf16(v[0][0], v[0][1]); w.y = cvt_pk_bf16(v[0][2], v[0][3]); w.z = cvt_pk_bf16(v[1][0], v[1][1]); w.w = cvt_pk_bf16(v[1][2], v[1][3]);
                    *(u32x4*)(rowp + bj * HALF) = w; } }
    }
};
struct EpiSwiglu {
    static constexpr bool PERM = true;
    bf16_t* O; int ldc;
    __device__ __forceinline__ void operator()(f32x4 (&acc)[2][2][4][2], const Unit& u, int wr, int wc, int fr, int fq) const {
        const int colt = u.pn * HALF + wc * 32 + 8 * fq;
#pragma unroll
        for (int ai = 0; ai < 2; ++ai)
#pragma unroll
            for (int m = 0; m < 4; ++m) { bf16_t* rowp = O + (size_t)EPI_ROWS(ai, m) * ldc + colt; float r[8];
#pragma unroll
                for (int n = 0; n < 2; ++n)
#pragma unroll
                    for (int i = 0; i < 4; ++i) { const float a = acc[ai][0][m][n][i], b = acc[ai][1][m][n][i]; r[n * 4 + i] = a * sigmoidf_(a) * b; }
                u32x4 w; w.x = cvt_pk_bf16(r[0], r[1]); w.y = cvt_pk_bf16(r[2], r[3]); w.z = cvt_pk_bf16(r[4], r[5]); w.w = cvt_pk_bf16(r[6], r[7]);
                *(u32x4*)rowp = w; }
    }
};
struct EpiBranch {
    static constexpr bool PERM = true;
    bf16_t* O; const bf16_t* proj;
    __device__ __forceinline__ void operator()(f32x4 (&acc)[2][2][4][2], const Unit& u, int wr, int wc, int fr, int fq) const {
        const int colt = u.pn * BM + wc * 32 + 8 * fq;
#pragma unroll
        for (int ai = 0; ai < 2; ++ai) {
            u32x4 gw[4][2];
#pragma unroll
            for (int m = 0; m < 4; ++m) { const bf16_t* gp = proj + (size_t)EPI_ROWS(ai, m) * LDP + PC_GATE + u.z * DM + colt;
#pragma unroll
                for (int bj = 0; bj < 2; ++bj) gw[m][bj] = *(const u32x4*)(gp + bj * HALF); }
            asm volatile("" ::: "memory");
#pragma unroll
            for (int m = 0; m < 4; ++m)
#pragma unroll
                for (int bj = 0; bj < 2; ++bj) { const u32x4 g = gw[m][bj]; const f32x4 v0 = acc[ai][bj][m][0], v1 = acc[ai][bj][m][1];
                    acc[ai][bj][m][0] = (f32x4){v0[0] * sigmoidf_(bflo(g.x)), v0[1] * sigmoidf_(bfhi(g.x)), v0[2] * sigmoidf_(bflo(g.y)), v0[3] * sigmoidf_(bfhi(g.y))};
                    acc[ai][bj][m][1] = (f32x4){v1[0] * sigmoidf_(bflo(g.z)), v1[1] * sigmoidf_(bfhi(g.z)), v1[2] * sigmoidf_(bflo(g.w)), v1[3] * sigmoidf_(bfhi(g.w))}; }
            if (u.z != 0) {
#pragma unroll
                for (int m = 0; m < 4; ++m) { const bf16_t* rowp = O + (size_t)EPI_ROWS(ai, m) * DM + colt;
#pragma unroll
                    for (int bj = 0; bj < 2; ++bj) gw[m][bj] = *(const u32x4*)(rowp + bj * HALF); }
                asm volatile("" ::: "memory");
#pragma unroll
                for (int m = 0; m < 4; ++m)
#pragma unroll
                    for (int bj = 0; bj < 2; ++bj) { const u32x4 o = gw[m][bj];
                        acc[ai][bj][m][0] += (f32x4){bflo(o.x), bfhi(o.x), bflo(o.y), bfhi(o.y)}; acc[ai][bj][m][1] += (f32x4){bflo(o.z), bfhi(o.z), bflo(o.w), bfhi(o.w)}; }
            }
#pragma unroll
            for (int m = 0; m < 4; ++m) { bf16_t* rowp = O + (size_t)EPI_ROWS(ai, m) * DM + colt;
#pragma unroll
                for (int bj = 0; bj < 2; ++bj) { const f32x4 v0 = acc[ai][bj][m][0], v1 = acc[ai][bj][m][1];
                    u32x4 w; w.x = cvt_pk_bf16(v0[0], v0[1]); w.y = cvt_pk_bf16(v0[2], v0[3]); w.z = cvt_pk_bf16(v1[0], v1[1]); w.w = cvt_pk_bf16(v1[2], v1[3]);
                    *(u32x4*)(rowp + bj * HALF) = w; } }
            asm volatile("" ::: "memory");
        }
    }
};
struct EpiResid {
    static constexpr bool PERM = false;
    const float* base; float* out;
    __device__ __forceinline__ void operator()(f32x4 (&acc)[2][2][4][2], const Unit& u, int wr, int wc, int fr, int fq) const {
        const int colt = u.pn * BM + wc * 32 + 4 * fq;
#pragma unroll
        for (int ai = 0; ai < 2; ++ai) {
            f32x4 bv[4][2][2];
#pragma unroll
            for (int m = 0; m < 4; ++m) { const size_t off = (size_t)EPI_ROWS(ai, m) * DM + colt;
#pragma unroll
                for (int bj = 0; bj < 2; ++bj)
#pragma unroll
                    for (int n = 0; n < 2; ++n) bv[m][bj][n] = *(const f32x4*)(base + off + bj * HALF + n * 16); }
            asm volatile("" ::: "memory");
#pragma unroll
            for (int m = 0; m < 4; ++m) { const size_t off = (size_t)EPI_ROWS(ai, m) * DM + colt;
#pragma unroll
                for (int bj = 0; bj < 2; ++bj)
#pragma unroll
                    for (int n = 0; n < 2; ++n) *(f32x4*)(out + off + bj * HALF + n * 16) = bv[m][bj][n] + acc[ai][bj][m][n]; }
            asm volatile("" ::: "memory");
        }
    }
};
#undef EPI_ROWS
}

namespace att {
constexpr int OFF_V = 0, SHM_V = 16384, OFF_KAUX = 32768, OFF_WS = 33280, OFF_KX = 35328, SHM_KX = 2048, OFF_K = 40960;
constexpr float L2E = 1.4426950408889634f, THR2 = 8.f * L2E;
template <int MODE> struct Cfg;
template <> struct Cfg<0> { static constexpr int DK = 64, NQ = 4; static constexpr float SCALE = 0.125f; };
template <> struct Cfg<1> { static constexpr int DK = 128, NQ = 8; static constexpr float SCALE = 0.08838834764831845f; };
template <> struct Cfg<2> { static constexpr int DK = 192, NQ = 12; static constexpr float SCALE = 0.07216878364870322f; };
static_assert(OFF_K + 2 * 64 * 192 * 2 <= RING_BYTES, "attention LDS map");

__device__ __forceinline__ int crow(int r, int hi) { return (r & 3) + 8 * (r >> 2) + 4 * hi; }
#define SBAR() __builtin_amdgcn_sched_barrier(0)
__device__ __forceinline__ void partialSM2(f32x16& p0, f32x16& p1, bool first, float& m_reg, float& alpha) {
    float pmax = p0[0];
#pragma unroll
    for (int r = 1; r < 16; ++r) pmax = fmaxf(pmax, p0[r]);
#pragma unroll
    for (int r = 0; r < 16; ++r) pmax = fmaxf(pmax, p1[r]);
    { auto rr = __builtin_amdgcn_permlane32_swap(__float_as_uint(pmax), __float_as_uint(pmax), false, false);
      pmax = fmaxf(__uint_as_float(rr[0]), __uint_as_float(rr[1])); }
    if (first) {
        m_reg = pmax; alpha = 0.f;
#pragma unroll
        for (int r = 0; r < 16; ++r) { p0[r] -= pmax; p1[r] -= pmax; }
    } else if (__builtin_expect(__all(pmax <= THR2), 1)) { alpha = 1.f; }
    else { const float delta = fmaxf(pmax, 0.f); alpha = __builtin_amdgcn_exp2f(-delta); m_reg += delta;
#pragma unroll
        for (int r = 0; r < 16; ++r) { p0[r] -= delta; p1[r] -= delta; } }
#pragma unroll
    for (int r = 0; r < 16; ++r) p0[r] = __builtin_amdgcn_exp2f(p0[r]);
}
__device__ __forceinline__ void finishSM(f32x16& p0, f32x16& p1, float alpha, float& l_reg, bf16x8& pa0, bf16x8& pa1, bf16x8& pa2, bf16x8& pa3) {
#pragma unroll
    for (int r = 0; r < 16; ++r) p1[r] = __builtin_amdgcn_exp2f(p1[r]);
    float ps = 0;
#pragma unroll
    for (int r = 0; r < 16; ++r) ps += p0[r];
#pragma unroll
    for (int r = 0; r < 16; ++r) ps += p1[r];
    { auto rr = __builtin_amdgcn_permlane32_swap(__float_as_uint(ps), __float_as_uint(ps), false, false);
      ps = __uint_as_float(rr[0]) + __uint_as_float(rr[1]); }
    l_reg = l_reg * alpha + ps;
#define PK4(P, BASE, OUT) do { unsigned a0 = cvt_pk_bf16(P[BASE + 0], P[BASE + 1]), a1 = cvt_pk_bf16(P[BASE + 2], P[BASE + 3]);   \
    unsigned b0 = cvt_pk_bf16(P[BASE + 4], P[BASE + 5]), b1 = cvt_pk_bf16(P[BASE + 6], P[BASE + 7]);                              \
    auto r0 = __builtin_amdgcn_permlane32_swap(a0, b0, false, false); auto r1 = __builtin_amdgcn_permlane32_swap(a1, b1, false, false); \
    u32x4 w = {r0[0], r1[0], r0[1], r1[1]}; OUT = *reinterpret_cast<bf16x8*>(&w); } while (0)
    PK4(p0, 0, pa0); PK4(p0, 8, pa1); PK4(p1, 0, pa2); PK4(p1, 8, pa3);
#undef PK4
}
__device__ __forceinline__ int v_st(int k, int c) { const int kk = (k & ~0xC) | ((k & 4) << 1) | ((k & 8) >> 1); return ((kk >> 3) * 4 + (c >> 5)) * 512 + ((kk & 7) * 32 + (c & 31)) * 2; }
__device__ __forceinline__ int v_rd_base(int lane) { return ((lane & 3) << 3) | (((lane >> 2) & 3) << 6) | (((lane >> 4) & 1) << 5) | (((lane >> 5) & 1) << 8); }
constexpr int v_rd_off(int d0, int ks, int half) { return d0 * 512 + ks * 4096 + half * 2048; }
template <int OFF> __device__ __forceinline__ s16x4 tr_read(int vb) {
    s16x4 r; asm volatile("ds_read_b64_tr_b16 %0, %1 offset:%2" : "=&v"(r) : "v"(vb), "i"(OFF) : "memory"); return r;
}
struct VFrag { s16x4 l0, h0, l1, h1, l2, h2, l3, h3; };
template <int D0> __device__ __forceinline__ void v_load(VFrag& f, int vb) {
    f.l0 = tr_read<v_rd_off(D0, 0, 0)>(vb); f.h0 = tr_read<v_rd_off(D0, 0, 1)>(vb); f.l1 = tr_read<v_rd_off(D0, 1, 0)>(vb); f.h1 = tr_read<v_rd_off(D0, 1, 1)>(vb);
    f.l2 = tr_read<v_rd_off(D0, 2, 0)>(vb); f.h2 = tr_read<v_rd_off(D0, 2, 1)>(vb); f.l3 = tr_read<v_rd_off(D0, 3, 0)>(vb); f.h3 = tr_read<v_rd_off(D0, 3, 1)>(vb);
}
__device__ __forceinline__ void pv_mma(f32x16& od, const VFrag& f, bf16x8 pa0, bf16x8 pa1, bf16x8 pa2, bf16x8 pa3) {
#define PK(L, H) (bf16x8){L[0], L[1], L[2], L[3], H[0], H[1], H[2], H[3]}
    od = __builtin_amdgcn_mfma_f32_32x32x16_bf16(pa0, PK(f.l0, f.h0), od, 0, 0, 0);
    od = __builtin_amdgcn_mfma_f32_32x32x16_bf16(pa1, PK(f.l1, f.h1), od, 0, 0, 0);
    od = __builtin_amdgcn_mfma_f32_32x32x16_bf16(pa2, PK(f.l2, f.h2), od, 0, 0, 0);
    od = __builtin_amdgcn_mfma_f32_32x32x16_bf16(pa3, PK(f.l3, f.h3), od, 0, 0, 0);
#undef PK
}
__device__ __forceinline__ void pv_all(f32x16 (&o)[4], int vb, bf16x8 pa0, bf16x8 pa1, bf16x8 pa2, bf16x8 pa3) {
    VFrag fa, fb;
    v_load<0>(fa, vb); v_load<1>(fb, vb);
    asm volatile("s_waitcnt lgkmcnt(8)" ::: "memory"); SBAR(); pv_mma(o[0], fa, pa0, pa1, pa2, pa3); SBAR();
    v_load<2>(fa, vb);
    asm volatile("s_waitcnt lgkmcnt(8)" ::: "memory"); SBAR(); pv_mma(o[1], fb, pa0, pa1, pa2, pa3); SBAR();
    v_load<3>(fb, vb);
    asm volatile("s_waitcnt lgkmcnt(8)" ::: "memory"); SBAR(); pv_mma(o[2], fa, pa0, pa1, pa2, pa3); SBAR();
    asm volatile("s_waitcnt lgkmcnt(0)" ::: "memory"); SBAR(); pv_mma(o[3], fb, pa0, pa1, pa2, pa3);
}

struct AttnP {
    unsigned char* ws; const int* positions; const float* subln_g; float lam, out_scale;
    __device__ __forceinline__ const bf16_t* proj() const { return (const bf16_t*)(ws + WS_PROJ); }
    __device__ __forceinline__ const bf16_t* qm() const { return (const bf16_t*)(ws + WS_QM); }
    __device__ __forceinline__ const bf16_t* knv() const { return (const bf16_t*)(ws + WS_KNV); }
    __device__ __forceinline__ const bf16_t* krot() const { return (const bf16_t*)(ws + WS_KROT); }
    __device__ __forceinline__ const float* ckS() const { return (const float*)(ws + MS_CKS); }
    __device__ __forceinline__ bf16_t* obuf() const { return (bf16_t*)(ws + WS_OBUF); }
};

template <int MODE>
__device__ __forceinline__ void attn_unit(const AttnP& P, int b, int h, int x, LAS char* lds) {
    constexpr int DK = Cfg<MODE>::DK, NQ = Cfg<MODE>::NQ, RS = DK * 2, SHM_K = 64 * RS;
    constexpr bool HAS_N = (MODE != 0);
    constexpr int RCOL = (MODE == 2) ? 128 : 0;
    constexpr bool HAS_R = (MODE != 1);
    constexpr bool HAS_AUX = (MODE != 2);
    int tid = threadIdx.x; asm volatile("" : "+v"(tid));
    const int wid = __builtin_amdgcn_readfirstlane(tid >> 6), lane = tid & 63, r32 = lane & 31, hi = lane >> 5;
    const size_t tok0 = (size_t)b * SEQ;
    const int q0w = x * 256 + wid * 32;
    const int NT = 4 * x + 4, jmax = 4 * x + (wid >> 1);
    LAS float* ws = (LAS float*)(lds + OFF_WS) + wid * 64; LAS float* li_l = ws; LAS float* al_l = ws + 32;
    const int sr = tid >> 4, sc = (tid & 15) * 8, vst0 = v_st(sr, sc), vst1 = v_st(32 + sr, sc);
    const int vb0 = (int)(uintptr_t)(lds + OFF_V) + v_rd_base(lane);
    const int rrow = tid >> 3, rcol = (tid & 7) * 8;
#define KSWZ(row, colB) ((row) * RS + ((colB) ^ (((row) & 7) << 4)))
    const int kstN0 = KSWZ(sr, sc * 2), kstN1 = KSWZ(32 + sr, sc * 2), kstR = KSWZ(rrow, (RCOL + rcol) * 2);
    int kb[4];
#pragma unroll
    for (int c = 0; c < 4; ++c) kb[c] = KSWZ(r32, c * 32 + hi * 16);
    constexpr int ldN = (MODE == 2) ? 2048 : LDP, ldR = (MODE == 2) ? 64 : LDP, ldV = (MODE == 2) ? 2048 : LDP, ldQ = (MODE == 2) ? 1536 : LDP;
    const bf16_t *srcN = nullptr, *srcR = nullptr, *srcV = nullptr, *srcQ = nullptr;
    if (MODE == 0) { srcR = P.proj() + tok0 * LDP + PC_AK + h * 128; srcV = P.proj() + tok0 * LDP + PC_AV + h * 128; srcQ = P.proj() + tok0 * LDP + PC_AQ + h * 128; }
    if (MODE == 1) { srcN = P.proj() + tok0 * LDP + PC_BK + h * 128; srcV = P.proj() + tok0 * LDP + PC_BV + h * 128; srcQ = P.proj() + tok0 * LDP + PC_BQ + h * 128; }
    if (MODE == 2) { srcN = P.knv() + tok0 * 2048 + h * 128; srcR = P.krot() + tok0 * 64; srcV = P.knv() + tok0 * 2048 + 1024 + h * 128; srcQ = P.qm() + tok0 * 1536 + h * 192; }
    float qaux = 0.f, slope2 = 0.f, xref = 0.f;
    if (MODE == 0) { qaux = (float)P.positions[tok0 + q0w + r32]; slope2 = exp2f(-(float)(h + 1)) * L2E; xref = (float)P.positions[tok0 + x * 256]; }
    if (MODE == 1) xref = P.ckS()[((size_t)b * 8 + h) * SEQ + x * 256];
    bf16x8 qx = bf16x8{}; if (hi == 0) { qx[0] = (short)0x3F80; qx[1] = (short)0x3F80; }
    f32x16 o[4]; float m_reg, l_reg; bf16x8 qr[NQ];
    constexpr int NMAP = (MODE == 0) ? 2 : 1;
    for (int mp = 0; mp < NMAP; ++mp) {
#pragma unroll
        for (int d = 0; d < 4; ++d) o[d] = f32x16{};
        m_reg = 0.f; l_reg = 0.f;
        { const bf16_t* Qw = srcQ + (size_t)(q0w + r32) * ldQ + mp * 64 + hi * 8;
#pragma unroll
          for (int d0 = 0; d0 < NQ; ++d0) qr[d0] = *(const bf16x8*)(Qw + d0 * 16); }
        const char* gN = (const char*)srcN; const char* gR = (const char*)(srcR + mp * 64); const char* gV = (const char*)srcV;
        const unsigned oN = (unsigned)(sr * ldN + sc) * 2u, oR = (unsigned)(rrow * ldR + rcol) * 2u, oV = (unsigned)(sr * ldV + sc) * 2u;
        bf16x8 sN0, sN1, sR, sV0, sV1; float sAux = 0.f; int tload = 0;
#define SLOAD() do { if (HAS_N) { sN0 = *(const bf16x8*)(gN + oN); sN1 = *(const bf16x8*)(gN + (size_t)32 * ldN * 2 + oN); gN += (size_t)64 * ldN * 2; } \
        if (HAS_R) { sR = *(const bf16x8*)(gR + oR); gR += (size_t)64 * ldR * 2; } \
        sV0 = *(const bf16x8*)(gV + oV); sV1 = *(const bf16x8*)(gV + (size_t)32 * ldV * 2 + oV); gV += (size_t)64 * ldV * 2; \
        if (HAS_AUX && tid < 64) { if (MODE == 0) sAux = (float)P.positions[tok0 + tload * 64 + tid]; else sAux = P.ckS()[((size_t)b * 8 + h) * SEQ + tload * 64 + tid]; } \
        ++tload; } while (0)
#define SWRITE(bf) do { LAS char* Kb = lds + OFF_K + (bf) * SHM_K; LAS char* Vb = lds + OFF_V + (bf) * SHM_V; \
        if (HAS_N) { *(LAS bf16x8*)(Kb + kstN0) = sN0; *(LAS bf16x8*)(Kb + kstN1) = sN1; } if (HAS_R) *(LAS bf16x8*)(Kb + kstR) = sR; \
        *(LAS bf16x8*)(Vb + vst0) = sV0; *(LAS bf16x8*)(Vb + vst1) = sV1; \
        if (HAS_AUX && tid < 64) { const float val = (MODE == 0) ? slope2 * (sAux - xref) : (xref - sAux) * L2E; const unsigned vh = cvt_pk_bf16(val, 0.f) & 0xffffu; \
            const unsigned vl = cvt_pk_bf16(val - __uint_as_float(vh << 16), 0.f) & 0xffffu; LAS u32x4* kx = (LAS u32x4*)(lds + OFF_KX + (bf) * SHM_KX + tid * 32); \
            kx[0] = (u32x4){vh | (vl << 16), 0u, 0u, 0u}; kx[1] = (u32x4){0u, 0u, 0u, 0u}; \
            if (MODE == 0) ((LAS float*)(lds + OFF_KAUX))[(bf) * 64 + tid] = sAux; } } while (0)
        __syncthreads();
        SLOAD(); SWRITE(0); SLOAD();
        for (int j = 0; j < NT; ++j) {
            __syncthreads();
            const int bf = j & 1;
            if (j <= jmax) {
                const bool first = (j == 0);
                f32x16 p0, p1; { const float ini = first ? 0.f : -m_reg;
#pragma unroll
                  for (int r = 0; r < 16; ++r) { p0[r] = ini; p1[r] = ini; } }
                {
                  const LAS char* Kb = lds + OFF_K + bf * SHM_K;
                  const LAS char* kx = lds + OFF_KX + bf * SHM_KX + r32 * 32 + hi * 16;
                  constexpr int NS = NQ + (HAS_AUX ? 1 : 0);
                  bf16x8 ra[3], rb[3];
#define QLOAD(s_) do { if ((s_) < NQ) { const LAS char* kp = Kb + kb[(s_) & 3] + ((s_) >> 2) * 128; ra[(s_) % 3] = *(const LAS bf16x8*)kp; rb[(s_) % 3] = *(const LAS bf16x8*)(kp + 32 * RS); } \
                      else { ra[(s_) % 3] = *(const LAS bf16x8*)kx; rb[(s_) % 3] = *(const LAS bf16x8*)(kx + 1024); } } while (0)
                  QLOAD(0); QLOAD(1);
#pragma unroll
                  for (int st = 0; st < NS; ++st) {
                      if (st + 2 < NS) QLOAD(st + 2);
                      SBAR();
                      const bf16x8 qb = (st < NQ) ? qr[st < NQ ? st : 0] : qx;
                      p0 = __builtin_amdgcn_mfma_f32_32x32x16_bf16(ra[st % 3], qb, p0, 0, 0, 0);
                      p1 = __builtin_amdgcn_mfma_f32_32x32x16_bf16(rb[st % 3], qb, p1, 0, 0, 0);
                      SBAR(); }
#undef QLOAD
                }
                if (MODE == 0 && j == jmax) {
                    const LAS float* ka = (const LAS float*)(lds + OFF_KAUX) + bf * 64 + 4 * hi; const float s2 = 2.f * slope2;
#pragma unroll
                    for (int g = 0; g < 4; ++g) { const f32x4 a0 = *(const LAS f32x4*)(ka + 8 * g), a1 = *(const LAS f32x4*)(ka + 32 + 8 * g);
#pragma unroll
                        for (int i = 0; i < 4; ++i) { p0[4 * g + i] = fmaf(s2, fminf(qaux - a0[i], 0.f), p0[4 * g + i]); p1[4 * g + i] = fmaf(s2, fminf(qaux - a1[i], 0.f), p1[4 * g + i]); } }
                }
                if (MODE == 1 && j == jmax) {
                    const int rowt = q0w - 64 * j + r32;
#pragma unroll
                    for (int r = 0; r < 16; ++r) { const int kk = crow(r, hi); if (kk > rowt) p0[r] = -__builtin_inff(); if (kk + 32 > rowt) p1[r] = -__builtin_inff(); }
                }
                float alpha; partialSM2(p0, p1, first, m_reg, alpha);
                if (__any(alpha < 1.f)) { if (hi == 0) al_l[r32] = alpha; LDS_WAIT();
#pragma unroll
                    for (int d = 0; d < 4; ++d)
#pragma unroll
                        for (int r = 0; r < 16; ++r) o[d][r] *= al_l[crow(r, hi)]; }
                bf16x8 pa0, pa1, pa2, pa3; finishSM(p0, p1, alpha, l_reg, pa0, pa1, pa2, pa3); SBAR();
                const int vb = vb0 + bf * SHM_V;
                pv_all(o, vb, pa0, pa1, pa2, pa3);
            }
            if (j + 1 < NT) { SWRITE(bf ^ 1); if (j + 2 < NT) SLOAD(); }
        }
#undef SLOAD
#undef SWRITE
        if (hi == 0) li_l[r32] = l_reg; LDS_WAIT();
        float rli[16];
#pragma unroll
        for (int r = 0; r < 16; ++r) rli[r] = __builtin_amdgcn_rcpf(li_l[crow(r, hi)]);
        LDS_WAIT();
        bf16_t* Ob = P.obuf() + (tok0 + q0w) * 3072 + MODE * 1024 + h * 128;
        constexpr int LDO = 3072;
        int hi4 = hi * 4; asm volatile("" : "+v"(hi4));
        if (MODE == 0 && mp == 1) {
            asm volatile("s_waitcnt vmcnt(0)" ::: "memory");
            const bf16_t* O1 = Ob; bf16_t* Oc = Ob;
            float gq[4];
#pragma unroll
            for (int d = 0; d < 4; ++d) gq[d] = P.subln_g[r32 + 32 * d] * P.out_scale;
            bf16_t a1[16][4];
#pragma unroll
            for (int r = 0; r < 16; ++r) { const unsigned vo1 = (unsigned)(((r & 3) + 8 * (r >> 2) + hi4) * 3072 + r32) * 2u;
#pragma unroll
                for (int d = 0; d < 4; ++d) a1[r][d] = *(const bf16_t*)((const char*)O1 + vo1 + d * 64); }
            asm volatile("" ::: "memory");
#pragma unroll
            for (int r = 0; r < 16; ++r) { const int rowi = (r & 3) + 8 * (r >> 2) + hi4; const unsigned vo2 = (unsigned)(rowi * 3072 + r32) * 2u;
                float v[4]; float ss = 0.f;
#pragma unroll
                for (int d = 0; d < 4; ++d) { const float a = bf2f(a1[r][d]); const float bq = __uint_as_float(cvt_pk_bf16(o[d][r] * rli[r], 0.f) << 16);
                    v[d] = a - P.lam * bq; ss += v[d] * v[d]; }
                ss = row_sum16(ss); ss += __int_as_float(__builtin_amdgcn_ds_swizzle(__float_as_int(ss), 0x401F));
                const float rs = __builtin_amdgcn_rsqf(ss * (1.0f / 128.0f) + NORM_EPS);
#pragma unroll
                for (int d = 0; d < 4; ++d) *(bf16_t*)((char*)Oc + vo2 + d * 64) = (bf16_t)(cvt_pk_bf16(v[d] * rs * gq[d], 0.f) & 0xffffu); }
        } else {
#pragma unroll
        for (int r = 0; r < 16; ++r) { const unsigned voff = (unsigned)(((r & 3) + 8 * (r >> 2) + hi4) * LDO + r32) * 2u;
#pragma unroll
            for (int d = 0; d < 4; ++d) *(bf16_t*)((char*)Ob + voff + d * 64) = (bf16_t)(cvt_pk_bf16(o[d][r] * rli[r], 0.f) & 0xffffu); }
        }
    }
#undef KSWZ
}
#undef SBAR
}

__device__ __forceinline__ int wsrc_in(int n) {
    if (n < 6144) return n;
    if (n < 7168) return 6152 + (n - 6144);
    if (n < 13312) return 7240 + (n - 7168);
    if (n < 13376) { const int j = n - 13312; return 7176 + (j & 1) * 32 + (j >> 1); }
    if (n < 13384) return 6144 + (n - 13376);
    return -1;
}
__device__ __forceinline__ int wsrc_uq(int n) { const int h = n / 192, d = n % 192; if (d < 128) return n; const int j = d - 128; return h * 192 + 128 + (j & 1) * 32 + (j >> 1); }
template <int KIND>
__device__ __forceinline__ void wconv_job(const float* W, const float* W2, int ldw, int K, int ndst, int nz, size_t wzs, size_t bzs, bf16_t* Bt, const float* ks, int kzs, LAS float* scr, int vcu, int G, int tid, int r0 = 0, int r1 = 0x7fffff) {
    const int lane = tid & 63, wave = __builtin_amdgcn_readfirstlane(tid >> 6);
    const int nkb = K / 64, nnb = ndst / 64, per = nkb * nnb, stride = G * 8, ntile_all = per * nz, ntile = (r1 < 0x7fffff && (long)r1 * stride < ntile_all) ? r1 * stride : ntile_all;
    LAS char* img = (LAS char*)scr + wave * 9216;
    float v[64]; int src = 0; float cs = 1.0f;
#define WC_LOAD(t_) do { const int z_ = (t_) / per, r_ = (t_) % per, kb_ = r_ / nnb, nb_ = r_ % nnb, nd_ = nb_ * 64 + lane; \
        const float* Wp_ = W + (size_t)z_ * wzs; src = nd_; \
        if (KIND == 1) { src = wsrc_in(nd_); cs = (nd_ < 1024) ? att::Cfg<0>::SCALE * att::L2E : ((nd_ >= PC_BQ && nd_ < PC_BK) ? att::Cfg<1>::SCALE * att::L2E : 1.0f); }     \
        if (KIND == 2) src = wsrc_uq(nd_); \
        if (KIND == 3) { Wp_ = (((nb_ >> 1) & 1) ? W2 : W) + (size_t)z_ * wzs; src = (nb_ >> 2) * 128 + (nb_ & 1) * 64 + lane; } \
        const float* col_ = Wp_ + (size_t)(kb_ * 64) * ldw + (src >= 0 ? src : 0); \
        _Pragma("unroll") for (int i = 0; i < 64; ++i) v[i] = __builtin_nontemporal_load(col_ + (size_t)i * ldw); } while (0)
    int t = vcu * 8 + wave + r0 * stride;
    if (t < ntile) WC_LOAD(t);
    while (t < ntile) {
        const int z = t / per, r = t % per, kb = r / nnb, nb = r % nnb, k0 = kb * 64, n0 = nb * 64;
        if (src < 0) {
#pragma unroll
            for (int i = 0; i < 64; ++i) v[i] = 0.f;
        }
        if (KIND == 1) {
#pragma unroll
            for (int i = 0; i < 64; ++i) v[i] *= cs; }
        if (ks) { const float* ksp = ks + (size_t)z * kzs + k0;
#pragma unroll
            for (int i = 0; i < 64; ++i) v[i] *= ksp[i]; }
#pragma unroll
        for (int c = 0; c < 8; ++c) { u32x4 o; o.x = cvt_pk_bf16(v[8 * c], v[8 * c + 1]); o.y = cvt_pk_bf16(v[8 * c + 2], v[8 * c + 3]); o.z = cvt_pk_bf16(v[8 * c + 4], v[8 * c + 5]); o.w = cvt_pk_bf16(v[8 * c + 6], v[8 * c + 7]);
            *(LAS u32x4*)(img + lane * 144 + c * 16) = o; }
        const int tn = t + stride;
        if (tn < ntile) WC_LOAD(tn);
        asm volatile("s_waitcnt lgkmcnt(0)" ::: "memory");
        bf16_t* dst = Bt + (size_t)z * bzs + (size_t)(n0 + (lane >> 3)) * K + k0 + (lane & 7) * 8;
#pragma unroll
        for (int i = 0; i < 8; ++i) { const u32x4 o = *(const LAS u32x4*)(img + ((lane >> 3) + 8 * i) * 144 + (lane & 7) * 16); __builtin_nontemporal_store(o, (u32x4*)(dst + (size_t)(8 * i) * K)); }
        asm volatile("s_waitcnt lgkmcnt(0)" ::: "memory");
        t = tn;
    }
#undef WC_LOAD
}
__device__ __forceinline__ void rmsnorm_rows(const float* x, const float* g, bf16_t* out, int vcu, int G, int wave, int lane) {
    f32x4 gv[8];
#pragma unroll
    for (int j = 0; j < 8; ++j) gv[j] = *((const f32x4*)g + lane + 64 * j);
    for (int m = vcu * 8 + wave; m < T; m += G * 16) {
        const int m2 = (m + G * 8 < T) ? m + G * 8 : m;
        const f32x4* xr = (const f32x4*)(x + (size_t)m * DM) + lane; const f32x4* xq = (const f32x4*)(x + (size_t)m2 * DM) + lane; f32x4 v[8], u[8]; float s = 0.f, s2 = 0.f;
#pragma unroll
        for (int j = 0; j < 8; ++j) v[j] = xr[64 * j];
#pragma unroll
        for (int j = 0; j < 8; ++j) u[j] = xq[64 * j];
#pragma unroll
        for (int j = 0; j < 8; ++j) s += (v[j][0] * v[j][0] + v[j][1] * v[j][1]) + (v[j][2] * v[j][2] + v[j][3] * v[j][3]);
#pragma unroll
        for (int j = 0; j < 8; ++j) s2 += (u[j][0] * u[j][0] + u[j][1] * u[j][1]) + (u[j][2] * u[j][2] + u[j][3] * u[j][3]);
        const float rstd = __builtin_amdgcn_rsqf(wave_sum(s) * (1.0f / DM) + NORM_EPS), rstd2 = __builtin_amdgcn_rsqf(wave_sum(s2) * (1.0f / DM) + NORM_EPS);
        u32x2* o8 = (u32x2*)(out + (size_t)m * DM) + lane; u32x2* o9 = (u32x2*)(out + (size_t)m2 * DM) + lane;
#pragma unroll
        for (int j = 0; j < 8; ++j) { const f32x4 y = v[j] * rstd * gv[j]; u32x2 w; w.x = cvt_pk_bf16(y[0], y[1]); w.y = cvt_pk_bf16(y[2], y[3]); o8[64 * j] = w; }
#pragma unroll
        for (int j = 0; j < 8; ++j) { const f32x4 y = u[j] * rstd2 * gv[j]; u32x2 w; w.x = cvt_pk_bf16(y[0], y[1]); w.y = cvt_pk_bf16(y[2], y[3]); o9[64 * j] = w; }
    }
}
__device__ __forceinline__ void prep_phase(const bf16_t* proj, const float* tail, const int* positions, const float* fbias,
                                           float* rstdq, float* rstdkv, bf16_t* krot, float* ckS, LAS float* scr, int vcu, int G, int tid, int wave, int lane) {
    const float rfreq = __builtin_amdgcn_exp2f(-(float)(lane & 31) * 0.41524101186092f) * 0.15915494309189535f;
    for (int m = vcu * 8 + wave; m < T; m += G * 32) {
        int mk[4]; u32x4 a[4], b[4]; f32x2 xv[4]; float pos[4];
#pragma unroll
        for (int k = 0; k < 4; ++k) { mk[k] = (m + k * G * 8 < T) ? m + k * G * 8 : m; }
#pragma unroll
        for (int k = 0; k < 4; ++k) { a[k] = *(const u32x4*)(proj + (size_t)mk[k] * LDP + PC_CQ + 8 * lane); b[k] = *(const u32x4*)(proj + (size_t)mk[k] * LDP + PC_CKV + 8 * lane);
            xv[k] = *((const f32x2*)(tail + (size_t)mk[k] * TAILW) + (lane & 31)); pos[k] = (float)positions[mk[k]]; }
#pragma unroll
        for (int k = 0; k < 4; ++k) {
            float sa = 0.f, sb = 0.f;
#pragma unroll
            for (int i = 0; i < 4; ++i) { const float a0 = bflo(a[k][i]), a1 = bfhi(a[k][i]), b0 = bflo(b[k][i]), b1 = bfhi(b[k][i]); sa += a0 * a0 + a1 * a1; sb += b0 * b0 + b1 * b1; }
            sa = wave_sum(sa); sb = wave_sum(sb);
            if (lane == 0) { rstdq[mk[k]] = __builtin_amdgcn_rsqf(sa * (1.0f / 512.0f) + NORM_EPS); rstdkv[mk[k]] = __builtin_amdgcn_rsqf(sb * (1.0f / 512.0f) + NORM_EPS); }
            if (lane < 32) { const float rev = pos[k] * rfreq, frc = rev - floorf(rev);
                const float cs = __builtin_amdgcn_cosf(frc), sn = __builtin_amdgcn_sinf(frc);
                ((unsigned*)(krot + (size_t)mk[k] * 64))[lane] = cvt_pk_bf16(xv[k].x * cs - xv[k].y * sn, xv[k].y * cs + xv[k].x * sn); }
        }
    }
    for (int u = vcu; u < NB * 8; u += G) {
        const int b = u >> 3, h = u & 7; const float fb = fbias[h]; float v[8]; float run = 0.f;
#pragma unroll
        for (int i = 0; i < 8; ++i) { const float f = tail[((size_t)b * SEQ + tid * 8 + i) * TAILW + 64 + h] + fb;
            const float ls = -(fmaxf(-f, 0.f) + log1pf(__expf(-fabsf(f)))); run += ls; v[i] = run; }
        __syncthreads();
        scr[tid] = run; __syncthreads();
        for (int o = 1; o < 512; o <<= 1) { float t = (tid >= o) ? scr[tid - o] : 0.f; __syncthreads(); scr[tid] += t; __syncthreads(); }
        const float excl = scr[tid] - run;
#pragma unroll
        for (int i = 0; i < 8; ++i) ckS[((size_t)b * 8 + h) * SEQ + tid * 8 + i] = excl + v[i];
        __syncthreads();
    }
}

__device__ __forceinline__ void diff_combine(const bf16_t* oscr, const float* g, float lam, float out_scale, bf16_t* obuf, int vcu, int G, int wave, int lane) {
    f32x4 g0 = *(const f32x4*)(g + (lane & 15) * 8), g1 = *(const f32x4*)(g + (lane & 15) * 8 + 4);
    for (int m = vcu * 8 + wave; m < T; m += G * 8) {
#pragma unroll
        for (int c = 0; c < 2; ++c) {
            const u32x4 a = *(const u32x4*)(oscr + (size_t)m * 2048 + c * 512 + lane * 8), b = *(const u32x4*)(oscr + (size_t)m * 2048 + 1024 + c * 512 + lane * 8);
            float v[8]; float ss = 0.f;
#pragma unroll
            for (int i = 0; i < 4; ++i) { v[2 * i] = bflo(a[i]) - lam * bflo(b[i]); v[2 * i + 1] = bfhi(a[i]) - lam * bfhi(b[i]); ss += v[2 * i] * v[2 * i] + v[2 * i + 1] * v[2 * i + 1]; }
            ss = row_sum16(ss);
            const float rs = __builtin_amdgcn_rsqf(ss * (1.0f / 128.0f) + NORM_EPS) * out_scale;
            u32x4 w; w.x = cvt_pk_bf16(v[0] * rs * g0[0], v[1] * rs * g0[1]); w.y = cvt_pk_bf16(v[2] * rs * g0[2], v[3] * rs * g0[3]);
            w.z = cvt_pk_bf16(v[4] * rs * g1[0], v[5] * rs * g1[1]); w.w = cvt_pk_bf16(v[6] * rs * g1[2], v[7] * rs * g1[3]);
            *(u32x4*)(obuf + (size_t)m * 3072 + c * 512 + lane * 8) = w;
        }
    }
}

#define LADD(p, v) (void)__hip_atomic_fetch_add((p), (v), __ATOMIC_RELAXED, __HIP_MEMORY_SCOPE_WORKGROUP)
__device__ __forceinline__ void moe_route(const float* x, const float* g, const float* router_w, int* route, float* rstd2, unsigned* cnt, LAS unsigned char* lds, int vcu, int G, int tid, int wave, int lane) {
    LAS float* Wt = (LAS float*)lds; LAS unsigned* elist = (LAS unsigned*)(lds + 65536);
    for (int idx = tid; idx < DM * 8; idx += 512) Wt[(idx & 7) * DM + (idx >> 3)] = router_w[idx];
    __syncthreads();
    int Gd = G; asm volatile("" : "+s"(Gd));
    const int TPW = (T + Gd - 1) / Gd, t0 = vcu * TPW, t1 = (t0 + TPW < T) ? t0 + TPW : T;
    f32x4 gv[8];
#pragma unroll
    for (int j = 0; j < 8; ++j) gv[j] = *((const f32x4*)g + lane + 64 * j);
    for (int m = t0 + wave; m < t1; m += 16) {
        const int mq = (m + 8 < t1) ? m + 8 : m;
        const f32x4* xr = (const f32x4*)(x + (size_t)m * DM) + lane; const f32x4* xq = (const f32x4*)(x + (size_t)mq * DM) + lane; f32x4 v[8], u[8]; float s = 0.f, sq = 0.f;
#pragma unroll
        for (int j = 0; j < 8; ++j) v[j] = xr[64 * j];
#pragma unroll
        for (int j = 0; j < 8; ++j) u[j] = xq[64 * j];
#pragma unroll
        for (int j = 0; j < 8; ++j) s += (v[j][0] * v[j][0] + v[j][1] * v[j][1]) + (v[j][2] * v[j][2] + v[j][3] * v[j][3]);
#pragma unroll
        for (int j = 0; j < 8; ++j) sq += (u[j][0] * u[j][0] + u[j][1] * u[j][1]) + (u[j][2] * u[j][2] + u[j][3] * u[j][3]);
        const float rstd = __builtin_amdgcn_rsqf(wave_sum(s) * (1.0f / DM) + NORM_EPS), rstdq = __builtin_amdgcn_rsqf(wave_sum(sq) * (1.0f / DM) + NORM_EPS);
#pragma unroll
        for (int j = 0; j < 8; ++j) { v[j] = v[j] * rstd * gv[j]; u[j] = u[j] * rstdq * gv[j]; }
        float lg[8], lq[8];
#pragma unroll
        for (int e = 0; e < 8; ++e) { float a = 0.f, b = 0.f;
#pragma unroll
            for (int j = 0; j < 8; ++j) { const f32x4 w = *((const LAS f32x4*)(Wt + e * DM) + lane + 64 * j); a += (v[j][0] * w[0] + v[j][1] * w[1]) + (v[j][2] * w[2] + v[j][3] * w[3]);
                b += (u[j][0] * w[0] + u[j][1] * w[1]) + (u[j][2] * w[2] + u[j][3] * w[3]); }
            lg[e] = wave_sum(a); lq[e] = wave_sum(b); }
#define ROUTE_PICK(lg_, m_, rstd_) do { int e0 = 0; float v0 = lg_[0]; \
        _Pragma("unroll") for (int e = 1; e < 8; ++e) if (lg_[e] > v0) { v0 = lg_[e]; e0 = e; } \
        int e1 = -1; float v1 = -__builtin_inff(); \
        _Pragma("unroll") for (int e = 0; e < 8; ++e) if (e != e0 && lg_[e] > v1) { v1 = lg_[e]; e1 = e; } \
        const float ex = __expf(v1 - v0), w0 = 1.0f / (1.0f + ex), w1 = ex * w0; \
        if (lane == 0) { i32x4 r; r.x = e0; r.y = e1; r.z = __float_as_int(w0); r.w = __float_as_int(w1); *((i32x4*)route + (m_)) = r; rstd2[m_] = rstd_; elist[(m_) - t0] = (unsigned)e0 | ((unsigned)e1 << 8); } } while (0)
        ROUTE_PICK(lg, m, rstd); ROUTE_PICK(lq, mq, rstdq);
#undef ROUTE_PICK
    }
    __syncthreads();
    if (tid < 8) { unsigned c = 0; for (int i = 0; i < t1 - t0; ++i) { const unsigned w = elist[i]; c += ((w & 255u) == (unsigned)tid) + ((w >> 8) == (unsigned)tid); } cnt[vcu * 8 + tid] = c; }
    __syncthreads();
}
__device__ __forceinline__ void moe_gather(const float* x, const float* g, const int* route, const float* rstd2, const unsigned* cnt, int* slots, int* moe_off, bf16_t* hs,
                                           LAS unsigned char* lds, int vcu, int G, int tid, int wave, int lane) {
    LAS unsigned* tot = (LAS unsigned*)lds; LAS unsigned* base = tot + 8; LAS int* offp = (LAS int*)(tot + 16); LAS unsigned* elist = tot + 32; LAS int* slotl = (LAS int*)(tot + 32 + 1024);
    if (tid < 16) tot[tid] = 0u;
    __syncthreads();
    for (int w = tid; w < G; w += 512) { const u32x4 c0 = *((const u32x4*)cnt + 2 * w), c1 = *((const u32x4*)cnt + 2 * w + 1);
#pragma unroll
        for (int e = 0; e < 4; ++e) { LADD(&tot[e], c0[e]); LADD(&tot[4 + e], c1[e]); if (w < vcu) { LADD(&base[e], c0[e]); LADD(&base[4 + e], c1[e]); } } }
    __syncthreads();
    if (tid == 0) { int o = 0; for (int e = 0; e < 8; ++e) { offp[e] = o; o += (int)((tot[e] + 255u) & ~255u); } offp[8] = o; }
    __syncthreads();
    if (vcu == 0 && tid < 9) moe_off[tid] = offp[tid];
    int Gd = G; asm volatile("" : "+s"(Gd));
    const int TPW = (T + Gd - 1) / Gd, t0 = vcu * TPW, t1 = (t0 + TPW < T) ? t0 + TPW : T, nt = t1 - t0;
    for (int i = tid; i < nt; i += 512) { const i32x4 r = *((const i32x4*)route + t0 + i); elist[i] = (unsigned)r.x | ((unsigned)r.y << 8); }
    __syncthreads();
    for (int i = tid; i < nt; i += 512) { const unsigned w = elist[i], e0 = w & 255u, e1 = w >> 8; int r0 = 0, r1 = 0;
        for (int k = 0; k < i; ++k) { const unsigned q = elist[k], a = q & 255u, b = q >> 8; r0 += (a == e0) + (b == e0); r1 += (a == e1) + (b == e1); }
        const int s0 = offp[e0] + (int)base[e0] + r0, s1 = offp[e1] + (int)base[e1] + r1;
        slotl[2 * i] = s0; slotl[2 * i + 1] = s1; slots[2 * (t0 + i)] = s0; slots[2 * (t0 + i) + 1] = s1; }
    __syncthreads();
    f32x4 gv[8];
#pragma unroll
    for (int j = 0; j < 8; ++j) gv[j] = *((const f32x4*)g + lane + 64 * j);
    for (int m = t0 + wave; m < t1; m += 16) {
        const int mq = (m + 8 < t1) ? m + 8 : m;
        const f32x4* xr = (const f32x4*)(x + (size_t)m * DM) + lane; const f32x4* xq = (const f32x4*)(x + (size_t)mq * DM) + lane; f32x4 v[8], u[8];
#pragma unroll
        for (int j = 0; j < 8; ++j) v[j] = xr[64 * j];
#pragma unroll
        for (int j = 0; j < 8; ++j) u[j] = xq[64 * j];
        const float rstd = rstd2[m], rstdq = rstd2[mq]; const int s0 = slotl[2 * (m - t0)], s1 = slotl[2 * (m - t0) + 1], q0 = slotl[2 * (mq - t0)], q1 = slotl[2 * (mq - t0) + 1];
        u32x2* o0 = (u32x2*)(hs + (size_t)s0 * DM) + lane; u32x2* o1 = (u32x2*)(hs + (size_t)s1 * DM) + lane; u32x2* p0 = (u32x2*)(hs + (size_t)q0 * DM) + lane; u32x2* p1 = (u32x2*)(hs + (size_t)q1 * DM) + lane;
#pragma unroll
        for (int j = 0; j < 8; ++j) { const f32x4 y = v[j] * rstd * gv[j]; u32x2 w; w.x = cvt_pk_bf16(y[0], y[1]); w.y = cvt_pk_bf16(y[2], y[3]); o0[64 * j] = w; o1[64 * j] = w; }
#pragma unroll
        for (int j = 0; j < 8; ++j) { const f32x4 y = u[j] * rstdq * gv[j]; u32x2 w; w.x = cvt_pk_bf16(y[0], y[1]); w.y = cvt_pk_bf16(y[2], y[3]); p0[64 * j] = w; p1[64 * j] = w; }
    }
    __syncthreads();
}
__device__ __forceinline__ void final_phase(const float* x, const bf16_t* ys, const int* route, const int* slots, const float* g, float* out, const LAS int* late, bool want_late, int vcu, int G, int wave, int lane) {
    f32x4 gv[8];
#pragma unroll
    for (int j = 0; j < 8; ++j) gv[j] = *((const f32x4*)g + lane + 64 * j);
    for (int m = vcu * 8 + wave; m < T; m += G * 8) {
        const int s0 = __builtin_amdgcn_readfirstlane(slots[2 * m]), s1 = __builtin_amdgcn_readfirstlane(slots[2 * m + 1]);
        if (((late[s0 >> 8] | late[s1 >> 8]) != 0) != want_late) continue;
        const i32x4 r = *((const i32x4*)route + m); const float w0 = __int_as_float(r.z), w1 = __int_as_float(r.w);
        const f32x4* xr = (const f32x4*)(x + (size_t)m * DM) + lane; const u32x2* y0 = (const u32x2*)(ys + (size_t)s0 * DM) + lane; const u32x2* y1 = (const u32x2*)(ys + (size_t)s1 * DM) + lane;
        f32x4 v[8]; float s = 0.f;
#pragma unroll
        for (int j = 0; j < 8; ++j) { const u32x2 a = y0[64 * j], b = y1[64 * j]; f32x4 t = xr[64 * j];
            t[0] += w0 * bflo(a.x) + w1 * bflo(b.x); t[1] += w0 * bfhi(a.x) + w1 * bfhi(b.x); t[2] += w0 * bflo(a.y) + w1 * bflo(b.y); t[3] += w0 * bfhi(a.y) + w1 * bfhi(b.y);
            v[j] = t; s += (t[0] * t[0] + t[1] * t[1]) + (t[2] * t[2] + t[3] * t[3]); }
        const float rstd = __builtin_amdgcn_rsqf(wave_sum(s) * (1.0f / DM) + NORM_EPS);
        f32x4* o = (f32x4*)(out + (size_t)m * DM) + lane;
#pragma unroll
        for (int j = 0; j < 8; ++j) o[64 * j] = v[j] * rstd * gv[j];
    }
}

constexpr int NWAVES = 8, PH_PER_LAYER = 13, NPH = 1 + 2 * PH_PER_LAYER;
struct Args {
    const float* x; const int* positions; const float* attn_norm_g; const float* w_in; const float* diff_lambda; const float* diff_subln_g; const float* fox_bias;
    const float* q_norm_g; const float* kv_norm_g; const float* w_uq; const float* w_uk; const float* w_uv; const float* w_branch; const float* w_out; const float* ffn_norm_g;
    const float* dense_w1; const float* dense_w3; const float* dense_w2; const float* router_w; const float* expert_w1; const float* expert_w3; const float* expert_w2; const float* final_norm_g;
    float* out; unsigned char* ws; int ph_lo, ph_hi, li, pad;
};
__host__ __device__ constexpr bool phase_exists(int k) {
    if (k == 0) return true;
    const int l = (k - 1) / PH_PER_LAYER, p = (k - 1) % PH_PER_LAYER;
    if (l == 0) return p >= 1 && p <= 10;
    return true;
}

typedef const __attribute__((address_space(4))) Args* KArgs;
__device__ __forceinline__ KArgs kargs() { KArgs p = (KArgs)__builtin_amdgcn_kernarg_segment_ptr(); asm volatile("" : "+s"(p)); return p; }

__global__ void __launch_bounds__(NWAVES * 64, 2) mega_fwd(Args a) {
    extern __shared__ __attribute__((aligned(16))) unsigned char lds_raw[];
    LAS unsigned char* lds = (LAS unsigned char*)lds_raw;
    const int G = gridDim.x, bx = blockIdx.x, vcu = (G % 8 == 0) ? (bx % 8) * (G / 8) + bx / 8 : bx;
    volatile LAS unsigned* MISC = (volatile LAS unsigned*)(lds + MISC_OFF);
    for (int u = threadIdx.x; u < (LDS_BYTES - LDSCTL_OFF) / 4; u += NWAVES * 64) ((LAS unsigned*)(lds + LDSCTL_OFF))[u] = 0u;
    __syncthreads();
    XcdBarrier bar = xcd_barrier_post((unsigned*)(a.ws + WS_CTL) + CW_BAR + a.li * XCD_BAR_WORDS, MISC + 8);
    const int lo = a.ph_lo, hi = a.ph_hi;
#ifndef ATT_MODES
#define ATT_MODES 7
#endif
#ifndef PH_ENABLE
#define PH_ENABLE 0xFFFFFFFFu
#endif
#define IN(k) (lo <= (k) && (k) < hi)
#define EN(kind) (((PH_ENABLE) >> (kind)) & 1u)
#ifndef PROBE_REP_MASK
#define PROBE_REP_MASK 0u
#endif
#define REPS(kind) for (int rep_ = 0; rep_ < ((((PROBE_REP_MASK) >> (kind)) & 1u) ? PROBE_REP_N : 1); ++rep_)
#ifndef PROBE_REP_N
#define PROBE_REP_N 2
#endif
#ifndef PROBE_BAR2
#define PROBE_BAR2 0
#endif
#define SEAM(k) do { if (IN(k) && (k) + 1 < hi) { xcd_barrier(bar); if (PROBE_BAR2) xcd_barrier(bar); } } while (0)
#define PHASE_LOCALS KArgs A = kargs(); unsigned char* ws = A->ws; int tid = threadIdx.x; asm volatile("" : "+v"(tid)); const int lane = tid & 63, wave = __builtin_amdgcn_readfirstlane(tid >> 6); (void)lane; (void)wave; (void)ws
#define WSP(T_, off) ((T_*)(ws + (off)))

    if (EN(0) && IN(0)) REPS(0) {
        PHASE_LOCALS; LAS float* scr = (LAS float*)lds;
        wconv_job<1>(A->w_in, nullptr, N_IN_SRC, DM, NIN, 1, (size_t)DM * N_IN_SRC, (size_t)NIN * DM, WSP(bf16_t, WS_WIN), nullptr, 0, scr, vcu, G, tid);
        wconv_job<2>(A->w_uq, nullptr, 1536, 512, 1536, 2, (size_t)512 * 1536, (size_t)1536 * 512, WSP(bf16_t, WS_WUQ), A->q_norm_g, 512, scr, vcu, G, tid);
        wconv_job<0>(A->w_uk, nullptr, 1024, 512, 1024, 2, (size_t)512 * 1024, (size_t)2048 * 512, WSP(bf16_t, WS_WUKV), A->kv_norm_g, 512, scr, vcu, G, tid);
        wconv_job<0>(A->w_uv, nullptr, 1024, 512, 1024, 2, (size_t)512 * 1024, (size_t)2048 * 512, WSP(bf16_t, WS_WUKV) + (size_t)1024 * 512, A->kv_norm_g, 512, scr, vcu, G, tid);
        rmsnorm_rows(A->x, A->attn_norm_g, WSP(bf16_t, WS_H), vcu, G, wave, lane);
    }
    SEAM(0);

    for (int l = 0; l < DEPTH; ++l) {
        const int pb = 1 + l * PH_PER_LAYER;
        if (hi <= pb || lo >= pb + PH_PER_LAYER) continue;

        if (l > 0) { if (EN(1) && IN(pb + 0)) REPS(1) { PHASE_LOCALS; rmsnorm_rows(A->out, A->attn_norm_g + l * DM, WSP(bf16_t, WS_H), vcu, G, wave, lane); } SEAM(pb + 0); }

        if (EN(2) && IN(pb + 1)) REPS(2) {
            PHASE_LOCALS;
            pg8::Gemm g{WSP(bf16_t, WS_H), DM, 0, WSP(bf16_t, WS_WIN + (size_t)l * SZ_WIN), DM, 0}; pg8::StaticOrder S; S.init(T / 256, NIN / 256, G, bx);
            pg8::EpiProj E{WSP(bf16_t, WS_PROJ), WSP(float, WS_TAIL)};
            pg8::gemm_phase(lds, g, S, E);
        }
        SEAM(pb + 1);

        if (EN(3) && IN(pb + 2)) REPS(3) { PHASE_LOCALS;
            prep_phase(WSP(bf16_t, WS_PROJ), WSP(float, WS_TAIL), A->positions, A->fox_bias + l * 8, WSP(float, MS_RSTDQ), WSP(float, MS_RSTDKV), WSP(bf16_t, WS_KROT), WSP(float, MS_CKS),
                       (LAS float*)lds, vcu, G, tid, wave, lane); }
        SEAM(pb + 2);

        if (EN(4) && IN(pb + 3)) REPS(4) {
            { PHASE_LOCALS;
              pg8::Gemm g{WSP(bf16_t, WS_PROJ) + PC_CQ, LDP, 0, WSP(bf16_t, WS_WUQ + (size_t)l * SZ_WUQ), 512, 0}; pg8::StaticOrder S; S.init(T / 256, 1536 / 256, G, bx);
              pg8::EpiQ E{WSP(bf16_t, WS_QM), WSP(float, MS_RSTDQ), A->positions, att::Cfg<2>::SCALE * att::L2E};
              pg8::gemm_phase(lds, g, S, E); }
            { PHASE_LOCALS;
              pg8::Gemm g{WSP(bf16_t, WS_PROJ) + PC_CKV, LDP, 0, WSP(bf16_t, WS_WUKV + (size_t)l * SZ_WUKV), 512, 0}; pg8::StaticOrder S; S.init(T / 256, 2048 / 256, G, bx);
              pg8::EpiBf16 E{WSP(bf16_t, WS_KNV), 2048, WSP(float, MS_RSTDKV)};
              pg8::gemm_phase(lds, g, S, E); }
        }
        SEAM(pb + 3);

        const float lam_init = (l == 0) ? 0.2f : 0.35550906759f;
        if (EN(5) && IN(pb + 4)) REPS(5) {
            PHASE_LOCALS;
            const float* dl = A->diff_lambda + l * 256; const float p = dl[lane] * dl[64 + lane], q = dl[128 + lane] * dl[192 + lane];
            const float lam = __expf(wave_sum(p)) - __expf(wave_sum(q)) + lam_init;
            att::AttnP P{ws, A->positions, A->diff_subln_g + l * 128, lam, 1.0f - lam_init};
            int cslot = 0;
#define CJ(KIND_, W_, W2_, ldw_, K_, nd_, nz_, wzs_, bzs_, Bt_, pre_, rp_) do { const int a_ = g0_ - (pre_), b_ = a_ + rs0; \
                wconv_job<KIND_>(W_, W2_, ldw_, K_, nd_, nz_, wzs_, bzs_, Bt_, nullptr, 0, (LAS float*)lds, vcu, G, tid, a_ < 0 ? 0 : a_, b_ < (rp_) ? b_ : (rp_)); } while (0)
#define CONV_CONSTS int Gq_ = G; asm volatile("" : "+s"(Gq_)); const int nslots = 6 * ((512 - vcu + Gq_ - 1) / Gq_); const int rp2 = ((DFFE / 64) * (DM / 64) * NEXP + Gq_ * 8 - 1) / (Gq_ * 8), rp13 = ((DM / 64) * (2 * DFFE / 64) * EARLY_EXP + Gq_ * 8 - 1) / (Gq_ * 8); const int rs2 = (rp2 + nslots - 1) / nslots, rs13 = (rp13 + nslots - 1) / nslots; const int W8 = Gq_ * 8, rpA = ((DM / 64) * (NIN / 64) + W8 - 1) / W8, rpB = ((DM / 64) * (2 * DFF / 64) + W8 - 1) / W8, rpC = (6 * (1024 / 64) * (DM / 64) + W8 - 1) / W8, rpD = ((DFF / 64) * (DM / 64) + W8 - 1) / W8, rpE = (2 * (DM / 64) * (DM / 64) + W8 - 1) / W8;
#define CONV_SLOT() do { CONV_CONSTS if (l == 1) { __syncthreads(); const int q0_ = cslot * rs2, q1_ = q0_ + rs2, e0_ = cslot * rs13, e1_ = e0_ + rs13; ++cslot; \
                wconv_job<0>(A->expert_w2, nullptr, DM, DFFE, DM, NEXP, (size_t)DFFE * DM, (size_t)DM * DFFE, WSP(bf16_t, WS_EW2), nullptr, 0, (LAS float*)lds, vcu, G, tid, q0_, q1_); \
                wconv_job<3>(A->expert_w1, A->expert_w3, DFFE, DM, 2 * DFFE, EARLY_EXP, (size_t)DM * DFFE, (size_t)2 * DFFE * DM, WSP(bf16_t, WS_EW13), nullptr, 0, (LAS float*)lds, vcu, G, tid, e0_, e1_); } } while (0)
#define CONV_SLOT0() do { CONV_CONSTS if (l == 0) { __syncthreads(); const int rs0 = (rpA + rpB + rpC + rpD + rpE + nslots / 3 - 1) / (nslots / 3), g0_ = cslot * rs0; \
                CJ(1, A->w_in + (size_t)DM * N_IN_SRC, nullptr, N_IN_SRC, DM, NIN, 1, 0, 0, WSP(bf16_t, WS_WIN) + (size_t)NIN * DM, 0, rpA); \
                CJ(3, A->dense_w1, A->dense_w3, DFF, DM, 2 * DFF, 1, 0, 0, WSP(bf16_t, WS_WD13), rpA, rpB); \
                CJ(0, A->w_branch, nullptr, DM, 1024, DM, 6, (size_t)1024 * DM, (size_t)DM * 1024, WSP(bf16_t, WS_WBR), rpA + rpB, rpC); \
                CJ(0, A->dense_w2, nullptr, DM, DFF, DM, 1, 0, 0, WSP(bf16_t, WS_WD2), rpA + rpB + rpC, rpD); \
                CJ(0, A->w_out, nullptr, DM, DM, DM, 2, (size_t)DM * DM, (size_t)DM * DM, WSP(bf16_t, WS_WOUT), rpA + rpB + rpC + rpD, rpE); ++cslot; } } while (0)
            if (ATT_MODES & 1) for (int u = vcu; u < 512; u += G) for (int hf = 0; hf < 2; ++hf) { att::attn_unit<0>(P, u >> 6, (u >> 3) & 7, hf ? 15 - (u & 7) : (u & 7), (LAS char*)lds); CONV_SLOT0(); CONV_SLOT(); }
            if (ATT_MODES & 2) for (int u = vcu; u < 512; u += G) for (int hf = 0; hf < 2; ++hf) { att::attn_unit<1>(P, u >> 6, (u >> 3) & 7, hf ? 15 - (u & 7) : (u & 7), (LAS char*)lds); CONV_SLOT(); }
            if (ATT_MODES & 4) for (int u = vcu; u < 512; u += G) for (int hf = 0; hf < 2; ++hf) { att::attn_unit<2>(P, u >> 6, (u >> 3) & 7, hf ? 15 - (u & 7) : (u & 7), (LAS char*)lds); CONV_SLOT(); }
#undef CONV_SLOT
#undef CONV_SLOT0
#undef CJ
#undef CONV_CONSTS
            __syncthreads();
        }
        SEAM(pb + 4);


        if (EN(6) && IN(pb + 6)) REPS(6) {
            PHASE_LOCALS;
            pg8::Gemm g{WSP(bf16_t, WS_OBUF), 3072, 1024, WSP(bf16_t, WS_WBR + (size_t)l * SZ_WBR), 1024, (size_t)DM * 1024}; pg8::Z3Order S; S.init(T / 256, DM / 256, G, bx);
            pg8::EpiBranch E{WSP(bf16_t, WS_MERGED), WSP(bf16_t, WS_PROJ)};
            pg8::gemm_phase(lds, g, S, E);
        }
        SEAM(pb + 6);

        if (EN(7) && IN(pb + 7)) REPS(7) {
            PHASE_LOCALS;
            pg8::Gemm g{WSP(bf16_t, WS_MERGED), DM, 0, WSP(bf16_t, WS_WOUT + (size_t)l * SZ_WOUT), DM, 0}; pg8::StaticOrder S; S.init(T / 256, DM / 256, G, bx);
            pg8::EpiResid E{(l == 0) ? A->x : (const float*)A->out, (((PROBE_REP_MASK >> 7) & 1u) && rep_ == 0) ? WSP(float, WS_QM) : A->out};
            pg8::gemm_phase(lds, g, S, E);
        }
        SEAM(pb + 7);

        if (l == 0) {
            if (EN(8) && IN(pb + 8)) REPS(8) { PHASE_LOCALS; rmsnorm_rows(A->out, A->ffn_norm_g, WSP(bf16_t, WS_H), vcu, G, wave, lane); }
            SEAM(pb + 8);
            if (EN(9) && IN(pb + 9)) REPS(9) {
                PHASE_LOCALS;
                pg8::Gemm g{WSP(bf16_t, WS_H), DM, 0, WSP(bf16_t, WS_WD13), DM, 0}; pg8::StaticOrder S; S.init(T / 256, 2 * DFF / 256, G, bx);
                pg8::EpiSwiglu E{WSP(bf16_t, WS_UD), DFF};
                pg8::gemm_phase(lds, g, S, E);
            }
            SEAM(pb + 9);
            if (EN(10) && IN(pb + 10)) REPS(10) {
                PHASE_LOCALS;
                pg8::Gemm g{WSP(bf16_t, WS_UD), DFF, 0, WSP(bf16_t, WS_WD2), DFF, 0}; pg8::StaticOrder S; S.init(T / 256, DM / 256, G, bx);
                pg8::EpiResid E{A->out, (((PROBE_REP_MASK >> 10) & 1u) && rep_ == 0) ? WSP(float, WS_QM) : A->out};
                pg8::gemm_phase(lds, g, S, E);
            }
            SEAM(pb + 10);
        } else {
            if (EN(11) && IN(pb + 8)) REPS(11) {
                PHASE_LOCALS; LAS float* scr = (LAS float*)lds;
                wconv_job<3>(A->expert_w1 + (size_t)EARLY_EXP * DM * DFFE, A->expert_w3 + (size_t)EARLY_EXP * DM * DFFE, DFFE, DM, 2 * DFFE, NEXP - EARLY_EXP, (size_t)DM * DFFE, (size_t)2 * DFFE * DM,
                             WSP(bf16_t, WS_EW13) + (size_t)EARLY_EXP * 2 * DFFE * DM, nullptr, 0, scr, vcu, G, tid);
                __syncthreads();
                moe_route(A->out, A->ffn_norm_g + DM, A->router_w, WSP(int, MS_ROUTE), WSP(float, MS_RSTD2), WSP(unsigned, MS_CNT), lds, vcu, G, tid, wave, lane);
            }
            SEAM(pb + 8);
            if (EN(12) && IN(pb + 9)) REPS(12) { PHASE_LOCALS;
                moe_gather(A->out, A->ffn_norm_g + DM, WSP(int, MS_ROUTE), WSP(float, MS_RSTD2), WSP(unsigned, MS_CNT), WSP(int, MS_SLOTS), WSP(int, MS_MOEOFF), WSP(bf16_t, WS_HS), lds, vcu, G, tid, wave, lane); }
            SEAM(pb + 9);
            if (EN(13) && IN(pb + 10)) REPS(13) {
                PHASE_LOCALS;
                pg8::MoeOrder S; const int* moe_off = WSP(int, MS_MOEOFF);
#pragma unroll
                for (int e = 0; e < 9; ++e) S.off[e] = __builtin_amdgcn_readfirstlane(moe_off[e]);
                S.init(S.off[8] / 256, 2 * DFFE / 256, G, bx);
                pg8::Gemm g{WSP(bf16_t, WS_HS), DM, 0, WSP(bf16_t, WS_EW13), DM, (size_t)2 * DFFE * DM};
                pg8::EpiSwiglu E{WSP(bf16_t, WS_UM), DFFE};
                pg8::gemm_phase(lds, g, S, E);
            }
            SEAM(pb + 10);
            if (EN(14) && IN(pb + 11)) REPS(14) {
                PHASE_LOCALS;
                pg8::MoeRange S; const int* moe_off = WSP(int, MS_MOEOFF);
#pragma unroll
                for (int e = 0; e < 9; ++e) S.off[e] = __builtin_amdgcn_readfirstlane(moe_off[e]);
                S.init(S.off[8] / 256, DM / 256, G, bx); int Gd = G; asm volatile("" : "+s"(Gd)); S.i0 = 0; S.i1 = S.nwg / Gd;
                if ((S.i1 * G) % (pg8::WGM * (DM / 256)) == 0) S.nwg = S.i1 * G; else S.i1 += 1;
                pg8::Gemm g{WSP(bf16_t, WS_UM), DFFE, 0, WSP(bf16_t, WS_EW2), DFFE, (size_t)DM * DFFE};
                pg8::EpiBf16 E{WSP(bf16_t, WS_HS), DM, nullptr};
                pg8::gemm_phase(lds, g, S, E);
            }
            SEAM(pb + 11);
            if (EN(15) && IN(pb + 12)) REPS(15) { PHASE_LOCALS;
                pg8::MoeOne S; const int* moe_off = WSP(int, MS_MOEOFF);
#pragma unroll
                for (int e = 0; e < 9; ++e) S.off[e] = __builtin_amdgcn_readfirstlane(moe_off[e]);
                S.init(S.off[8] / 256, DM / 256, G, bx);
                int Gd = G; asm volatile("" : "+s"(Gd)); constexpr int NIG = pg8::WGM * (DM / 256);
                const int R = S.nwg / Gd; const bool clean = ((R * G) % NIG) == 0; const int Lc = clean ? S.nwg - R * G : 0;
                LAS int* late = (LAS int*)(lds + LDSCTL_OFF + 8192);
                for (int u = tid; u < 512; u += NWAVES * 64) late[u] = (clean && Lc > 0 && u >= (R * G) / (DM / 256) && u < S.nM) ? 1 : 0;
                __syncthreads();
                if (bx < Lc) {
                    { const int id = R * G + bx, gid = id / NIG, fm = gid * pg8::WGM, gsz = (S.nM - fm) < pg8::WGM ? (S.nM - fm) : pg8::WGM; S.pm1 = fm + (id % NIG) % gsz; S.pn1 = (id % NIG) / gsz; }
                    pg8::Gemm g{WSP(bf16_t, WS_UM), DFFE, 0, WSP(bf16_t, WS_EW2), DFFE, (size_t)DM * DFFE};
                    pg8::EpiBf16 E{WSP(bf16_t, WS_HS), DM, nullptr};
                    pg8::gemm_phase(lds, g, S, E);
                } else final_phase(A->out, WSP(bf16_t, WS_HS), WSP(int, MS_ROUTE), WSP(int, MS_SLOTS), A->final_norm_g, A->out, late, false, bx - Lc, G - Lc, wave, lane);
                xcd_barrier(bar);
                final_phase(A->out, WSP(bf16_t, WS_HS), WSP(int, MS_ROUTE), WSP(int, MS_SLOTS), A->final_norm_g, A->out, late, true, vcu, G, wave, lane);
            }
        }
    }
#undef IN
#undef EN
#undef SEAM
#undef PHASE_LOCALS
#undef WSP
}

extern "C" void kernel_launch(void* const* d_in, const int* in_sizes, int n_in, void* d_out, int out_size, void* d_ws, size_t ws_size, hipStream_t stream) {
    static int grid = 0;
    if (grid == 0) {
        if (n_in != 23 || in_sizes[0] != T * DM || out_size != T * DM || ws_size < WS_NEED) {
            fprintf(stderr, "kernel_launch: shape mismatch: n_in %d in0 %d out %d ws %zu (need %zu)\n", n_in, n_in > 0 ? in_sizes[0] : -1, out_size, ws_size, (size_t)WS_NEED); grid = -1; return; }
        int dev = 0, cus = 0, per_cu = 0;
        if (hipGetDevice(&dev) != hipSuccess || hipDeviceGetAttribute(&cus, hipDeviceAttributeMultiprocessorCount, dev) != hipSuccess) { fprintf(stderr, "kernel_launch: device query failed\n"); grid = -1; return; }
        if (hipFuncSetAttribute((const void*)mega_fwd, hipFuncAttributeMaxDynamicSharedMemorySize, LDS_BYTES) != hipSuccess) { fprintf(stderr, "kernel_launch: hipFuncSetAttribute failed\n"); grid = -1; return; }
        if (hipOccupancyMaxActiveBlocksPerMultiprocessor(&per_cu, (const void*)mega_fwd, NWAVES * 64, LDS_BYTES) != hipSuccess || per_cu < 1)
            fprintf(stderr, "kernel_launch: note: occupancy query reports %d workgroups per CU\n", per_cu);
        (void)hipGetLastError();
        grid = cus;
    }
    if (grid < 0) return;
    if (hipMemsetAsync((char*)d_ws + WS_CTL, 0, CTL_ZERO_BYTES, stream) != hipSuccess) { fprintf(stderr, "kernel_launch: memset failed\n"); return; }
    Args a{};
    a.x = (const float*)d_in[0]; a.positions = (const int*)d_in[1]; a.attn_norm_g = (const float*)d_in[2]; a.w_in = (const float*)d_in[3]; a.diff_lambda = (const float*)d_in[4];
    a.diff_subln_g = (const float*)d_in[5]; a.fox_bias = (const float*)d_in[6]; a.q_norm_g = (const float*)d_in[7]; a.kv_norm_g = (const float*)d_in[8]; a.w_uq = (const float*)d_in[9];
    a.w_uk = (const float*)d_in[10]; a.w_uv = (const float*)d_in[11]; a.w_branch = (const float*)d_in[12]; a.w_out = (const float*)d_in[13]; a.ffn_norm_g = (const float*)d_in[14];
    a.dense_w1 = (const float*)d_in[15]; a.dense_w3 = (const float*)d_in[16]; a.dense_w2 = (const float*)d_in[17]; a.router_w = (const float*)d_in[18]; a.expert_w1 = (const float*)d_in[19];
    a.expert_w3 = (const float*)d_in[20]; a.expert_w2 = (const float*)d_in[21]; a.final_norm_g = (const float*)d_in[22];
    a.out = (float*)d_out; a.ws = (unsigned char*)d_ws;
#if MK_ONE_LAUNCH
    a.ph_lo = 0; a.ph_hi = NPH; a.li = 0;
    hipLaunchKernelGGL(mega_fwd, dim3(grid), dim3(NWAVES * 64), LDS_BYTES, stream, a);
#else
    int li = 0;
    for (int k = 0; k < NPH; ++k) { if (!phase_exists(k)) continue;
        a.ph_lo = k; a.ph_hi = k + 1; a.li = li++;
        hipLaunchKernelGGL(mega_fwd, dim3(grid), dim3(NWAVES * 64), LDS_BYTES, stream, a); }
#endif
    const hipError_t le = hipPeekAtLastError();
    if (le != hipSuccess) fprintf(stderr, "kernel_launch: launch failed: %s\n", hipGetErrorName(le));
}
```
